# Optimizing an MI355X kernel written in HIP

```python
import math
import jax, jax.numpy as jnp
from jax import lax
import numpy as np

D_MODEL = 1024
BATCH = 8
SEQ = 4096
DEPTH = 1

D_MIX = D_MODEL
D_SSM = D_MIX // 2
D_CONV = D_MIX - D_SSM
SSM_GROUP = 16
N_SSM_GROUPS = D_SSM // SSM_GROUP
SSM_STATE = 64
CONV_HEADS = 8
CONV_WIDTH = 3
D_FF = ((8 * D_MODEL // 3 + 127) // 128) * 128
FFN_CONV_WIDTH = 3
N_MOD = 6
D_IN_PROJ = D_SSM + 3 * D_CONV
EPS = 1e-6
DT_MIN = 1e-3
DT_MAX = 1e-1
LAMBDA_RE_MAX = -1e-4

kernel_name = 'hymba_s5_shortconv_convffn_adaln'


def rms_norm(x, g):
    xf = x.astype(jnp.float32)
    y = xf * lax.rsqrt(jnp.mean(xf * xf, axis=-1, keepdims=True) + EPS)
    return (y * g.astype(jnp.float32)).astype(x.dtype)


def head_rms_norm(y, g, n_heads):
    shp = y.shape
    yf = y.astype(jnp.float32).reshape(shp[:-1] + (n_heads, shp[-1] // n_heads))
    yf = yf * lax.rsqrt(jnp.mean(yf * yf, axis=-1, keepdims=True) + EPS)
    return (yf.reshape(shp) * g.astype(jnp.float32)).astype(y.dtype)


def causal_dwconv(x, w):
    k_w = w.shape[0]
    seq = x.shape[1]
    xp = jnp.pad(x, ((0, 0), (k_w - 1, 0), (0, 0)))
    y = xp[:, 0:seq, :] * w[0]
    for k in range(1, k_w):
        y = y + xp[:, k:k + seq, :] * w[k]
    return y


def _s5_binop(e1, e2):
    a1, b1 = e1
    a2, b2 = e2
    return a2 * a1, a2 * b1 + b2


def s5_mixer(u, lam_re, lam_im, log_step, b_re, b_im, c_re, c_im, d_skip, glu_w, glu_b):
    bsz, seq, _ = u.shape
    uf = u.astype(jnp.float32)
    ug = uf.reshape(bsz, seq, N_SSM_GROUPS, SSM_GROUP)
    lam = lax.complex(jnp.minimum(lam_re.astype(jnp.float32), LAMBDA_RE_MAX),
                      lam_im.astype(jnp.float32))
    step = jnp.exp(log_step.astype(jnp.float32))[:, None]
    lam_bar = jnp.exp(lam * step)
    b_c = lax.complex(b_re.astype(jnp.float32), b_im.astype(jnp.float32))
    b_bar = ((lam_bar - 1.0) / lam)[..., None] * b_c
    bu = jnp.einsum('blgh,gph->blgp', ug.astype(jnp.complex64), b_bar)
    a = jnp.broadcast_to(lam_bar, (1, seq) + lam_bar.shape)
    _, states = lax.associative_scan(_s5_binop, (a, bu), axis=1)
    c_c = lax.complex(c_re.astype(jnp.float32), c_im.astype(jnp.float32))
    y = jnp.einsum('blgp,ghp->blgh', states, c_c).real.reshape(bsz, seq, D_SSM)
    y = y + d_skip.astype(jnp.float32) * uf
    z = jax.nn.gelu(y)
    z = z * jax.nn.sigmoid(z @ glu_w.astype(jnp.float32) + glu_b.astype(jnp.float32))
    return z.astype(u.dtype)


def short_conv_mixer(bg, cg, v, conv_w):
    return bg * causal_dwconv(cg * v, conv_w)


def conv_ffn(h, w_up, ffn_conv_w, w_down):
    hid = causal_dwconv(h @ w_up, ffn_conv_w)
    a, v = jnp.split(hid, 2, axis=-1)
    return (jax.nn.silu(a) * v) @ w_down


def setup_inputs(seed: int = 0) -> dict:
    key = jax.random.key(seed)
    ks = jax.random.split(key, 26)
    f32 = jnp.float32

    def nrm(k, shape, s):
        return jax.random.normal(k, shape, f32) * s

    nl = DEPTH
    g_, p_, h_ = N_SSM_GROUPS, SSM_STATE, SSM_GROUP
    n_idx = jnp.arange(SSM_STATE, dtype=f32)
    return {
        'x': nrm(ks[0], (BATCH, SEQ, D_MODEL), 1.0),
        'c': nrm(ks[1], (BATCH, D_MODEL), 1.0),
        'w_ada': nrm(ks[2], (nl, D_MODEL, N_MOD * D_MODEL), 0.5 * D_MODEL ** -0.5),
        'b_ada': nrm(ks[3], (nl, N_MOD * D_MODEL), 0.02),
        'g_pre_mix': 1.0 + nrm(ks[4], (nl, D_MODEL), 0.02),
        'g_post_mix': 1.0 + nrm(ks[5], (nl, D_MODEL), 0.02),
        'w_in': nrm(ks[6], (nl, D_MODEL, D_IN_PROJ), D_MODEL ** -0.5),
        'ssm_lam_re': -0.5 + nrm(ks[7], (nl, g_, p_), 0.01),
        'ssm_lam_im': math.pi * n_idx + nrm(ks[8], (nl, g_, p_), 0.01),
        'ssm_log_step': jax.random.uniform(ks[9], (nl, g_), f32, math.log(DT_MIN), math.log(DT_MAX)),
        'ssm_b_re': nrm(ks[10], (nl, g_, p_, h_), (2 * h_) ** -0.5),
        'ssm_b_im': nrm(ks[11], (nl, g_, p_, h_), (2 * h_) ** -0.5),
        'ssm_c_re': nrm(ks[12], (nl, g_, h_, p_), p_ ** -0.5),
        'ssm_c_im': nrm(ks[13], (nl, g_, h_, p_), p_ ** -0.5),
        'ssm_d': nrm(ks[14], (nl, D_SSM), 1.0),
        'glu_w': nrm(ks[15], (nl, D_SSM, D_SSM), D_SSM ** -0.5),
        'glu_b': nrm(ks[16], (nl, D_SSM), 0.02),
        'g_out_ssm': 1.0 + nrm(ks[17], (nl, D_SSM), 0.02),
        'conv_w': nrm(ks[18], (nl, CONV_WIDTH, D_CONV), CONV_WIDTH ** -0.5),
        'g_out_conv': 1.0 + nrm(ks[19], (nl, D_CONV), 0.02),
        'w_out': nrm(ks[20], (nl, D_MIX, D_MODEL), D_MIX ** -0.5),
        'g_pre_ffn': 1.0 + nrm(ks[21], (nl, D_MODEL), 0.02),
        'g_post_ffn': 1.0 + nrm(ks[22], (nl, D_MODEL), 0.02),
        'w_up': nrm(ks[23], (nl, D_MODEL, 2 * D_FF), D_MODEL ** -0.5),
        'ffn_conv_w': nrm(ks[24], (nl, FFN_CONV_WIDTH, 2 * D_FF), FFN_CONV_WIDTH ** -0.5),
        'w_down': nrm(ks[25], (nl, D_FF, D_MODEL), D_FF ** -0.5),
    }


def reference(x, c, w_ada, b_ada, g_pre_mix, g_post_mix, w_in, ssm_lam_re, ssm_lam_im, ssm_log_step,
              ssm_b_re, ssm_b_im, ssm_c_re, ssm_c_im, ssm_d, glu_w, glu_b, g_out_ssm, conv_w, g_out_conv,
              w_out, g_pre_ffn, g_post_ffn, w_up, ffn_conv_w, w_down):
    c_act = jax.nn.silu(c)
    for i in range(DEPTH):
        mod = (c_act @ w_ada[i] + b_ada[i])[:, None, :]
        sh1, sc1, gt1, sh2, sc2, gt2 = jnp.split(mod, N_MOD, axis=-1)

        h = rms_norm(x, g_pre_mix[i]) * (1.0 + sc1) + sh1
        proj = h @ w_in[i]
        u = proj[..., :D_SSM]
        bg, cg, v = jnp.split(proj[..., D_SSM:], 3, axis=-1)
        y_a = s5_mixer(u, ssm_lam_re[i], ssm_lam_im[i], ssm_log_step[i], ssm_b_re[i], ssm_b_im[i],
                       ssm_c_re[i], ssm_c_im[i], ssm_d[i], glu_w[i], glu_b[i])
        y_b = short_conv_mixer(bg, cg, v, conv_w[i])
        y = jnp.concatenate([head_rms_norm(y_a, g_out_ssm[i], N_SSM_GROUPS),
                             head_rms_norm(y_b, g_out_conv[i], CONV_HEADS)], axis=-1)
        x = x + gt1 * rms_norm(y @ w_out[i], g_post_mix[i])

        h = rms_norm(x, g_pre_ffn[i]) * (1.0 + sc2) + sh2
        x = x + gt2 * rms_norm(conv_ffn(h, w_up[i], ffn_conv_w[i], w_down[i]), g_post_ffn[i])
    return x
```

```cpp
#include <hip/hip_runtime.h>
#include <hip/hip_cooperative_groups.h>
#include <cstdio>
#include <cstdint>
namespace cg = cooperative_groups;

#ifndef ONE_LAUNCH
#define ONE_LAUNCH 0
#endif

#define LAS __attribute__((address_space(3)))
typedef unsigned short bf16_t;
typedef short bf16x8 __attribute__((ext_vector_type(8)));
typedef float f32x4 __attribute__((ext_vector_type(4)));
typedef float f32x16 __attribute__((ext_vector_type(16)));
typedef unsigned u32x4 __attribute__((ext_vector_type(4)));
typedef unsigned u32x2 __attribute__((ext_vector_type(2)));

constexpr int NB = 8, SEQ = 4096, D = 1024, M = NB * SEQ;
constexpr int DSSM = 512, DIN = 2048, DFF = 2816, NUP = 2 * DFF, NMOD = 6 * D;
constexpr int NGRP = 32, TCH = 16, NCH = SEQ / TCH;
constexpr float EPS = 1e-6f;

constexpr size_t MiB = 1u << 20;
constexpr size_t WS_MOD = 0, WS_WIN = 1 * MiB, WS_GLU = 5 * MiB, WS_WOUT = 6 * MiB, WS_WUP = 8 * MiB, WS_WDN = 19 * MiB,
                 WS_HT = 25 * MiB, WS_SS = 36 * MiB, WS_H = 68 * MiB, WS_PROJ = 132 * MiB, WS_Z = 260 * MiB, WS_Y = 292 * MiB,
                 WS_T = 356 * MiB, WS_G = 132 * MiB, WS_END = 420 * MiB;

constexpr int LDS_BYTES = 152064;
constexpr int NPHASE = 11;

__device__ __forceinline__ unsigned pk2(float lo, float hi) { unsigned r; asm("v_cvt_pk_bf16_f32 %0, %1, %2" : "=v"(r) : "v"(lo), "v"(hi)); return r; }
__device__ __forceinline__ float bflo(unsigned w) { return __uint_as_float(w << 16); }
__device__ __forceinline__ float bfhi(unsigned w) { return __uint_as_float(w & 0xffff0000u); }
__device__ __forceinline__ float bf1(bf16_t h) { return __uint_as_float(((unsigned)h) << 16); }
__device__ __forceinline__ float wave_sum(float v) {
#pragma unroll
    for (int o = 1; o < 64; o <<= 1) v += __shfl_xor(v, o);
    return v;
}
__device__ __forceinline__ float sigmoidf_(float x) { return 1.0f / (1.0f + __expf(-x)); }
__device__ __forceinline__ float siluf_(float x) { return x / (1.0f + __expf(-x)); }
__device__ __forceinline__ float gelu_tanh(float y) {
    const float a = 0.7978845608028654f * (y + 0.044715f * y * y * y);
    const float t = 1.0f - 2.0f / (1.0f + __expf(2.0f * a));
    return 0.5f * y * (1.0f + t);
}
__device__ __forceinline__ int lane_id() { return (int)__builtin_amdgcn_mbcnt_hi(~0u, __builtin_amdgcn_mbcnt_lo(~0u, 0u)); }
#define LDS_WAIT() asm volatile("s_waitcnt lgkmcnt(0)" ::: "memory")

namespace pg8 {
constexpr int BM = 256, BK = 64, HALF = 128, HTB = HALF * BK * 2, STAGE_BYTES = 8 * HTB, NXCD = 8, WGM = 8;
__host__ __device__ __forceinline__ int lds_byte(int r, int c) { const int st = (r >> 4) * 2 + (c >> 5), rr = r & 15, cc = c & 31, ob = rr * 64 + cc * 2; return st * 1024 + (ob ^ (((ob >> 9) & 1) << 5)); }
__host__ __device__ __forceinline__ void stage_rc(int b, int& R, int& C) { const int st = b / 1024, sb = b % 1024, swz = sb ^ (((sb >> 9) & 1) << 5); R = (st >> 1) * 16 + swz / 64; C = (st & 1) * 32 + (swz % 64) / 2; }
__host__ __device__ __forceinline__ int perm32(int rho) { const int n = rho >> 4, i = rho & 15; return 8 * (i >> 2) + 4 * n + (i & 3); }
struct Unit { int pm, pn; };
struct Gemm { const bf16_t* A; const bf16_t* Bt; int M, N, K; };
struct StaticOrder {
    int nM, nN, nwg, G, c;
    __device__ void init(int M_, int N_, int G_, int c_) { nM = M_ / BM; nN = N_ / BM; nwg = nM * nN; G = G_; c = c_; }
    __device__ bool next(int i, Unit& u) const {
        const long L = (long)i * G + c; if (L >= nwg) return false;
        int wgid = (int)L; { const int q = nwg / NXCD, r = nwg % NXCD, xcd = wgid % NXCD, off = wgid / NXCD; wgid = (xcd < r ? xcd * (q + 1) : r * (q + 1) + (xcd - r) * q) + off; }
        const int nig = WGM * nN, gid = wgid / nig, fm = gid * WGM, gsz = (nM - fm) < WGM ? (nM - fm) : WGM;
        u.pm = fm + ((wgid % nig) % gsz); u.pn = (wgid % nig) / gsz; return true;
    }
};

template <class Epi, bool ALIGN_EPI, bool SP2>
__device__ __forceinline__ void gemm_phase(LAS unsigned char* lds, const Gemm g, const StaticOrder& S, const Epi& E, int wid0) {
    int tid_ = wid0 * 64 + lane_id(); asm volatile("" : "+v"(tid_));
    const int tid = tid_, wid = __builtin_amdgcn_readfirstlane(tid >> 6), lane = tid & 63, wr = wid >> 2, wc = wid & 3, fr = lane & 15, fq = lane >> 4;
    const int K = g.K, nt = K / BK;
    unsigned voffA[2], voffB[2];
#pragma unroll
    for (int i = 0; i < 2; ++i) { int R, C; stage_rc(tid * 16 + i * 8192, R, C); const int Rb = Epi::PERM ? ((R & ~31) + perm32(R & 31)) : R;
        voffA[i] = (unsigned)(R * K + C) * 2u; voffB[i] = (unsigned)(Rb * K + C) * 2u; }
    const size_t kstep = (size_t)(BK * 2);
    const size_t hstep = (size_t)HALF * K * 2;
    const size_t tstep = 2 * hstep;
    const unsigned ldsw = (unsigned)wid * 1024u;
    const int aoff = lds_byte(wr * 64 + fr, fq * 8), boff = lds_byte(wc * 32 + fr, fq * 8);
#define PG8_SA(b, h) (((b) * 2 + (h)) * HTB)
#define PG8_SB(b, h) ((4 + (b) * 2 + (h)) * HTB)
#define PG8_STAGE(bufoff, gbase, voff) do { _Pragma("unroll") for (int _i = 0; _i < 2; ++_i) \
        __builtin_amdgcn_global_load_lds((const unsigned*)((const char*)(gbase) + (voff)[_i]), (LAS unsigned*)(lds + (bufoff) + ldsw + _i * 8192), 16, 0, 0); } while (0)
#define PG8_LDA(dst, b, h) do { _Pragma("unroll") for (int m = 0; m < 4; ++m) _Pragma("unroll") for (int k = 0; k < 2; ++k) dst[m][k] = *(const LAS bf16x8*)(lds + PG8_SA(b, h) + aoff + m * 2048 + k * 1024); } while (0)
#define PG8_LDB(dst, b, h) do { _Pragma("unroll") for (int n = 0; n < 2; ++n) _Pragma("unroll") for (int k = 0; k < 2; ++k) dst[n][k] = *(const LAS bf16x8*)(lds + PG8_SB(b, h) + boff + n * 2048 + k * 1024); } while (0)
#define PG8_MMA(ai, bj, At, Bt) do { __builtin_amdgcn_s_setprio(1); _Pragma("unroll") for (int m = 0; m < 4; ++m) _Pragma("unroll") for (int n = 0; n < 2; ++n) _Pragma("unroll") for (int k = 0; k < 2; ++k) \
        acc[ai][bj][m][n] = __builtin_amdgcn_mfma_f32_16x16x32_bf16(Bt[n][k], At[m][k], acc[ai][bj][m][n], 0, 0, 0); __builtin_amdgcn_s_setprio(0); } while (0)
#define PG8_WAIT_V(n) asm volatile("s_waitcnt vmcnt(" #n ")" ::: "memory")
#define PG8_WAIT_L(n) asm volatile("s_waitcnt lgkmcnt(" #n ")" ::: "memory")
#define PG8_BAR __builtin_amdgcn_s_barrier()
#define PG8_SCHED __builtin_amdgcn_sched_barrier(0)
    Unit cur, nxt; int ui = 0;
    if (!S.next(0, cur)) return;
    f32x4 acc[2][2][4][2];
#pragma unroll
    for (int a = 0; a < 2; ++a)
#pragma unroll
        for (int b = 0; b < 2; ++b)
#pragma unroll
            for (int m = 0; m < 4; ++m)
#pragma unroll
                for (int n = 0; n < 2; ++n) acc[a][b][m][n] = (f32x4){0.f, 0.f, 0.f, 0.f};
    bf16x8 At[4][2], B0[2][2], B1[2][2];
    const char* cA = (const char*)g.A + (size_t)cur.pm * tstep; const char* cB = (const char*)g.Bt + (size_t)cur.pn * tstep;
    if constexpr (SP2) {
        PG8_STAGE(PG8_SB(0, 0), cB, voffB); PG8_STAGE(PG8_SB(0, 1), cB + hstep, voffB); PG8_STAGE(PG8_SA(0, 0), cA, voffA); PG8_STAGE(PG8_SA(0, 1), cA + hstep, voffA);
        if (wr == 1) PG8_BAR;
        PG8_WAIT_V(2); PG8_BAR;
        PG8_STAGE(PG8_SB(1, 0), cB + kstep, voffB); PG8_STAGE(PG8_SA(1, 0), cA + kstep, voffA); PG8_STAGE(PG8_SB(1, 1), cB + hstep + kstep, voffB);
        PG8_WAIT_V(6); PG8_BAR;
    } else {
        PG8_STAGE(PG8_SB(0, 0), cB, voffB); PG8_STAGE(PG8_SA(0, 0), cA, voffA); PG8_STAGE(PG8_SB(0, 1), cB + hstep, voffB); PG8_STAGE(PG8_SA(0, 1), cA + hstep, voffA);
        if (wr == 1) PG8_BAR;
        PG8_WAIT_V(4); PG8_BAR;
        PG8_STAGE(PG8_SB(1, 0), cB + kstep, voffB); PG8_STAGE(PG8_SA(1, 0), cA + kstep, voffA); PG8_STAGE(PG8_SB(1, 1), cB + hstep + kstep, voffB);
        PG8_WAIT_V(6); PG8_BAR;
    }
    for (;;) {
        const bool has_next = S.next(ui + 1, nxt);
        const char* nA = has_next ? (const char*)g.A + (size_t)nxt.pm * tstep : cA; const char* nB = has_next ? (const char*)g.Bt + (size_t)nxt.pn * tstep : cB;
        for (int t = 0; t < nt; t += 2) {
            const bool last = (t == nt - 2);
            const char* a1 = cA + (size_t)(t + 1) * kstep;
            const char* a2 = last ? nA : cA + (size_t)(t + 2) * kstep; const char* b2 = last ? nB : cB + (size_t)(t + 2) * kstep;
            const char* a3 = a2 + kstep; const char* b3 = b2 + kstep;
            if constexpr (SP2) {
            PG8_LDB(B0, 0, 0); PG8_LDB(B1, 0, 1); PG8_SCHED; PG8_LDA(At, 0, 0); PG8_STAGE(PG8_SA(1, 1), a1 + hstep, voffA);
            PG8_WAIT_V(8); PG8_WAIT_L(0); PG8_BAR; PG8_MMA(0, 0, At, B0); PG8_MMA(0, 1, At, B1); PG8_BAR; PG8_SCHED;
            PG8_LDA(At, 0, 1); PG8_STAGE(PG8_SB(0, 0), b2, voffB); PG8_STAGE(PG8_SB(0, 1), b2 + hstep, voffB); PG8_STAGE(PG8_SA(0, 0), a2, voffA);
            PG8_WAIT_V(8); PG8_WAIT_L(0); PG8_BAR; PG8_MMA(1, 0, At, B0); PG8_MMA(1, 1, At, B1); PG8_BAR; PG8_SCHED;
            PG8_LDB(B0, 1, 0); PG8_LDB(B1, 1, 1); PG8_SCHED; PG8_LDA(At, 1, 0); PG8_STAGE(PG8_SA(0, 1), a2 + hstep, voffA);
            PG8_WAIT_V(8); PG8_WAIT_L(0); PG8_BAR; PG8_MMA(0, 0, At, B0); PG8_MMA(0, 1, At, B1); PG8_BAR; PG8_SCHED;
            PG8_LDA(At, 1, 1); PG8_STAGE(PG8_SB(1, 0), b3, voffB); PG8_STAGE(PG8_SB(1, 1), b3 + hstep, voffB); PG8_STAGE(PG8_SA(1, 0), a3, voffA);
            PG8_WAIT_V(8); PG8_WAIT_L(0); PG8_BAR; PG8_MMA(1, 0, At, B0); PG8_MMA(1, 1, At, B1); PG8_BAR; PG8_SCHED;
            } else {
            PG8_LDB(B0, 0, 0); PG8_SCHED; PG8_LDA(At, 0, 0); PG8_STAGE(PG8_SA(1, 1), a1 + hstep, voffA);
            PG8_WAIT_L(8); PG8_BAR; PG8_WAIT_L(0); PG8_MMA(0, 0, At, B0); PG8_BAR; PG8_SCHED;
            PG8_LDB(B1, 0, 1); PG8_STAGE(PG8_SB(0, 0), b2, voffB);
            PG8_BAR; PG8_WAIT_L(0); PG8_MMA(0, 1, At, B1); PG8_BAR;
            PG8_LDA(At, 0, 1); PG8_STAGE(PG8_SA(0, 0), a2, voffA);
            PG8_BAR; PG8_WAIT_L(0); PG8_MMA(1, 0, At, B0); PG8_BAR; PG8_SCHED;
            PG8_STAGE(PG8_SB(0, 1), b2 + hstep, voffB);
            PG8_WAIT_V(6); PG8_BAR; PG8_MMA(1, 1, At, B1); PG8_BAR;
            PG8_LDB(B0, 1, 0); PG8_SCHED; PG8_LDA(At, 1, 0); PG8_STAGE(PG8_SA(0, 1), a2 + hstep, voffA);
            PG8_WAIT_L(8); PG8_BAR; PG8_WAIT_L(0); PG8_MMA(0, 0, At, B0); PG8_BAR; PG8_SCHED;
            PG8_LDB(B1, 1, 1); PG8_STAGE(PG8_SB(1, 0), b3, voffB);
            PG8_BAR; PG8_WAIT_L(0); PG8_MMA(0, 1, At, B1); PG8_BAR;
            PG8_LDA(At, 1, 1); PG8_STAGE(PG8_SA(1, 0), a3, voffA);
            PG8_BAR; PG8_WAIT_L(0); PG8_MMA(1, 0, At, B0); PG8_BAR; PG8_SCHED;
            PG8_STAGE(PG8_SB(1, 1), b3 + hstep, voffB);
            PG8_WAIT_V(6); PG8_BAR; PG8_MMA(1, 1, At, B1); PG8_BAR;
            }
        }
        if constexpr (ALIGN_EPI) { if (wr == 0) PG8_BAR; }
        E(acc, cur, wr, wc, fr, fq);
        if (!has_next) break;
#pragma unroll
        for (int a = 0; a < 2; ++a)
#pragma unroll
            for (int b = 0; b < 2; ++b)
#pragma unroll
                for (int m = 0; m < 4; ++m)
#pragma unroll
                    for (int n = 0; n < 2; ++n) acc[a][b][m][n] = (f32x4){0.f, 0.f, 0.f, 0.f};
        cur = nxt; cA = nA; cB = nB; ++ui;
        if constexpr (ALIGN_EPI) { if (wr == 1) PG8_BAR; }
    }
    PG8_WAIT_V(0);
    if constexpr (!ALIGN_EPI) { if (wr == 0) PG8_BAR; }
    PG8_BAR;
#undef PG8_SA
#undef PG8_SB
#undef PG8_STAGE
#undef PG8_LDA
#undef PG8_LDB
#undef PG8_MMA
#undef PG8_WAIT_V
#undef PG8_WAIT_L
#undef PG8_SCHED
}

struct EpiBf16 {
    static constexpr bool PERM = true;
    bf16_t* O; int ldc;
    __device__ __forceinline__ void operator()(const f32x4 (&acc)[2][2][4][2], const Unit& u, int wr, int wc, int fr, int fq) const {
        const int row0 = u.pm * BM + wr * 64 + fr, col0 = u.pn * BM + wc * 32 + 8 * fq;
#pragma unroll
        for (int ai = 0; ai < 2; ++ai)
#pragma unroll
            for (int m = 0; m < 4; ++m) { bf16_t* rowp = O + (size_t)(row0 + ai * HALF + m * 16) * ldc + col0;
#pragma unroll
                for (int bj = 0; bj < 2; ++bj) { const f32x4 v0 = acc[ai][bj][m][0], v1 = acc[ai][bj][m][1];
                    u32x4 w; w.x = pk2(v0[0], v0[1]); w.y = pk2(v0[2], v0[3]); w.z = pk2(v1[0], v1[1]); w.w = pk2(v1[2], v1[3]);
                    *(u32x4*)(rowp + bj * HALF) = w; } }
    }
};
struct EpiGlu {
    static constexpr bool PERM = true;
    const bf16_t* Z; bf16_t* Y; const float* glu_b; const float* gss;
    __device__ __forceinline__ void operator()(const f32x4 (&acc)[2][2][4][2], const Unit& u, int wr, int wc, int fr, int fq) const {
        const int row0 = u.pm * BM + wr * 64 + fr, col0 = u.pn * BM + wc * 32 + 8 * fq;
#pragma unroll
        for (int bj = 0; bj < 2; ++bj) {
            const int cb = col0 + bj * HALF;
            const f32x4 b0 = *(const f32x4*)(glu_b + cb), b1 = *(const f32x4*)(glu_b + cb + 4);
            const f32x4 g0 = *(const f32x4*)(gss + cb), g1 = *(const f32x4*)(gss + cb + 4);
#pragma unroll
            for (int ai = 0; ai < 2; ++ai)
#pragma unroll
                for (int m = 0; m < 4; ++m) {
                    const size_t row = (size_t)(row0 + ai * HALF + m * 16);
                    const u32x4 zr = *(const u32x4*)(Z + row * DSSM + cb);
                    float z[8] = {bflo(zr.x), bfhi(zr.x), bflo(zr.y), bfhi(zr.y), bflo(zr.z), bfhi(zr.z), bflo(zr.w), bfhi(zr.w)};
                    float y[8]; float ss = 0.f;
#pragma unroll
                    for (int e = 0; e < 4; ++e) { y[e] = z[e] * sigmoidf_(acc[ai][bj][m][0][e] + b0[e]); y[4 + e] = z[4 + e] * sigmoidf_(acc[ai][bj][m][1][e] + b1[e]); }
#pragma unroll
                    for (int e = 0; e < 8; ++e) ss += y[e] * y[e];
                    ss += __shfl_xor(ss, 16);
                    const float rs = rsqrtf(ss * (1.0f / 16.0f) + EPS);
                    u32x4 w; w.x = pk2(y[0] * rs * g0[0], y[1] * rs * g0[1]); w.y = pk2(y[2] * rs * g0[2], y[3] * rs * g0[3]);
                    w.z = pk2(y[4] * rs * g1[0], y[5] * rs * g1[1]); w.w = pk2(y[6] * rs * g1[2], y[7] * rs * g1[3]);
                    *(u32x4*)(Y + row * D + cb) = w;
                }
        }
    }
};
__device__ __forceinline__ void fmac_shr1(float& o, float src, float w) { asm volatile("s_nop 1\n\tv_fmac_f32_dpp %0, %1, %2 row_shr:1 row_mask:0xf bank_mask:0xf bound_ctrl:1" : "+v"(o) : "v"(src), "v"(w)); }
__device__ __forceinline__ void fmac_shr2(float& o, float src, float w) { asm volatile("v_fmac_f32_dpp %0, %1, %2 row_shr:2 row_mask:0xf bank_mask:0xf bound_ctrl:1" : "+v"(o) : "v"(src), "v"(w)); }
__device__ __forceinline__ void fmac_ror1(float& o, float src, float w) { asm volatile("v_fmac_f32_dpp %0, %1, %2 row_ror:1 row_mask:0xf bank_mask:0xf" : "+v"(o) : "v"(src), "v"(w)); }
__device__ __forceinline__ void fmac_ror2(float& o, float src, float w) { asm volatile("v_fmac_f32_dpp %0, %1, %2 row_ror:2 row_mask:0xf bank_mask:0xf" : "+v"(o) : "v"(src), "v"(w)); }
struct EpiUp {
    static constexpr bool PERM = true;
    bf16_t* G; float* HT; const float* fcw; LAS float* xb;
    __device__ __forceinline__ void operator()(f32x4 (&acc)[2][2][4][2], const Unit& u, int wr, int wc, int fr_, int fq_) const {
        int lq = lane_id(); asm volatile("" : "+v"(lq));
        const int fr = lq & 15, fq = (lq >> 4) & 3;
        const int ct0 = wc * 32 + 8 * fq;
        if (fr >= 14) {
#pragma unroll
            for (int ai = 0; ai < 2; ++ai)
#pragma unroll
                for (int bj = 0; bj < 2; ++bj)
#pragma unroll
                    for (int n = 0; n < 2; ++n) *(LAS f32x4*)(xb + ((ai * 2 + wr) * 2 + (fr - 14)) * 256 + bj * HALF + ct0 + 4 * n) = acc[ai][bj][3][n];
        }
        if (wr == 0 && fr < 2) {
            float* hp = HT + ((size_t)u.pm * 4 + fr) * NUP + (size_t)u.pn * 256 + ct0;
#pragma unroll
            for (int bj = 0; bj < 2; ++bj)
#pragma unroll
                for (int n = 0; n < 2; ++n) *(f32x4*)(hp + bj * HALF + 4 * n) = acc[0][bj][0][n];
        }
        if (wr == 1 && fr >= 14) {
            float* hp = HT + ((size_t)u.pm * 4 + 2 + (fr - 14)) * NUP + (size_t)u.pn * 256 + ct0;
#pragma unroll
            for (int bj = 0; bj < 2; ++bj)
#pragma unroll
                for (int n = 0; n < 2; ++n) *(f32x4*)(hp + bj * HALF + 4 * n) = acc[1][bj][3][n];
        }
        LDS_WAIT(); __builtin_amdgcn_s_barrier(); asm volatile("" ::: "memory");
#ifndef NO_STEP2
#pragma unroll
        for (int bj = 0; bj < 2; ++bj)
#pragma unroll
            for (int n = 0; n < 2; ++n)
#pragma unroll
                for (int e = 0; e < 4; ++e) {
                    __builtin_amdgcn_sched_barrier(0);
                    const int oc = (bj ? DFF : 0) + u.pn * HALF + ct0 + 4 * n + e;
                    const float w0 = fcw[oc], w1 = fcw[NUP + oc], w2 = fcw[2 * NUP + oc];
                    const float w1m = (fr == 0) ? w1 : 0.f, w0m = (fr < 2) ? w0 : 0.f;
#pragma unroll
                    for (int ai = 0; ai < 2; ++ai) {
                        const int blk = ai * 2 + wr;
                        float h = 0.f;
                        if (blk > 0) { const float r14 = xb[((blk - 1) * 2 + 0) * 256 + bj * HALF + ct0 + 4 * n + e], r15 = xb[((blk - 1) * 2 + 1) * 256 + bj * HALF + ct0 + 4 * n + e];
                            h = w1m * r15 + w0m * ((fr == 0) ? r14 : r15); }
#pragma unroll
                        for (int m = 3; m >= 0; --m) {
                            const float cur = acc[ai][bj][m][n][e];
                            float v = w2 * cur;
                            fmac_shr1(v, cur, w1); fmac_shr2(v, cur, w0);
                            if (m > 0) { const float pb = acc[ai][bj][m - 1][n][e]; fmac_ror1(v, pb, w1m); fmac_ror2(v, pb, w0m); }
                            else v += h;
                            acc[ai][bj][m][n][e] = v;
                        }
                    }
                }
#endif
#ifndef NO_STEP3
        const int row0 = u.pm * BM + wr * 64 + fr, col0 = u.pn * HALF + ct0;
#pragma unroll
        for (int ai = 0; ai < 2; ++ai)
#pragma unroll
            for (int m = 0; m < 4; ++m) {
                __builtin_amdgcn_sched_barrier(0);
                const f32x4 a0 = acc[ai][0][m][0], a1 = acc[ai][0][m][1], v0 = acc[ai][1][m][0], v1 = acc[ai][1][m][1];
                u32x4 w; w.x = pk2(siluf_(a0[0]) * v0[0], siluf_(a0[1]) * v0[1]); w.y = pk2(siluf_(a0[2]) * v0[2], siluf_(a0[3]) * v0[3]);
                w.z = pk2(siluf_(a1[0]) * v1[0], siluf_(a1[1]) * v1[1]); w.w = pk2(siluf_(a1[2]) * v1[2], siluf_(a1[3]) * v1[3]);
                *(u32x4*)(G + (size_t)(row0 + ai * HALF + m * 16) * DFF + col0) = w;
            }
#endif
    }
};
#undef PG8_BAR
}

struct Args { const float* in[26]; float* out; unsigned char* ws; int ph_lo, ph_hi; };
typedef const __attribute__((address_space(4))) Args* ArgsP;
__device__ __forceinline__ ArgsP opaque_args() { ArgsP p = (ArgsP)__builtin_amdgcn_kernarg_segment_ptr(); asm volatile("" : "+s"(p)); return p; }
enum { I_X = 0, I_C, I_WADA, I_BADA, I_GPREMIX, I_GPOSTMIX, I_WIN, I_LRE, I_LIM, I_LSTEP, I_BRE, I_BIM, I_CRE, I_CIM, I_DSKIP, I_GLUW, I_GLUB,
       I_GOSSM, I_CONVW, I_GOCONV, I_WOUT, I_GPREFFN, I_GPOSTFFN, I_WUP, I_FCW, I_WDN };

__device__ __forceinline__ void transpose_item(const float* W, int K, int N, bf16_t* WT, int drow, int k0, int n0, LAS float* scr, int lane) {
#pragma unroll 8
    for (int i = 0; i < 32; ++i) { const int kk = 2 * i + (lane >> 5); scr[kk * 33 + (lane & 31)] = W[(size_t)(k0 + kk) * N + n0 + (lane & 31)]; }
    LDS_WAIT();
    const int c = lane & 7;
#pragma unroll
    for (int j = 0; j < 4; ++j) { const int n = (lane >> 3) + 8 * j; const LAS float* s = scr + (8 * c) * 33 + n;
        u32x4 o; o.x = pk2(s[0 * 33], s[1 * 33]); o.y = pk2(s[2 * 33], s[3 * 33]); o.z = pk2(s[4 * 33], s[5 * 33]); o.w = pk2(s[6 * 33], s[7 * 33]);
        *(u32x4*)(WT + (size_t)(drow + n) * K + k0 + 8 * c) = o; }
    LDS_WAIT();
}
__device__ __forceinline__ void p0_prologue(ArgsP ap, LAS unsigned char* lds, int wid0) {
    int tid_ = wid0 * 64 + lane_id(); asm volatile("" : "+v"(tid_));
    const int tid = tid_, lane = tid & 63, wave = tid >> 6, G = gridDim.x;
    unsigned char* ws = ap->ws;
    if ((int)blockIdx.x < 96) {
        LAS float* cact = (LAS float*)(lds + 72 * 1024);
        LAS float* red = (LAS float*)(lds + 104 * 1024);
        const float* c = ap->in[I_C];
        for (int i = tid; i < NB * D; i += 512) cact[i] = siluf_(c[i]);
        __syncthreads();
        for (int item = blockIdx.x; item < 96; item += G) {
            const int col = item * 64 + lane, k0 = wave * 128;
            const float* wp = ap->in[I_WADA] + (size_t)k0 * NMOD + col;
            float acc[NB];
#pragma unroll
            for (int b = 0; b < NB; ++b) acc[b] = 0.f;
#pragma unroll 8
            for (int k = 0; k < 128; ++k) { const float w = wp[(size_t)k * NMOD];
#pragma unroll
                for (int b = 0; b < NB; ++b) acc[b] += cact[b * D + k0 + k] * w; }
#pragma unroll
            for (int b = 0; b < NB; ++b) red[(wave * NB + b) * 64 + lane] = acc[b];
            __syncthreads();
            { const int b = wave; float s = ap->in[I_BADA][col];
#pragma unroll
              for (int w = 0; w < 8; ++w) s += red[(w * NB + b) * 64 + lane];
              ((float*)(ws + WS_MOD))[b * NMOD + col] = s; }
            __syncthreads();
        }
    }
    LAS float* scr = (LAS float*)(lds + wave * 8704);
    const int gw = blockIdx.x * 8 + wave, NGW = G * 8;
    constexpr int I1 = 16 * 64, I2 = 8 * 16, I3 = 16 * 32, I4 = 16 * 176, I5 = 44 * 32, NIT = I1 + I2 + I3 + I4 + I5;
    for (int it = gw; it < NIT; it += NGW) {
        int r = it;
        if (r < I1) { const int nb = r % 64, kb = r / 64; transpose_item(ap->in[I_WIN], D, DIN, (bf16_t*)(ws + WS_WIN), 32 * nb, 64 * kb, 32 * nb, scr, lane); continue; } r -= I1;
        if (r < I2) { const int nb = r % 16, kb = r / 16; transpose_item(ap->in[I_GLUW], DSSM, DSSM, (bf16_t*)(ws + WS_GLU), 32 * nb, 64 * kb, 32 * nb, scr, lane); continue; } r -= I2;
        if (r < I3) { const int nb = r % 32, kb = r / 32; transpose_item(ap->in[I_WOUT], D, D, (bf16_t*)(ws + WS_WOUT), 32 * nb, 64 * kb, 32 * nb, scr, lane); continue; } r -= I3;
        if (r < I4) { const int nb = r % 176, kb = r / 176; const int n0 = 32 * nb; const int j = n0 < DFF ? n0 : n0 - DFF;
            const int drow = (j / 128) * 256 + (n0 < DFF ? 0 : 128) + (j % 128);
            transpose_item(ap->in[I_WUP], D, NUP, (bf16_t*)(ws + WS_WUP), drow, 64 * kb, n0, scr, lane); continue; } r -= I4;
        { const int nb = r % 32, kb = r / 32; transpose_item(ap->in[I_WDN], DFF, D, (bf16_t*)(ws + WS_WDN), 32 * nb, 64 * kb, 32 * nb, scr, lane); }
    }
}

__device__ __forceinline__ void p1_rows(ArgsP ap, int wid0) {
    int tid_ = wid0 * 64 + lane_id(); asm volatile("" : "+v"(tid_));
    const int lane = tid_ & 63, wave = tid_ >> 6, G = gridDim.x;
    const float* mod = (const float*)(ap->ws + WS_MOD);
    bf16_t* H = (bf16_t*)(ap->ws + WS_H);
    for (int base = (blockIdx.x * 8 + wave) * 16; base < M; base += G * 8 * 16) {
        const int b = base / SEQ;
        f32x4 gs[4], sh[4];
#pragma unroll
        for (int j = 0; j < 4; ++j) { const int col = 4 * lane + 256 * j;
            const f32x4 g = *(const f32x4*)(ap->in[I_GPREMIX] + col), sc = *(const f32x4*)(mod + b * NMOD + D + col);
            gs[j] = g * (sc + 1.0f); sh[j] = *(const f32x4*)(mod + b * NMOD + col); }
        for (int r = 0; r < 16; ++r) {
            const size_t row = base + r;
            const f32x4* xr = (const f32x4*)(ap->in[I_X] + row * D) + lane;
            f32x4 v[4]; float ss = 0.f;
#pragma unroll
            for (int j = 0; j < 4; ++j) { v[j] = xr[64 * j]; ss += (v[j].x * v[j].x + v[j].y * v[j].y) + (v[j].z * v[j].z + v[j].w * v[j].w); }
            const float rs = rsqrtf(wave_sum(ss) * (1.0f / D) + EPS);
            u32x2* o = (u32x2*)(H + row * D) + lane;
#pragma unroll
            for (int j = 0; j < 4; ++j) { const f32x4 h = v[j] * rs * gs[j] + sh[j]; u32x2 w; w.x = pk2(h.x, h.y); w.y = pk2(h.z, h.w); o[64 * j] = w; }
        }
    }
}

constexpr int L_KTAB = 0, L_XS = 8704, L_MT = 78336, L_CARRY = 147968;
constexpr int L_BBAR = L_XS, L_CC = L_XS + 8192, L_LAMP = L_XS + 16384;
__device__ __forceinline__ void ssm_unit(ArgsP ap, LAS unsigned char* lds, int unit, int wid0) {
    int tid_ = wid0 * 64 + lane_id(); asm volatile("" : "+v"(tid_));
    const int tid = tid_, lane = tid & 63, wave = __builtin_amdgcn_readfirstlane(tid >> 6), b = unit >> 5, g = unit & 31;
    const bf16_t* PROJ = (const bf16_t*)(ap->ws + WS_PROJ);
    bf16_t* Z = (bf16_t*)(ap->ws + WS_Z);
    float* SS = (float*)(ap->ws + WS_SS) + (size_t)unit * NCH * 128;
    LAS float* bbar = (LAS float*)(lds + L_BBAR);
    LAS float* cc = (LAS float*)(lds + L_CC);
    LAS float* lamp = (LAS float*)(lds + L_LAMP);
    __syncthreads();
    const float step = expf(ap->in[I_LSTEP][g]);
    for (int i = tid; i < 17 * 64; i += 512) { const int d = i >> 6, p = i & 63;
        const float lr = fminf(ap->in[I_LRE][g * 64 + p], -1e-4f), li = ap->in[I_LIM][g * 64 + p];
        const float er = expf(lr * step * (float)d); float sn, cs; sincosf(li * step * (float)d, &sn, &cs);
        lamp[i * 2] = er * cs; lamp[i * 2 + 1] = er * sn; }
    for (int i = tid; i < 64 * 16; i += 512) { const int p = i >> 4;
        const float lr = fminf(ap->in[I_LRE][g * 64 + p], -1e-4f), li = ap->in[I_LIM][g * 64 + p];
        const float ar = lr * step, ai = li * step;
        float sn, cs; sincosf(ai, &sn, &cs); const float em1 = expm1f(ar), ea = em1 + 1.0f; const float sh = sinf(0.5f * ai);
        const float nr = em1 * cs - 2.0f * sh * sh, ni = ea * sn;
        const float den = 1.0f / (lr * lr + li * li);
        const float qr = (nr * lr + ni * li) * den, qi = (ni * lr - nr * li) * den;
        const float br = ap->in[I_BRE][(size_t)g * 1024 + i], bi = ap->in[I_BIM][(size_t)g * 1024 + i];
        bbar[i * 2] = qr * br - qi * bi; bbar[i * 2 + 1] = qr * bi + qi * br; }
    for (int i = tid; i < 16 * 64; i += 512) { cc[i * 2] = ap->in[I_CRE][(size_t)g * 1024 + i]; cc[i * 2 + 1] = ap->in[I_CIM][(size_t)g * 1024 + i]; }
    for (int i = tid; i < 128; i += 512) ((LAS unsigned*)(lds + L_KTAB))[i] = 0u;
    __syncthreads();
    for (int i = tid; i < 16 * 256; i += 512) { const int d = i >> 8, h = (i >> 4) & 15, hp = i & 15; float s = 0.f;
        for (int p = 0; p < 64; ++p) { const float lr = lamp[(d * 64 + p) * 2], li = lamp[(d * 64 + p) * 2 + 1], br = bbar[(p * 16 + hp) * 2], bi = bbar[(p * 16 + hp) * 2 + 1];
            const float tr = lr * br - li * bi, ti = lr * bi + li * br; s += cc[(h * 64 + p) * 2] * tr - cc[(h * 64 + p) * 2 + 1] * ti; }
        ((LAS bf16_t*)(lds + L_KTAB))[256 + i] = (bf16_t)(pk2(s, 0.f) & 0xffffu); }
    for (int i = tid; i < 128 * 256; i += 512) { const int n = i >> 8, k = i & 255, p = n & 63, j = k >> 4, hp = k & 15;
        const float lr = lamp[((15 - j) * 64 + p) * 2], li = lamp[((15 - j) * 64 + p) * 2 + 1], br = bbar[(p * 16 + hp) * 2], bi = bbar[(p * 16 + hp) * 2 + 1];
        const float v = n < 64 ? (lr * br - li * bi) : (lr * bi + li * br);
        *(LAS bf16_t*)(lds + L_MT + n * 528 + k * 2) = (bf16_t)(pk2(v, 0.f) & 0xffffu); }
    __syncthreads();
    const int r32 = lane & 31, hh = lane >> 5, c0 = wave * 32;
    const bf16_t* up = PROJ + ((size_t)b * SEQ + (size_t)(c0 + r32) * TCH) * DIN + 16 * g + 8 * hh;
    {
    bf16x8 ufr[16];
#pragma unroll
    for (int j = 0; j < 16; ++j) ufr[j] = *(const bf16x8*)(up + (size_t)j * DIN);
#pragma unroll
    for (int nb = 0; nb < 4; ++nb) {
        __builtin_amdgcn_sched_barrier(0);
        f32x16 acc;
#pragma unroll
        for (int e = 0; e < 16; ++e) acc[e] = 0.f;
#pragma unroll
        for (int j = 0; j < 16; ++j) { const bf16x8 bf = *(const LAS bf16x8*)(lds + L_MT + (32 * nb + r32) * 528 + (16 * j + 8 * hh) * 2);
            acc = __builtin_amdgcn_mfma_f32_32x32x16_bf16(ufr[j], bf, acc, 0, 0, 0); }
#pragma unroll
        for (int e = 0; e < 16; ++e) { const int ch = c0 + (e & 3) + 8 * (e >> 2) + 4 * hh; SS[(size_t)ch * 128 + 32 * nb + r32] = acc[e]; }
    }
    }
    __threadfence_block();
    __syncthreads();
    for (int i = tid; i < 256 * 128; i += 512) { const int n = i >> 7, q = i & 127, p = q & 63, ii = n >> 4, h = n & 15;
        const float lr = lamp[((ii + 1) * 64 + p) * 2], li = lamp[((ii + 1) * 64 + p) * 2 + 1], cr = cc[(h * 64 + p) * 2], ci = cc[(h * 64 + p) * 2 + 1];
        const float v = q < 64 ? (cr * lr - ci * li) : -(cr * li + ci * lr);
        *(LAS bf16_t*)(lds + L_MT + n * 272 + q * 2) = (bf16_t)(pk2(v, 0.f) & 0xffffu); }
    const int p = lane, sb = wave;
    const float ltr = lamp[(16 * 64 + p) * 2], lti = lamp[(16 * 64 + p) * 2 + 1];
    __syncthreads();
    float er[32], ei[32];
    { float xr = 0.f, xi = 0.f;
      const float* sp = SS + (size_t)(32 * sb) * 128 + p;
#pragma unroll
      for (int k = 0; k < 32; ++k) { er[k] = xr; ei[k] = xi; const float sr = sp[(size_t)k * 128], si = sp[(size_t)k * 128 + 64];
          const float nr = ltr * xr - lti * xi + sr, ni = ltr * xi + lti * xr + si; xr = nr; xi = ni; }
      LAS float* carry = (LAS float*)(lds + L_CARRY);
      carry[(sb * 64 + p) * 2] = xr; carry[(sb * 64 + p) * 2 + 1] = xi; }
    __syncthreads();
    { float l32r = ltr, l32i = lti;
#pragma unroll
      for (int s = 0; s < 5; ++s) { const float nr = l32r * l32r - l32i * l32i, ni = 2.0f * l32r * l32i; l32r = nr; l32i = ni; }
      const LAS float* carry = (const LAS float*)(lds + L_CARRY);
      float xr = 0.f, xi = 0.f;
      for (int s = 0; s < sb; ++s) { const float nr = l32r * xr - l32i * xi + carry[(s * 64 + p) * 2], ni = l32r * xi + l32i * xr + carry[(s * 64 + p) * 2 + 1]; xr = nr; xi = ni; }
      float pr = 1.f, pi = 0.f;
#pragma unroll
      for (int k = 0; k < 32; ++k) { const float vr = er[k] + pr * xr - pi * xi, vi = ei[k] + pr * xi + pi * xr;
          LAS bf16_t* xs = (LAS bf16_t*)(lds + L_XS + (32 * sb + k) * 272);
          const unsigned w = pk2(vr, vi); xs[p] = (bf16_t)(w & 0xffffu); xs[64 + p] = (bf16_t)(w >> 16);
          const float nr = pr * ltr - pi * lti, ni = pr * lti + pi * ltr; pr = nr; pi = ni; } }
    __syncthreads();
    const float* dsk = ap->in[I_DSKIP];
    __builtin_amdgcn_sched_barrier(0);
    bf16x8 ufr[16];
    { int l2 = lane_id(); asm volatile("" : "+v"(l2)); const int r2 = l2 & 31, h2 = (l2 >> 5) & 1;
      const bf16_t* up2 = PROJ + ((size_t)b * SEQ + (size_t)(c0 + r2) * TCH) * DIN + 16 * g + 8 * h2;
#pragma unroll
      for (int j = 0; j < 16; ++j) ufr[j] = *(const bf16x8*)(up2 + (size_t)j * DIN); }
#pragma unroll
    for (int half = 0; half < 2; ++half) {
        __builtin_amdgcn_sched_barrier(0);
        f32x16 acc[4];
#pragma unroll
        for (int q = 0; q < 4; ++q)
#pragma unroll
            for (int e = 0; e < 16; ++e) acc[q][e] = 0.f;
#pragma unroll
        for (int j = 0; j < 8 * half + 8; ++j)
#pragma unroll
            for (int q = 0; q < 4; ++q) { const int nb = 4 * half + q;
                if (j <= 2 * nb + 1) { int d1 = 2 * nb - j + (r32 >> 4) + 1; d1 = d1 < 0 ? 0 : d1;
                    const bf16x8 bf = *(const LAS bf16x8*)(lds + L_KTAB + d1 * 512 + (lane & 15) * 32 + 16 * hh);
                    acc[q] = __builtin_amdgcn_mfma_f32_32x32x16_bf16(ufr[j], bf, acc[q], 0, 0, 0); } }
#pragma unroll
        for (int ks = 0; ks < 8; ++ks) { const bf16x8 af = *(const LAS bf16x8*)(lds + L_XS + (c0 + r32) * 272 + (16 * ks + 8 * hh) * 2);
#pragma unroll
            for (int q = 0; q < 4; ++q) { const int nb = 4 * half + q;
                const bf16x8 bf = *(const LAS bf16x8*)(lds + L_MT + (32 * nb + r32) * 272 + (16 * ks + 8 * hh) * 2);
                acc[q] = __builtin_amdgcn_mfma_f32_32x32x16_bf16(af, bf, acc[q], 0, 0, 0); } }
#pragma unroll
        for (int q = 0; q < 4; ++q) { __builtin_amdgcn_sched_barrier(0); const int n = 32 * (4 * half + q) + r32, ii = n >> 4, ch = 16 * g + (n & 15); const float dk = dsk[ch];
#pragma unroll
            for (int e = 0; e < 16; ++e) { const int chunk = c0 + (e & 3) + 8 * (e >> 2) + 4 * hh; const size_t t = (size_t)b * SEQ + (size_t)chunk * TCH + ii;
                const float uu = bf1(PROJ[t * DIN + ch]); const float y = acc[q][e] + dk * uu;
                Z[t * DSSM + ch] = (bf16_t)(pk2(gelu_tanh(y), 0.f) & 0xffffu); } }
    }
    __syncthreads();
}
__device__ __forceinline__ void conv_heads(ArgsP ap, int wid0) {
    int tid_ = wid0 * 64 + lane_id(); asm volatile("" : "+v"(tid_));
    const int lane = tid_ & 63, wave = tid_ >> 6, G = gridDim.x;
    const bf16_t* PROJ = (const bf16_t*)(ap->ws + WS_PROJ);
    bf16_t* Y = (bf16_t*)(ap->ws + WS_Y);
    const int ch = 8 * lane;
    float w0[8], w1[8], w2[8], gg[8];
#pragma unroll
    for (int e = 0; e < 8; ++e) { w0[e] = ap->in[I_CONVW][ch + e]; w1[e] = ap->in[I_CONVW][512 + ch + e]; w2[e] = ap->in[I_CONVW][1024 + ch + e]; gg[e] = ap->in[I_GOCONV][ch + e]; }
    for (int run = blockIdx.x * 8 + wave; run < M / 16; run += G * 8) {
        const size_t t0 = (size_t)run * 16; const int pos = (int)(t0 % SEQ);
        float p2[8], p1[8];
#pragma unroll
        for (int e = 0; e < 8; ++e) { p2[e] = 0.f; p1[e] = 0.f; }
        if (pos != 0) {
            const u32x4 c2 = *(const u32x4*)(PROJ + (t0 - 2) * DIN + 1024 + ch), v2 = *(const u32x4*)(PROJ + (t0 - 2) * DIN + 1536 + ch);
            const u32x4 c1 = *(const u32x4*)(PROJ + (t0 - 1) * DIN + 1024 + ch), v1 = *(const u32x4*)(PROJ + (t0 - 1) * DIN + 1536 + ch);
#pragma unroll
            for (int k = 0; k < 4; ++k) { p2[2 * k] = bflo(c2[k]) * bflo(v2[k]); p2[2 * k + 1] = bfhi(c2[k]) * bfhi(v2[k]); p1[2 * k] = bflo(c1[k]) * bflo(v1[k]); p1[2 * k + 1] = bfhi(c1[k]) * bfhi(v1[k]); }
        }
        for (int r = 0; r < 16; ++r) {
            const size_t t = t0 + r;
            const u32x4 bgw = *(const u32x4*)(PROJ + t * DIN + 512 + ch), cgw = *(const u32x4*)(PROJ + t * DIN + 1024 + ch), vw = *(const u32x4*)(PROJ + t * DIN + 1536 + ch);
            float cv[8], yb[8]; float ss = 0.f;
#pragma unroll
            for (int k = 0; k < 4; ++k) { cv[2 * k] = bflo(cgw[k]) * bflo(vw[k]); cv[2 * k + 1] = bfhi(cgw[k]) * bfhi(vw[k]); }
#pragma unroll
            for (int k = 0; k < 4; ++k) {
                yb[2 * k] = bflo(bgw[k]) * (w0[2 * k] * p2[2 * k] + w1[2 * k] * p1[2 * k] + w2[2 * k] * cv[2 * k]);
                yb[2 * k + 1] = bfhi(bgw[k]) * (w0[2 * k + 1] * p2[2 * k + 1] + w1[2 * k + 1] * p1[2 * k + 1] + w2[2 * k + 1] * cv[2 * k + 1]); }
#pragma unroll
            for (int e = 0; e < 8; ++e) { ss += yb[e] * yb[e]; p2[e] = p1[e]; p1[e] = cv[e]; }
            ss += __shfl_xor(ss, 1); ss += __shfl_xor(ss, 2); ss += __shfl_xor(ss, 4);
            const float rs = rsqrtf(ss * (1.0f / 64.0f) + EPS);
            u32x4 w; w.x = pk2(yb[0] * rs * gg[0], yb[1] * rs * gg[1]); w.y = pk2(yb[2] * rs * gg[2], yb[3] * rs * gg[3]);
            w.z = pk2(yb[4] * rs * gg[4], yb[5] * rs * gg[5]); w.w = pk2(yb[6] * rs * gg[6], yb[7] * rs * gg[7]);
            *(u32x4*)(Y + t * D + 512 + ch) = w;
        }
    }
}

__device__ __forceinline__ void p6_rows(ArgsP ap, int wid0) {
    int tid_ = wid0 * 64 + lane_id(); asm volatile("" : "+v"(tid_));
    const int lane = tid_ & 63, wave = tid_ >> 6, G = gridDim.x;
    const float* mod = (const float*)(ap->ws + WS_MOD);
    const bf16_t* T = (const bf16_t*)(ap->ws + WS_T);
    bf16_t* H = (bf16_t*)(ap->ws + WS_H);
    for (int base = (blockIdx.x * 8 + wave) * 16; base < M; base += G * 8 * 16) {
        const int b = base / SEQ;
        f32x4 c1[4], c2[4], c3[4];
#pragma unroll
        for (int j = 0; j < 4; ++j) { const int col = 4 * lane + 256 * j;
            c1[j] = *(const f32x4*)(mod + b * NMOD + 2 * D + col) * *(const f32x4*)(ap->in[I_GPOSTMIX] + col);
            c2[j] = *(const f32x4*)(ap->in[I_GPREFFN] + col) * (*(const f32x4*)(mod + b * NMOD + 4 * D + col) + 1.0f);
            c3[j] = *(const f32x4*)(mod + b * NMOD + 3 * D + col); }
        for (int r = 0; r < 16; ++r) {
            const size_t row = base + r;
            const f32x4* xr = (const f32x4*)(ap->in[I_X] + row * D) + lane;
            const u32x2* tr = (const u32x2*)(T + row * D) + lane;
            f32x4 v[4], t[4]; float ss = 0.f;
#pragma unroll
            for (int j = 0; j < 4; ++j) { v[j] = xr[64 * j]; const u32x2 w = tr[64 * j]; t[j] = (f32x4){bflo(w.x), bfhi(w.x), bflo(w.y), bfhi(w.y)};
                ss += (t[j].x * t[j].x + t[j].y * t[j].y) + (t[j].z * t[j].z + t[j].w * t[j].w); }
            const float rs = rsqrtf(wave_sum(ss) * (1.0f / D) + EPS);
            float s2 = 0.f;
#pragma unroll
            for (int j = 0; j < 4; ++j) { v[j] = v[j] + c1[j] * (t[j] * rs); s2 += (v[j].x * v[j].x + v[j].y * v[j].y) + (v[j].z * v[j].z + v[j].w * v[j].w); }
            const float rs2 = rsqrtf(wave_sum(s2) * (1.0f / D) + EPS);
            f32x4* orow = (f32x4*)(ap->out + row * D) + lane;
            u32x2* o = (u32x2*)(H + row * D) + lane;
#pragma unroll
            for (int j = 0; j < 4; ++j) { orow[64 * j] = v[j]; const f32x4 h = v[j] * rs2 * c2[j] + c3[j]; u32x2 w; w.x = pk2(h.x, h.y); w.y = pk2(h.z, h.w); o[64 * j] = w; }
        }
    }
}
__device__ __forceinline__ void p8_fixup(ArgsP ap, int wid0) {
    const float* HT = (const float*)(ap->ws + WS_HT);
    const float* fcw = ap->in[I_FCW];
    bf16_t* Gm = (bf16_t*)(ap->ws + WS_G);
    const int nthr = gridDim.x * 512;
    for (int i = blockIdx.x * 512 + wid0 * 64 + lane_id(); i < (M / 256) * DFF; i += nthr) {
        const int pm = i / DFF, j = i % DFF;
        if ((pm & 15) == 0) continue;
        const int ia = (j >> 7) * 256 + (j & 127), iv = ia + 128;
        const float* hp = HT + ((size_t)(pm - 1) * 4) * NUP, *hc = HT + ((size_t)pm * 4) * NUP;
        const float am2 = hp[2 * NUP + ia], am1 = hp[3 * NUP + ia], a0 = hc[ia], a1 = hc[NUP + ia];
        const float vm2 = hp[2 * NUP + iv], vm1 = hp[3 * NUP + iv], v0 = hc[iv], v1 = hc[NUP + iv];
        const float wa0 = fcw[j], wa1 = fcw[NUP + j], wa2 = fcw[2 * NUP + j], wv0 = fcw[DFF + j], wv1 = fcw[NUP + DFF + j], wv2 = fcw[2 * NUP + DFF + j];
        const float ca0 = wa0 * am2 + wa1 * am1 + wa2 * a0, ca1 = wa0 * am1 + wa1 * a0 + wa2 * a1;
        const float cv0 = wv0 * vm2 + wv1 * vm1 + wv2 * v0, cv1 = wv0 * vm1 + wv1 * v0 + wv2 * v1;
        Gm[((size_t)pm * 256) * DFF + j] = (bf16_t)(pk2(siluf_(ca0) * cv0, 0.f) & 0xffffu);
        Gm[((size_t)pm * 256 + 1) * DFF + j] = (bf16_t)(pk2(siluf_(ca1) * cv1, 0.f) & 0xffffu);
    }
}
__device__ __forceinline__ void p10_rows(ArgsP ap, int wid0) {
    int tid_ = wid0 * 64 + lane_id(); asm volatile("" : "+v"(tid_));
    const int lane = tid_ & 63, wave = tid_ >> 6, G = gridDim.x;
    const float* mod = (const float*)(ap->ws + WS_MOD);
    const bf16_t* T = (const bf16_t*)(ap->ws + WS_T);
    for (int base = (blockIdx.x * 8 + wave) * 16; base < M; base += G * 8 * 16) {
        const int b = base / SEQ;
        f32x4 c1[4];
#pragma unroll
        for (int j = 0; j < 4; ++j) { const int col = 4 * lane + 256 * j; c1[j] = *(const f32x4*)(mod + b * NMOD + 5 * D + col) * *(const f32x4*)(ap->in[I_GPOSTFFN] + col); }
        for (int r = 0; r < 16; ++r) {
            const size_t row = base + r;
            f32x4* orow = (f32x4*)(ap->out + row * D) + lane;
            const u32x2* tr = (const u32x2*)(T + row * D) + lane;
            f32x4 v[4], t[4]; float ss = 0.f;
#pragma unroll
            for (int j = 0; j < 4; ++j) { v[j] = orow[64 * j]; const u32x2 w = tr[64 * j]; t[j] = (f32x4){bflo(w.x), bfhi(w.x), bflo(w.y), bfhi(w.y)};
                ss += (t[j].x * t[j].x + t[j].y * t[j].y) + (t[j].z * t[j].z + t[j].w * t[j].w); }
            const float rs = rsqrtf(wave_sum(ss) * (1.0f / D) + EPS);
#pragma unroll
            for (int j = 0; j < 4; ++j) orow[64 * j] = v[j] + c1[j] * (t[j] * rs);
        }
    }
}

__global__ void __launch_bounds__(512, 2) hymba_fwd(Args a_unused) {
    extern __shared__ __attribute__((aligned(16))) unsigned char shm[];
    LAS unsigned char* lds = (LAS unsigned char*)shm;
    cg::grid_group grid = cg::this_grid();
    const int wid0 = __builtin_amdgcn_readfirstlane(threadIdx.x >> 6);
    const int lo = opaque_args()->ph_lo, hi = opaque_args()->ph_hi, G = gridDim.x;
#ifndef PHASE_MASK
#define PHASE_MASK 0x7ff
#endif
#define IN(k) (((PHASE_MASK >> (k)) & 1) && lo <= (k) && (k) < hi)
#define SEAM(k) do { if (IN(k) && IN((k) + 1)) grid.sync(); } while (0)
    if (IN(0)) { p0_prologue(opaque_args(), lds, wid0); } SEAM(0);
    if (IN(1)) { p1_rows(opaque_args(), wid0); } SEAM(1);
    if (IN(2)) {
        ArgsP ap = opaque_args(); unsigned char* ws = ap->ws;
        pg8::Gemm g{(const bf16_t*)(ws + WS_H), (const bf16_t*)(ws + WS_WIN), M, DIN, D}; pg8::StaticOrder S; S.init(M, DIN, G, blockIdx.x);
        pg8::EpiBf16 E{(bf16_t*)(ws + WS_PROJ), DIN};
        pg8::gemm_phase<pg8::EpiBf16, true, true>(lds, g, S, E, wid0);
    } SEAM(2);
    if (IN(3)) {
        for (int u = blockIdx.x; u < NB * NGRP; u += G) ssm_unit(opaque_args(), lds, u, wid0);
        conv_heads(opaque_args(), wid0);
    } SEAM(3);
    if (IN(4)) {
        ArgsP ap = opaque_args(); unsigned char* ws = ap->ws;
        pg8::Gemm g{(const bf16_t*)(ws + WS_Z), (const bf16_t*)(ws + WS_GLU), M, DSSM, DSSM}; pg8::StaticOrder S; S.init(M, DSSM, G, blockIdx.x);
        pg8::EpiGlu E{(const bf16_t*)(ws + WS_Z), (bf16_t*)(ws + WS_Y), ap->in[I_GLUB], ap->in[I_GOSSM]};
        pg8::gemm_phase<pg8::EpiGlu, true, true>(lds, g, S, E, wid0);
    } SEAM(4);
    if (IN(5)) {
        ArgsP ap = opaque_args(); unsigned char* ws = ap->ws;
        pg8::Gemm g{(const bf16_t*)(ws + WS_Y), (const bf16_t*)(ws + WS_WOUT), M, D, D}; pg8::StaticOrder S; S.init(M, D, G, blockIdx.x);
        pg8::EpiBf16 E{(bf16_t*)(ws + WS_T), D};
        pg8::gemm_phase<pg8::EpiBf16, true, true>(lds, g, S, E, wid0);
    } SEAM(5);
    if (IN(6)) { p6_rows(opaque_args(), wid0); } SEAM(6);
    if (IN(7)) {
        ArgsP ap = opaque_args(); unsigned char* ws = ap->ws;
        pg8::Gemm g{(const bf16_t*)(ws + WS_H), (const bf16_t*)(ws + WS_WUP), M, NUP, D}; pg8::StaticOrder S; S.init(M, NUP, G, blockIdx.x);
        pg8::EpiUp E{(bf16_t*)(ws + WS_G), (float*)(ws + WS_HT), ap->in[I_FCW], (LAS float*)(lds + pg8::STAGE_BYTES)};
        pg8::gemm_phase<pg8::EpiUp, true, true>(lds, g, S, E, wid0);
    } SEAM(7);
    if (IN(8)) { p8_fixup(opaque_args(), wid0); } SEAM(8);
    if (IN(9)) {
        ArgsP ap = opaque_args(); unsigned char* ws = ap->ws;
        pg8::Gemm g{(const bf16_t*)(ws + WS_G), (const bf16_t*)(ws + WS_WDN), M, D, DFF}; pg8::StaticOrder S; S.init(M, D, G, blockIdx.x);
        pg8::EpiBf16 E{(bf16_t*)(ws + WS_T), D};
        pg8::gemm_phase<pg8::EpiBf16, true, true>(lds, g, S, E, wid0);
    } SEAM(9);
    if (IN(10)) { p10_rows(opaque_args(), wid0); }
#undef IN
#undef SEAM
}

extern "C" void kernel_launch(void* const* d_in, const int* in_sizes, int n_in, void* d_out, int out_size, void* d_ws, size_t ws_size, hipStream_t stream) {
    static int grid = 0;
    if (grid == 0) {
        if (n_in != 26 || in_sizes[0] != M * D || out_size != M * D || ws_size < WS_END) { fprintf(stderr, "kernel_launch: unexpected shapes (n_in %d, ws %zu)\n", n_in, ws_size); grid = -1; return; }
        int dev = 0, cus = 0, per_cu = 0;
        hipGetDevice(&dev); hipDeviceGetAttribute(&cus, hipDeviceAttributeMultiprocessorCount, dev);
        if (hipFuncSetAttribute((const void*)hymba_fwd, hipFuncAttributeMaxDynamicSharedMemorySize, LDS_BYTES) != hipSuccess) { fprintf(stderr, "kernel_launch: hipFuncSetAttribute failed\n"); }
        if (hipOccupancyMaxActiveBlocksPerMultiprocessor(&per_cu, (const void*)hymba_fwd, 512, LDS_BYTES) != hipSuccess || per_cu < 1) per_cu = 1;
        (void)hipGetLastError();
        grid = cus * per_cu;
        if (grid > 256) grid = 256;
    }
    if (grid < 0) return;
    Args a{};
    for (int i = 0; i < 26; ++i) a.in[i] = (const float*)d_in[i];
    a.out = (float*)d_out; a.ws = (unsigned char*)d_ws;
#if ONE_LAUNCH
    a.ph_lo = 0; a.ph_hi = NPHASE;
    void* args[] = {&a};
    hipError_t e = hipLaunchCooperativeKernel((const void*)hymba_fwd, dim3(grid), dim3(512), args, LDS_BYTES, stream);
    if (e != hipSuccess) fprintf(stderr, "cooperative launch failed: %s (grid %d)\n", hipGetErrorString(e), grid);
#else
    for (int ph = 0; ph < NPHASE; ++ph) { a.ph_lo = ph; a.ph_hi = ph + 1; hipLaunchKernelGGL(hymba_fwd, dim3(grid), dim3(512), LDS_BYTES, stream, a); }
#endif
}
```

```cpp
#include <hip/hip_runtime.h>
#include <hip/hip_cooperative_groups.h>
#include <cstdio>
#include <cstdint>
namespace cg = cooperative_groups;


#define LAS __attribute__((address_space(3)))
typedef unsigned short bf16_t;
typedef short bf16x8 __attribute__((ext_vector_type(8)));
typedef float f32x4 __attribute__((ext_vector_type(4)));
typedef float f32x16 __attribute__((ext_vector_type(16)));
typedef unsigned u32x4 __attribute__((ext_vector_type(4)));
typedef unsigned u32x2 __attribute__((ext_vector_type(2)));

constexpr int NB = 8, SEQ = 4096, D = 1024, M = NB * SEQ;
constexpr int DSSM = 512, DIN = 2048, DFF = 2816, NUP = 2 * DFF, NMOD = 6 * D;
constexpr int NGRP = 32, TCH = 16, NCH = SEQ / TCH;
constexpr float EPS = 1e-6f;

constexpr size_t MiB = 1u << 20;
constexpr size_t WS_MOD = 0, WS_WIN = 1 * MiB, WS_GLU = 5 * MiB, WS_WOUT = 6 * MiB, WS_WUP = 8 * MiB, WS_WDN = 19 * MiB,
                 WS_HT = 25 * MiB, WS_SS = 36 * MiB, WS_H = 68 * MiB, WS_PROJ = 132 * MiB, WS_Z = 260 * MiB, WS_Y = 292 * MiB,
                 WS_T = 356 * MiB, WS_G = 132 * MiB, WS_TAB = 420 * MiB, WS_XG = 426 * MiB, WS_END = 428 * MiB;
constexpr int TAB_KTAB = 0, TAB_M3 = 8704, TAB_M2 = 76288, TAB_LAMT = 145920, TAB_BYTES = 146432;

constexpr size_t WS_CNT = 512 * 1024 + 16384;
constexpr size_t CTL_ZERO = 16384 + 3 * 128 * 256;
constexpr size_t WS_BAR = 512 * 1024;
constexpr size_t WS_U = WS_PROJ;
constexpr int L_BARST = 152064, LDS_BYTES = 152080;

__device__ __forceinline__ unsigned pk2(float lo, float hi) { unsigned r; asm("v_cvt_pk_bf16_f32 %0, %1, %2" : "=v"(r) : "v"(lo), "v"(hi)); return r; }
__device__ __forceinline__ float bflo(unsigned w) { return __uint_as_float(w << 16); }
__device__ __forceinline__ float bfhi(unsigned w) { return __uint_as_float(w & 0xffff0000u); }
__device__ __forceinline__ float bf1(bf16_t h) { return __uint_as_float(((unsigned)h) << 16); }
__device__ __forceinline__ float wave_sum(float v) {
#pragma unroll
    for (int o = 1; o < 64; o <<= 1) v += __shfl_xor(v, o);
    return v;
}
__device__ __forceinline__ float sigmoidf_(float x) { return __builtin_amdgcn_rcpf(1.0f + __expf(-x)); }
__device__ __forceinline__ float siluf_(float x) { return x * __builtin_amdgcn_rcpf(1.0f + __expf(-x)); }
__device__ __forceinline__ float gelu_tanh(float y) {
    const float y2 = y * y;
    const float t = y * (-2.302208198f + -0.1029432397f * y2);
    return y * __builtin_amdgcn_rcpf(1.0f + __builtin_amdgcn_exp2f(t));
}
__device__ __forceinline__ int lane_id() { return (int)__builtin_amdgcn_mbcnt_hi(~0u, __builtin_amdgcn_mbcnt_lo(~0u, 0u)); }
#define LDS_WAIT() asm volatile("s_waitcnt lgkmcnt(0)" ::: "memory")

namespace pg8 {
constexpr int BM = 256, BK = 64, HALF = 128, HTB = HALF * BK * 2, STAGE_BYTES = 8 * HTB, NXCD = 8, WGM = 8;
__host__ __device__ __forceinline__ int lds_byte(int r, int c) { const int st = (r >> 4) * 2 + (c >> 5), rr = r & 15, cc = c & 31, ob = rr * 64 + cc * 2; return st * 1024 + (ob ^ (((ob >> 9) & 1) << 5)); }
__host__ __device__ __forceinline__ void stage_rc(int b, int& R, int& C) { const int st = b / 1024, sb = b % 1024, swz = sb ^ (((sb >> 9) & 1) << 5); R = (st >> 1) * 16 + swz / 64; C = (st & 1) * 32 + (swz % 64) / 2; }
__host__ __device__ __forceinline__ int perm32(int rho) { const int n = rho >> 4, i = rho & 15; return 8 * (i >> 2) + 4 * n + (i & 3); }
struct Unit { int pm, pn; };
struct Gemm { const bf16_t* A; const bf16_t* Bt; int M, N, K; };
struct StaticOrder {
    int nM, nN, nwg, G, c;
    __device__ void init(int M_, int N_, int G_, int c_) { nM = M_ / BM; nN = N_ / BM; nwg = nM * nN; G = G_; c = c_; }
    __device__ bool next(int i, Unit& u) const {
        const long L = (long)i * G + c; if (L >= nwg) return false;
        int wgid = (int)L; { const int q = nwg / NXCD, r = nwg % NXCD, xcd = wgid % NXCD, off = wgid / NXCD; wgid = (xcd < r ? xcd * (q + 1) : r * (q + 1) + (xcd - r) * q) + off; }
        const int nig = WGM * nN, gid = wgid / nig, fm = gid * WGM, gsz = (nM - fm) < WGM ? (nM - fm) : WGM;
        u.pm = fm + ((wgid % nig) % gsz); u.pn = (wgid % nig) / gsz; return true;
    }
};

template <class Epi, bool ALIGN_EPI, bool SP2>
__device__ __forceinline__ void gemm_phase(LAS unsigned char* lds, const Gemm g, const StaticOrder& S, const Epi& E, int wid0) {
    int tid_ = wid0 * 64 + lane_id(); asm volatile("" : "+v"(tid_));
    const int tid = tid_, wid = __builtin_amdgcn_readfirstlane(tid >> 6), lane = tid & 63, wr = wid >> 2, wc = wid & 3, fr = lane & 15, fq = lane >> 4;
    const int K = g.K, nt = K / BK;
    unsigned voffA[2], voffB[2];
#pragma unroll
    for (int i = 0; i < 2; ++i) { int R, C; stage_rc(tid * 16 + i * 8192, R, C); const int Rb = Epi::PERM ? ((R & ~31) + perm32(R & 31)) : R;
        const int Ra = Epi::PERM_A ? ((R & ~63) + 4 * (R & 15) + ((R >> 4) & 3)) : R;
        voffA[i] = (unsigned)(Ra * K + C) * 2u; voffB[i] = (unsigned)(Rb * K + C) * 2u; }
    const size_t kstep = (size_t)(BK * 2);
    const size_t hstep = (size_t)HALF * K * 2;
    const size_t tstep = 2 * hstep;
    const unsigned ldsw = (unsigned)wid * 1024u;
    const int aoff = lds_byte(wr * 64 + fr, fq * 8), boff = lds_byte(wc * 32 + fr, fq * 8);
#define PG8_SA(b, h) (((b) * 2 + (h)) * HTB)
#define PG8_SB(b, h) ((4 + (b) * 2 + (h)) * HTB)
#define PG8_STAGE(bufoff, gbase, voff) do { _Pragma("unroll") for (int _i = 0; _i < 2; ++_i) \
        __builtin_amdgcn_global_load_lds((const unsigned*)((const char*)(gbase) + (voff)[_i]), (LAS unsigned*)(lds + (bufoff) + ldsw + _i * 8192), 16, 0, 0); } while (0)
#define PG8_LDA(dst, b, h) do { _Pragma("unroll") for (int m = 0; m < 4; ++m) _Pragma("unroll") for (int k = 0; k < 2; ++k) dst[m][k] = *(const LAS bf16x8*)(lds + PG8_SA(b, h) + aoff + m * 2048 + k * 1024); } while (0)
#define PG8_LDB(dst, b, h) do { _Pragma("unroll") for (int n = 0; n < 2; ++n) _Pragma("unroll") for (int k = 0; k < 2; ++k) dst[n][k] = *(const LAS bf16x8*)(lds + PG8_SB(b, h) + boff + n * 2048 + k * 1024); } while (0)
#define PG8_MMA(ai, bj, At, Bt) do { __builtin_amdgcn_s_setprio(1); _Pragma("unroll") for (int m = 0; m < 4; ++m) _Pragma("unroll") for (int n = 0; n < 2; ++n) _Pragma("unroll") for (int k = 0; k < 2; ++k) \
        acc[ai][bj][m][n] = __builtin_amdgcn_mfma_f32_16x16x32_bf16(Bt[n][k], At[m][k], acc[ai][bj][m][n], 0, 0, 0); __builtin_amdgcn_s_setprio(0); } while (0)
#define PG8_WAIT_V(n) asm volatile("s_waitcnt vmcnt(" #n ")" ::: "memory")
#define PG8_WAIT_L(n) asm volatile("s_waitcnt lgkmcnt(" #n ")" ::: "memory")
#define PG8_BAR __builtin_amdgcn_s_barrier()
#define PG8_SCHED __builtin_amdgcn_sched_barrier(0)
    Unit cur, nxt; int ui = 0;
    if (!S.next(0, cur)) return;
    f32x4 acc[2][2][4][2];
#pragma unroll
    for (int a = 0; a < 2; ++a)
#pragma unroll
        for (int b = 0; b < 2; ++b)
#pragma unroll
            for (int m = 0; m < 4; ++m)
#pragma unroll
                for (int n = 0; n < 2; ++n) acc[a][b][m][n] = (f32x4){0.f, 0.f, 0.f, 0.f};
    bf16x8 At[4][2], B0[2][2], B1[2][2];
    const char* cA = (const char*)g.A + (size_t)cur.pm * tstep; const char* cB = (const char*)g.Bt + (size_t)cur.pn * tstep;
    E.begin(cur);
    if constexpr (SP2) {
        PG8_STAGE(PG8_SB(0, 0), cB, voffB); PG8_STAGE(PG8_SB(0, 1), cB + hstep, voffB); PG8_STAGE(PG8_SA(0, 0), cA, voffA); PG8_STAGE(PG8_SA(0, 1), cA + hstep, voffA);
        if (wr == 1) PG8_BAR;
        PG8_WAIT_V(2); PG8_BAR;
        PG8_STAGE(PG8_SB(1, 0), cB + kstep, voffB); PG8_STAGE(PG8_SA(1, 0), cA + kstep, voffA); PG8_STAGE(PG8_SB(1, 1), cB + hstep + kstep, voffB);
        PG8_WAIT_V(6); PG8_BAR;
    } else {
        PG8_STAGE(PG8_SB(0, 0), cB, voffB); PG8_STAGE(PG8_SA(0, 0), cA, voffA); PG8_STAGE(PG8_SB(0, 1), cB + hstep, voffB); PG8_STAGE(PG8_SA(0, 1), cA + hstep, voffA);
        if (wr == 1) PG8_BAR;
        PG8_WAIT_V(4); PG8_BAR;
        PG8_STAGE(PG8_SB(1, 0), cB + kstep, voffB); PG8_STAGE(PG8_SA(1, 0), cA + kstep, voffA); PG8_STAGE(PG8_SB(1, 1), cB + hstep + kstep, voffB);
        PG8_WAIT_V(6); PG8_BAR;
    }
    for (;;) {
        const bool has_next = S.next(ui + 1, nxt);
        const char* nA = has_next ? (const char*)g.A + (size_t)nxt.pm * tstep : cA; const char* nB = has_next ? (const char*)g.Bt + (size_t)nxt.pn * tstep : cB;
        for (int t = 0; t < nt; t += 2) {
            const bool last = (t == nt - 2);
            const char* a1 = cA + (size_t)(t + 1) * kstep;
            const char* a2 = last ? nA : cA + (size_t)(t + 2) * kstep; const char* b2 = last ? nB : cB + (size_t)(t + 2) * kstep;
            const char* a3 = a2 + kstep; const char* b3 = b2 + kstep;
            if constexpr (SP2) {
            PG8_LDB(B0, 0, 0); PG8_LDB(B1, 0, 1); PG8_SCHED; PG8_LDA(At, 0, 0); PG8_STAGE(PG8_SA(1, 1), a1 + hstep, voffA);
            PG8_WAIT_V(8); PG8_WAIT_L(0); PG8_BAR; PG8_MMA(0, 0, At, B0); PG8_MMA(0, 1, At, B1); PG8_BAR; PG8_SCHED;
            PG8_LDA(At, 0, 1); PG8_STAGE(PG8_SB(0, 0), b2, voffB); PG8_STAGE(PG8_SB(0, 1), b2 + hstep, voffB); PG8_STAGE(PG8_SA(0, 0), a2, voffA);
            PG8_WAIT_V(8); PG8_WAIT_L(0); PG8_BAR; PG8_MMA(1, 0, At, B0); PG8_MMA(1, 1, At, B1); PG8_BAR; PG8_SCHED;
            PG8_LDB(B0, 1, 0); PG8_LDB(B1, 1, 1); PG8_SCHED; PG8_LDA(At, 1, 0); PG8_STAGE(PG8_SA(0, 1), a2 + hstep, voffA);
            PG8_WAIT_V(8); PG8_WAIT_L(0); PG8_BAR; PG8_MMA(0, 0, At, B0); PG8_MMA(0, 1, At, B1); PG8_BAR; PG8_SCHED;
            PG8_LDA(At, 1, 1); PG8_STAGE(PG8_SB(1, 0), b3, voffB); PG8_STAGE(PG8_SB(1, 1), b3 + hstep, voffB); PG8_STAGE(PG8_SA(1, 0), a3, voffA);
            PG8_WAIT_V(8); PG8_WAIT_L(0); PG8_BAR; PG8_MMA(1, 0, At, B0); PG8_MMA(1, 1, At, B1); PG8_BAR; PG8_SCHED;
            } else {
            PG8_LDB(B0, 0, 0); PG8_SCHED; PG8_LDA(At, 0, 0); PG8_STAGE(PG8_SA(1, 1), a1 + hstep, voffA);
            PG8_WAIT_L(8); PG8_BAR; PG8_WAIT_L(0); PG8_MMA(0, 0, At, B0); PG8_BAR; PG8_SCHED;
            PG8_LDB(B1, 0, 1); PG8_STAGE(PG8_SB(0, 0), b2, voffB);
            PG8_BAR; PG8_WAIT_L(0); PG8_MMA(0, 1, At, B1); PG8_BAR;
            PG8_LDA(At, 0, 1); PG8_STAGE(PG8_SA(0, 0), a2, voffA);
            PG8_BAR; PG8_WAIT_L(0); PG8_MMA(1, 0, At, B0); PG8_BAR; PG8_SCHED;
            PG8_STAGE(PG8_SB(0, 1), b2 + hstep, voffB);
            PG8_WAIT_V(6); PG8_BAR; PG8_MMA(1, 1, At, B1); PG8_BAR;
            PG8_LDB(B0, 1, 0); PG8_SCHED; PG8_LDA(At, 1, 0); PG8_STAGE(PG8_SA(0, 1), a2 + hstep, voffA);
            PG8_WAIT_L(8); PG8_BAR; PG8_WAIT_L(0); PG8_MMA(0, 0, At, B0); PG8_BAR; PG8_SCHED;
            PG8_LDB(B1, 1, 1); PG8_STAGE(PG8_SB(1, 0), b3, voffB);
            PG8_BAR; PG8_WAIT_L(0); PG8_MMA(0, 1, At, B1); PG8_BAR;
            PG8_LDA(At, 1, 1); PG8_STAGE(PG8_SA(1, 0), a3, voffA);
            PG8_BAR; PG8_WAIT_L(0); PG8_MMA(1, 0, At, B0); PG8_BAR; PG8_SCHED;
            PG8_STAGE(PG8_SB(1, 1), b3 + hstep, voffB);
            PG8_WAIT_V(6); PG8_BAR; PG8_MMA(1, 1, At, B1); PG8_BAR;
            }
        }
        if constexpr (ALIGN_EPI) { if (wr == 0) PG8_BAR; }
        E(acc, cur, wr, wc, fr, fq, has_next ? nxt.pn : -1, ui);
        if (!has_next) break;
#pragma unroll
        for (int a = 0; a < 2; ++a)
#pragma unroll
            for (int b = 0; b < 2; ++b)
#pragma unroll
                for (int m = 0; m < 4; ++m)
#pragma unroll
                    for (int n = 0; n < 2; ++n) acc[a][b][m][n] = (f32x4){0.f, 0.f, 0.f, 0.f};
        cur = nxt; cA = nA; cB = nB; ++ui;
        if constexpr (ALIGN_EPI) { if (wr == 1) PG8_BAR; }
    }
    PG8_WAIT_V(0);
    if constexpr (!ALIGN_EPI) { if (wr == 0) PG8_BAR; }
    PG8_BAR;
#undef PG8_SA
#undef PG8_SB
#undef PG8_STAGE
#undef PG8_LDA
#undef PG8_LDB
#undef PG8_MMA
#undef PG8_WAIT_V
#undef PG8_WAIT_L
#undef PG8_SCHED
}

struct EpiGlu {
    static constexpr bool PERM = true, PERM_A = false;
    const bf16_t* Z; bf16_t* Y; const float* glu_b; const float* gss;
    __device__ __forceinline__ void begin(const Unit&) const {}
    __device__ __forceinline__ void operator()(const f32x4 (&acc)[2][2][4][2], const Unit& u, int wr, int wc, int fr, int fq, int, int) const {
        const int row0 = u.pm * BM + wr * 64 + fr, col0 = u.pn * BM + wc * 32 + 8 * fq;
#pragma unroll
        for (int bj = 0; bj < 2; ++bj) {
            const int cb = col0 + bj * HALF;
            const f32x4 b0 = *(const f32x4*)(glu_b + cb), b1 = *(const f32x4*)(glu_b + cb + 4);
            const f32x4 g0 = *(const f32x4*)(gss + cb), g1 = *(const f32x4*)(gss + cb + 4);
#pragma unroll
            for (int ai = 0; ai < 2; ++ai)
#pragma unroll
                for (int m = 0; m < 4; ++m) {
                    const size_t row = (size_t)(row0 + ai * HALF + m * 16);
                    const u32x4 zr = *(const u32x4*)(Z + row * DSSM + cb);
                    float z[8] = {bflo(zr.x), bfhi(zr.x), bflo(zr.y), bfhi(zr.y), bflo(zr.z), bfhi(zr.z), bflo(zr.w), bfhi(zr.w)};
                    float y[8]; float ss = 0.f;
#pragma unroll
                    for (int e = 0; e < 4; ++e) { y[e] = z[e] * sigmoidf_(acc[ai][bj][m][0][e] + b0[e]); y[4 + e] = z[4 + e] * sigmoidf_(acc[ai][bj][m][1][e] + b1[e]); }
#pragma unroll
                    for (int e = 0; e < 8; ++e) ss += y[e] * y[e];
                    ss += __shfl_xor(ss, 16);
                    const float rs = rsqrtf(ss * (1.0f / 16.0f) + EPS);
                    u32x4 w; w.x = pk2(y[0] * rs * g0[0], y[1] * rs * g0[1]); w.y = pk2(y[2] * rs * g0[2], y[3] * rs * g0[3]);
                    w.z = pk2(y[4] * rs * g1[0], y[5] * rs * g1[1]); w.w = pk2(y[6] * rs * g1[2], y[7] * rs * g1[3]);
                    *(u32x4*)(Y + row * D + cb) = w;
                }
        }
    }
};
__device__ __forceinline__ void fmac_shr1(float& o, float src, float w) { asm volatile("s_nop 1\n\tv_fmac_f32_dpp %0, %1, %2 row_shr:1 row_mask:0xf bank_mask:0xf bound_ctrl:1" : "+v"(o) : "v"(src), "v"(w)); }
__device__ __forceinline__ void fmac_shr1b(float& o, float src, float w) { asm volatile("v_fmac_f32_dpp %0, %1, %2 row_shr:1 row_mask:0xf bank_mask:0xf bound_ctrl:1" : "+v"(o) : "v"(src), "v"(w)); }
__device__ __forceinline__ void fmac_shr2(float& o, float src, float w) { asm volatile("v_fmac_f32_dpp %0, %1, %2 row_shr:2 row_mask:0xf bank_mask:0xf bound_ctrl:1" : "+v"(o) : "v"(src), "v"(w)); }
__device__ __forceinline__ void fmac_ror1(float& o, float src, float w) { asm volatile("v_fmac_f32_dpp %0, %1, %2 row_ror:1 row_mask:0xf bank_mask:0xf" : "+v"(o) : "v"(src), "v"(w)); }
__device__ __forceinline__ void fmac_ror2(float& o, float src, float w) { asm volatile("v_fmac_f32_dpp %0, %1, %2 row_ror:2 row_mask:0xf bank_mask:0xf" : "+v"(o) : "v"(src), "v"(w)); }
struct EpiUp {
    static constexpr bool PERM = true, PERM_A = false;
    bf16_t* G; float* HT; const float* fcw; LAS float* xb;
    __device__ __forceinline__ void begin(const Unit& u) const {
        const int tq = __builtin_amdgcn_readfirstlane(threadIdx.x >> 6) * 64 + lane_id();
        const int c0w = tq & 255, oc0 = (c0w < 128 ? 0 : DFF - 128) + u.pn * HALF + c0w;
        LAS float* wt = xb + 2048;
        wt[tq] = fcw[(size_t)(tq >> 8) * NUP + oc0]; if (tq < 256) wt[512 + tq] = fcw[2 * (size_t)NUP + oc0];
    }
    __device__ __forceinline__ void operator()(f32x4 (&acc)[2][2][4][2], const Unit& u, int wr, int wc, int fr_, int fq_, int next_pn, int ui) const {
        int lq = lane_id(); asm volatile("" : "+v"(lq));
        const int fr = lq & 15, fq = (lq >> 4) & 3;
        const int ct0 = wc * 32 + 8 * fq;
        LAS float* wt = xb + 2048 + (ui & 1) * 768;
        LAS float* wtn = xb + 2048 + ((ui + 1) & 1) * 768;
        const int tq = (wr * 4 + wc) * 64 + lq;
        const int c0w = tq & 255, oc0 = (c0w < 128 ? 0 : DFF - 128) + (next_pn < 0 ? 0 : next_pn) * HALF + c0w;
        const float wq0 = fcw[(size_t)(tq >> 8) * NUP + oc0];
        const float wq1 = (tq < 256) ? fcw[2 * (size_t)NUP + oc0] : 0.f;
        if (fr >= 14) {
#pragma unroll
            for (int ai = 0; ai < 2; ++ai)
#pragma unroll
                for (int bj = 0; bj < 2; ++bj)
#pragma unroll
                    for (int n = 0; n < 2; ++n) *(LAS f32x4*)(xb + ((ai * 2 + wr) * 2 + (fr - 14)) * 256 + bj * HALF + ct0 + 4 * n) = acc[ai][bj][3][n];
        }
        if (wr == 0 && fr < 2) {
            float* hp = HT + ((size_t)u.pm * 4 + fr) * NUP + (size_t)u.pn * 256 + ct0;
#pragma unroll
            for (int bj = 0; bj < 2; ++bj)
#pragma unroll
                for (int n = 0; n < 2; ++n) *(f32x4*)(hp + bj * HALF + 4 * n) = acc[0][bj][0][n];
        }
        if (wr == 1 && fr >= 14) {
            float* hp = HT + ((size_t)u.pm * 4 + 2 + (fr - 14)) * NUP + (size_t)u.pn * 256 + ct0;
#pragma unroll
            for (int bj = 0; bj < 2; ++bj)
#pragma unroll
                for (int n = 0; n < 2; ++n) *(f32x4*)(hp + bj * HALF + 4 * n) = acc[1][bj][3][n];
        }
        LDS_WAIT(); __builtin_amdgcn_s_barrier(); asm volatile("" ::: "memory");
#pragma unroll
        for (int bj = 0; bj < 2; ++bj)
#pragma unroll
            for (int n = 0; n < 2; ++n) {
                __builtin_amdgcn_sched_barrier(0);
                const int tc = bj * HALF + ct0 + 4 * n;
                const f32x4 w0 = *(const LAS f32x4*)(wt + tc), w1 = *(const LAS f32x4*)(wt + 256 + tc), w2 = *(const LAS f32x4*)(wt + 512 + tc);
                const int b0 = wr, b1 = 2 + wr;
                const f32x4 q14 = *(const LAS f32x4*)(xb + ((b0 > 0 ? b0 - 1 : 0) * 2 + 0) * 256 + tc), q15 = *(const LAS f32x4*)(xb + ((b0 > 0 ? b0 - 1 : 0) * 2 + 1) * 256 + tc);
                const f32x4 s14 = *(const LAS f32x4*)(xb + ((b1 - 1) * 2 + 0) * 256 + tc), s15 = *(const LAS f32x4*)(xb + ((b1 - 1) * 2 + 1) * 256 + tc);
#pragma unroll
                for (int e = 0; e < 4; ++e) {
                    const float w1m = (fr == 0) ? w1[e] : 0.f, w0m = (fr < 2) ? w0[e] : 0.f;
#pragma unroll
                    for (int ai = 0; ai < 2; ++ai) {
                        const float r14 = ai ? s14[e] : q14[e], r15 = ai ? s15[e] : q15[e];
                        float h = w1m * r15 + w0m * ((fr == 0) ? r14 : r15);
                        if (ai == 0 && b0 == 0) h = 0.f;
#pragma unroll
                        for (int m = 3; m >= 0; --m) {
                            const float cur = acc[ai][bj][m][n][e];
                            float v = w2[e] * cur;
                            fmac_shr1(v, cur, w1[e]); fmac_shr2(v, cur, w0[e]);
                            if (m > 0) { const float pb = acc[ai][bj][m - 1][n][e]; fmac_ror1(v, pb, w1m); fmac_ror2(v, pb, w0m); }
                            else v += h;
                            acc[ai][bj][m][n][e] = v;
                        }
                    }
                }
            }
        const int row0 = u.pm * BM + wr * 64 + fr, col0 = u.pn * HALF + ct0;
#pragma unroll
        for (int ai = 0; ai < 2; ++ai)
#pragma unroll
            for (int m = 0; m < 4; ++m) {
                __builtin_amdgcn_sched_barrier(0);
                const f32x4 a0 = acc[ai][0][m][0], a1 = acc[ai][0][m][1], v0 = acc[ai][1][m][0], v1 = acc[ai][1][m][1];
                u32x4 w; w.x = pk2(siluf_(a0[0]) * v0[0], siluf_(a0[1]) * v0[1]); w.y = pk2(siluf_(a0[2]) * v0[2], siluf_(a0[3]) * v0[3]);
                w.z = pk2(siluf_(a1[0]) * v1[0], siluf_(a1[1]) * v1[1]); w.w = pk2(siluf_(a1[2]) * v1[2], siluf_(a1[3]) * v1[3]);
                *(u32x4*)(G + (size_t)(row0 + ai * HALF + m * 16) * DFF + col0) = w;
            }
        wtn[tq] = wq0; if (tq < 256) wtn[512 + tq] = wq1;
    }
};

__device__ __forceinline__ void panel_rms(const f32x4 (&v)[2][2][4][2], const Unit& u, int wr, int wc, int fr, int fq, int tid, float* xg, unsigned* cnt, LAS float* tab) {
#pragma unroll
    for (int ai = 0; ai < 2; ++ai)
#pragma unroll
        for (int m = 0; m < 4; ++m) { float ss = 0.f;
#pragma unroll
            for (int bj = 0; bj < 2; ++bj)
#pragma unroll
                for (int n = 0; n < 2; ++n) { const f32x4 x = v[ai][bj][m][n]; ss += (x[0] * x[0] + x[1] * x[1]) + (x[2] * x[2] + x[3] * x[3]); }
            ss += __shfl_xor(ss, 16); ss += __shfl_xor(ss, 32);
            if (fq == 0) tab[(ai * HALF + wr * 64 + m * 16 + fr) * 4 + wc] = ss; }
    LDS_WAIT(); __builtin_amdgcn_s_barrier(); asm volatile("" ::: "memory");
    if (tid < 256) { const f32x4 p = *(const LAS f32x4*)(tab + tid * 4);
        __hip_atomic_store(xg + ((size_t)u.pm * 256 + tid) * 4 + u.pn, (p[0] + p[1]) + (p[2] + p[3]), __ATOMIC_RELAXED, __HIP_MEMORY_SCOPE_AGENT);
        asm volatile("s_waitcnt vmcnt(0)" ::: "memory");
        if ((tid & 63) == 0) __hip_atomic_fetch_add(cnt + 64 * u.pm, 1u, __ATOMIC_RELAXED, __HIP_MEMORY_SCOPE_AGENT); }
    if (tid < 64) { unsigned sp = 0;
        while ((unsigned)__builtin_amdgcn_readfirstlane(__hip_atomic_load(cnt + 64 * u.pm, __ATOMIC_RELAXED, __HIP_MEMORY_SCOPE_AGENT)) < 16u) { __builtin_amdgcn_s_sleep(1); if (++sp > (1u << 20)) break; }
        __builtin_amdgcn_fence(__ATOMIC_ACQUIRE, "agent"); asm volatile("s_waitcnt vmcnt(0)" ::: "memory"); }
    asm volatile("" ::: "memory"); __builtin_amdgcn_s_barrier(); asm volatile("" ::: "memory");
    if (tid < 256) { const float* q = xg + ((size_t)u.pm * 256 + tid) * 4; float s = 0.f;
#pragma unroll
        for (int k = 0; k < 4; ++k) s += __hip_atomic_load(q + k, __ATOMIC_RELAXED, __HIP_MEMORY_SCOPE_AGENT);
        tab[1024 + tid] = rsqrtf(s * (1.0f / D) + EPS); }
    LDS_WAIT(); __builtin_amdgcn_s_barrier(); asm volatile("" ::: "memory");
}
struct EpiDownNorm {
    static constexpr bool PERM = true, PERM_A = false;
    float* out; const float* mod; const float* gpost; float* xg; unsigned* cnt; LAS float* tab;
    __device__ __forceinline__ void begin(const Unit&) const {}
    __device__ __forceinline__ void operator()(const f32x4 (&acc)[2][2][4][2], const Unit& u, int wr, int wc, int fr_, int fq_, int, int) const {
        int lq = lane_id(); asm volatile("" : "+v"(lq));
        const int fr = lq & 15, fq = (lq >> 4) & 3, tid = (wr * 4 + wc) * 64 + lq;
        panel_rms(acc, u, wr, wc, fr, fq, tid, xg, cnt, tab);
        const int row0 = u.pm * BM + wr * 64 + fr, col0 = u.pn * BM + wc * 32 + 8 * fq, b = u.pm >> 4;
#pragma unroll
        for (int bj = 0; bj < 2; ++bj) {
            __builtin_amdgcn_sched_barrier(0);
            const int cb = col0 + bj * HALF;
            const f32x4 c0 = *(const f32x4*)(mod + b * NMOD + 5 * D + cb) * *(const f32x4*)(gpost + cb), c1 = *(const f32x4*)(mod + b * NMOD + 5 * D + cb + 4) * *(const f32x4*)(gpost + cb + 4);
#pragma unroll
            for (int ai = 0; ai < 2; ++ai)
#pragma unroll
                for (int m = 0; m < 4; ++m) { const int rl = ai * HALF + wr * 64 + m * 16 + fr; const float rs = tab[1024 + rl];
                    float* op = out + (size_t)(row0 + ai * HALF + m * 16) * D + cb;
                    const f32x4 x0 = *(const f32x4*)op, x1 = *(const f32x4*)(op + 4);
                    *(f32x4*)op = x0 + c0 * (acc[ai][bj][m][0] * rs); *(f32x4*)(op + 4) = x1 + c1 * (acc[ai][bj][m][1] * rs); }
        }
    }
};

struct EpiOutNorm {
    static constexpr bool PERM = true, PERM_A = false;
    const float* x; float* out; bf16_t* H; const float* mod; const float* gpostmix; const float* gpreffn; float* xg; unsigned* cnt; LAS float* tab;
    __device__ __forceinline__ void begin(const Unit&) const {}
    __device__ __forceinline__ void operator()(f32x4 (&acc)[2][2][4][2], const Unit& u, int wr, int wc, int fr_, int fq_, int, int) const {
        int lq = lane_id(); asm volatile("" : "+v"(lq));
        const int fr = lq & 15, fq = (lq >> 4) & 3, tid = (wr * 4 + wc) * 64 + lq;
        panel_rms(acc, u, wr, wc, fr, fq, tid, xg, cnt, tab);
        const int row0 = u.pm * BM + wr * 64 + fr, col0 = u.pn * BM + wc * 32 + 8 * fq, b = u.pm >> 4;
        const float* mb = mod + b * NMOD;
#pragma unroll
        for (int bj = 0; bj < 2; ++bj) {
            __builtin_amdgcn_sched_barrier(0);
            const int cb = col0 + bj * HALF;
            const f32x4 c0 = *(const f32x4*)(mb + 2 * D + cb) * *(const f32x4*)(gpostmix + cb), c1 = *(const f32x4*)(mb + 2 * D + cb + 4) * *(const f32x4*)(gpostmix + cb + 4);
#pragma unroll
            for (int ai = 0; ai < 2; ++ai)
#pragma unroll
                for (int m = 0; m < 4; ++m) { const int rl = ai * HALF + wr * 64 + m * 16 + fr; const float rs = tab[1024 + rl];
                    const size_t off = (size_t)(row0 + ai * HALF + m * 16) * D + cb;
                    const f32x4 x0 = *(const f32x4*)(x + off), x1 = *(const f32x4*)(x + off + 4);
                    const f32x4 y0 = x0 + c0 * (acc[ai][bj][m][0] * rs), y1 = x1 + c1 * (acc[ai][bj][m][1] * rs);
                    *(f32x4*)(out + off) = y0; *(f32x4*)(out + off + 4) = y1;
                    acc[ai][bj][m][0] = y0; acc[ai][bj][m][1] = y1; }
        }
        __builtin_amdgcn_sched_barrier(0);
        panel_rms(acc, u, wr, wc, fr, fq, tid, xg + (size_t)M * 4, cnt + 128 * 64, tab);
#pragma unroll
        for (int bj = 0; bj < 2; ++bj) {
            __builtin_amdgcn_sched_barrier(0);
            const int cb = col0 + bj * HALF;
            const f32x4 g0 = *(const f32x4*)(gpreffn + cb) * (*(const f32x4*)(mb + 4 * D + cb) + 1.0f), g1 = *(const f32x4*)(gpreffn + cb + 4) * (*(const f32x4*)(mb + 4 * D + cb + 4) + 1.0f);
            const f32x4 s0 = *(const f32x4*)(mb + 3 * D + cb), s1 = *(const f32x4*)(mb + 3 * D + cb + 4);
#pragma unroll
            for (int ai = 0; ai < 2; ++ai)
#pragma unroll
                for (int m = 0; m < 4; ++m) { const int rl = ai * HALF + wr * 64 + m * 16 + fr; const float rs = tab[1024 + rl];
                    const f32x4 h0 = acc[ai][bj][m][0] * rs * g0 + s0, h1 = acc[ai][bj][m][1] * rs * g1 + s1;
                    u32x4 w; w.x = pk2(h0[0], h0[1]); w.y = pk2(h0[2], h0[3]); w.z = pk2(h1[0], h1[1]); w.w = pk2(h1[2], h1[3]);
                    *(u32x4*)(H + (size_t)(row0 + ai * HALF + m * 16) * D + cb) = w; }
        }
    }
};

struct EpiIn {
    static constexpr bool PERM = true, PERM_A = true;
    bf16_t* Y; bf16_t* U; float* HTI; const float* convw; const float* gconv; LAS float* xb;
    __device__ __forceinline__ void begin(const Unit&) const {
        const int t = __builtin_amdgcn_readfirstlane(threadIdx.x >> 6) * 64 + lane_id();
        LAS float* wl = xb + 512 + 1024;
#pragma unroll
        for (int k = 0; k < 3; ++k) wl[k * 512 + t] = convw[k * 512 + t];
        wl[3 * 512 + t] = gconv[t];
    }
    __device__ __forceinline__ void operator()(f32x4 (&acc)[2][2][4][2], const Unit& u, int wr, int wc, int fr_, int fq_, int, int) const {
        int lq = lane_id(); asm volatile("" : "+v"(lq));
        const int fr = lq & 15, fq = (lq >> 4) & 3;
        const int ch4 = 16 * wc + 4 * fq, gch = 64 * u.pn + ch4;
        LAS float* tab = xb + 512;
        const LAS float* wl = xb + 512 + 1024;
#pragma unroll
        for (int ai = 0; ai < 2; ++ai)
#pragma unroll
            for (int m = 0; m < 4; ++m) acc[ai][0][m][0] = acc[ai][0][m][0] * acc[ai][0][m][1];
        if (fr == 15) {
#pragma unroll
            for (int ai = 0; ai < 2; ++ai) { *(LAS f32x4*)(xb + ((ai * 2 + wr) * 2 + 0) * 64 + ch4) = acc[ai][0][2][0]; *(LAS f32x4*)(xb + ((ai * 2 + wr) * 2 + 1) * 64 + ch4) = acc[ai][0][3][0]; }
        }
        if (wr == 0 && fr == 0) { float* hp = HTI + ((size_t)u.pm * 6) * 512 + gch;
            *(f32x4*)(hp) = acc[0][0][0][0]; *(f32x4*)(hp + 512) = acc[0][0][1][0]; *(f32x4*)(hp + 4 * 512) = acc[0][1][0][0]; *(f32x4*)(hp + 5 * 512) = acc[0][1][1][0]; }
        if (wr == 1 && fr == 15) { float* hp = HTI + ((size_t)u.pm * 6 + 2) * 512 + gch; *(f32x4*)(hp) = acc[1][0][2][0]; *(f32x4*)(hp + 512) = acc[1][0][3][0]; }
        LDS_WAIT(); __builtin_amdgcn_s_barrier(); asm volatile("" ::: "memory");
        const f32x4 w0 = *(const LAS f32x4*)(wl + gch), w1 = *(const LAS f32x4*)(wl + 512 + gch), w2 = *(const LAS f32x4*)(wl + 1024 + gch);
#pragma unroll
        for (int ai = 0; ai < 2; ++ai) {
            __builtin_amdgcn_sched_barrier(0);
            const int blk = ai * 2 + wr, pblk = blk > 0 ? blk - 1 : 0;
            const bool halo = (fr == 0) && (blk > 0);
            const f32x4 h2 = *(const LAS f32x4*)(xb + (pblk * 2 + 0) * 64 + ch4), h3 = *(const LAS f32x4*)(xb + (pblk * 2 + 1) * 64 + ch4);
#pragma unroll
            for (int e = 0; e < 4; ++e) {
                const float w1m = halo ? w1[e] : 0.f, w0m = halo ? w0[e] : 0.f;
                const float c0 = acc[ai][0][0][0][e], c1 = acc[ai][0][1][0][e], c2 = acc[ai][0][2][0][e], c3 = acc[ai][0][3][0][e];
                float o1 = w2[e] * c1 + w1[e] * c0 + w0m * h3[e];
                float o0 = w2[e] * c0 + w1m * h3[e] + w0m * h2[e];
                fmac_shr1(o1, c3, w0[e]); fmac_shr1b(o0, c3, w1[e]); fmac_shr1b(o0, c2, w0[e]);
                acc[ai][0][3][0][e] = acc[ai][1][3][0][e] * (w2[e] * c3 + w1[e] * c2 + w0[e] * c1);
                acc[ai][0][2][0][e] = acc[ai][1][2][0][e] * (w2[e] * c2 + w1[e] * c1 + w0[e] * c0);
                acc[ai][0][1][0][e] = acc[ai][1][1][0][e] * o1; acc[ai][0][0][0][e] = acc[ai][1][0][0][e] * o0;
            }
        }
#pragma unroll
        for (int ai = 0; ai < 2; ++ai)
#pragma unroll
            for (int m = 0; m < 4; ++m) { const f32x4 y = acc[ai][0][m][0]; float ss = (y[0] * y[0] + y[1] * y[1]) + (y[2] * y[2] + y[3] * y[3]);
                ss += __shfl_xor(ss, 16); ss += __shfl_xor(ss, 32);
                if (fq == 0) tab[(ai * HALF + wr * 64 + 4 * fr + m) * 4 + wc] = ss; }
        LDS_WAIT(); __builtin_amdgcn_s_barrier(); asm volatile("" ::: "memory");
        const f32x4 gg = *(const LAS f32x4*)(wl + 1536 + gch);
        const int row0 = u.pm * BM + wr * 64 + 4 * fr;
#pragma unroll
        for (int ai = 0; ai < 2; ++ai)
#pragma unroll
            for (int m = 0; m < 4; ++m) { const int rl = ai * HALF + wr * 64 + 4 * fr + m; const f32x4 pp = *(const LAS f32x4*)(tab + rl * 4);
                const float rs = rsqrtf(((pp[0] + pp[1]) + (pp[2] + pp[3])) * (1.0f / 64.0f) + EPS);
                const f32x4 y = acc[ai][0][m][0] * rs * gg, uu = acc[ai][1][m][1];
                const size_t row = (size_t)(row0 + ai * HALF + m);
                u32x2 wy; wy.x = pk2(y[0], y[1]); wy.y = pk2(y[2], y[3]); *(u32x2*)(Y + row * D + 512 + gch) = wy;
                u32x2 wu; wu.x = pk2(uu[0], uu[1]); wu.y = pk2(uu[2], uu[3]); *(u32x2*)(U + row * DSSM + gch) = wu; }
    }
};
#undef PG8_BAR
}

#define XB_TMO      128
#define XB_XCNT(j)  (256  + 64 * (j))
#define XB_XSUB(j)  (1280 + 64 * (j))
#define XB_XGEN(j)  (2304 + 64 * (j))
#define XB_TOP      3328
#define XB_TOPGEN   3392
#define XCD_BAR_WORDS 3456
#define XB_SPIN_CAP (1u << 18)

__device__ __forceinline__ unsigned xb_ld(unsigned* p)              { return __hip_atomic_load(p, __ATOMIC_RELAXED, __HIP_MEMORY_SCOPE_AGENT); }
__device__ __forceinline__ unsigned xb_add(unsigned* p, unsigned v) { return __hip_atomic_fetch_add(p, v, __ATOMIC_RELAXED, __HIP_MEMORY_SCOPE_AGENT); }
__device__ __forceinline__ unsigned xb_xcc_id() { return (unsigned)__builtin_amdgcn_s_getreg((3 << 11) | 20) & 0xFu; }
#define XB_SPIN(cond, bar) do { unsigned _sp = 0; while (cond) { __builtin_amdgcn_s_sleep(1); \
    if ((++_sp & 255u) == 0u) { if (xb_ld(&(bar)[XB_TMO])) break; if (_sp > XB_SPIN_CAP) { atomicAdd(&(bar)[XB_TMO], 1u); break; } } } } while (0)

struct XcdBarrier {
    unsigned* bar; unsigned x;
    volatile LAS unsigned* st;
};

__device__ __forceinline__ XcdBarrier xcd_barrier_post(unsigned* bar, volatile LAS unsigned* st) {
    XcdBarrier b; b.bar = bar; b.x = xb_xcc_id(); b.st = st;
    if (threadIdx.x == 0) (void)xb_add(&bar[XB_XCNT(b.x)], 1u);
    return b;
}
__device__ __forceinline__ void xcd_barrier_complete(unsigned* bar, unsigned x, unsigned& nloc, unsigned& nx) {
    const unsigned G = gridDim.x * gridDim.y * gridDim.z;
    unsigned sum, cnt, mine, sp = 0u;
    for (;;) {
        sum = 0u; cnt = 0u; mine = 0u;
#pragma unroll
        for (unsigned j = 0; j < 16; ++j) { const unsigned c = xb_ld(&bar[XB_XCNT(j)]); sum += c; cnt += (c > 0u) ? 1u : 0u; mine = (j == x) ? c : mine; }
        if (sum == G) break;
        __builtin_amdgcn_s_sleep(1);
        if ((++sp & 255u) == 0u) { if (xb_ld(&bar[XB_TMO])) break; if (sp > XB_SPIN_CAP) { atomicAdd(&bar[XB_TMO], 1u); break; } }
    }
    nloc = mine > 0u ? mine : 1u; nx = cnt > 0u ? cnt : 1u;
}

__device__ __forceinline__ void xcd_barrier(const XcdBarrier& b) {
    asm volatile("s_waitcnt vmcnt(0)" ::: "memory");
    __syncthreads();
    if (threadIdx.x == 0) {
        unsigned* bar = b.bar;
        __builtin_amdgcn_s_waitcnt(0);
        unsigned nloc = b.st[0], nx = b.st[1];
        if (nloc == 0u) { xcd_barrier_complete(bar, b.x, nloc, nx); b.st[0] = nloc; b.st[1] = nx; }
        const unsigned old = xb_add(&bar[XB_XSUB(b.x)], 1u);
        const unsigned gen = old / nloc;
        if (old + 1u == (gen + 1u) * nloc) {
            __builtin_amdgcn_fence(__ATOMIC_RELEASE, "agent");
            asm volatile("s_waitcnt vmcnt(0)" ::: "memory");
            const unsigned og = xb_add(&bar[XB_TOP], 1u);
            const unsigned tg = og / nx;
            if (og + 1u == (tg + 1u) * nx) xb_add(&bar[XB_TOPGEN], 1u);
            else XB_SPIN(xb_ld(&bar[XB_TOPGEN]) == tg, bar);
            __builtin_amdgcn_fence(__ATOMIC_ACQUIRE, "agent");
            xb_add(&bar[XB_XGEN(b.x)], 1u);
            asm volatile("s_waitcnt vmcnt(0)" ::: "memory");
        } else {
            XB_SPIN(xb_ld(&bar[XB_XGEN(b.x)]) == gen, bar);
            __builtin_amdgcn_fence(__ATOMIC_ACQUIRE, "agent");
            asm volatile("s_waitcnt vmcnt(0)" ::: "memory");
        }
    }
    __syncthreads();
}


struct Args { const float* in[26]; float* out; unsigned char* ws; int ph_lo, ph_hi; };
typedef const __attribute__((address_space(4))) Args* ArgsP;
__device__ __forceinline__ ArgsP opaque_args() { ArgsP p = (ArgsP)__builtin_amdgcn_kernarg_segment_ptr(); asm volatile("" : "+s"(p)); return p; }
enum { I_X = 0, I_C, I_WADA, I_BADA, I_GPREMIX, I_GPOSTMIX, I_WIN, I_LRE, I_LIM, I_LSTEP, I_BRE, I_BIM, I_CRE, I_CIM, I_DSKIP, I_GLUW, I_GLUB,
       I_GOSSM, I_CONVW, I_GOCONV, I_WOUT, I_GPREFFN, I_GPOSTFFN, I_WUP, I_FCW, I_WDN };

__device__ __forceinline__ int win_row(int col) {
    const int sec = col >> 9, within = col & 511, pn = within >> 6, ch = within & 63, wc = ch >> 4, fq = (ch >> 2) & 3, e = ch & 3;
    const int bj = (sec == 0 || sec == 1) ? 1 : 0, n = (sec == 0 || sec == 3) ? 1 : 0;
    return pn * 256 + bj * 128 + wc * 32 + fq * 8 + n * 4 + e;
}
template <bool WIN = false>
__device__ __forceinline__ void transpose_item(const float* W, int K, int N, bf16_t* WT, int drow, int k0, int n0, LAS float* scr, int lane) {
#pragma unroll
    for (int i = 0; i < 32; ++i) { const int kk = 2 * i + (lane >> 5); scr[kk * 33 + (lane & 31)] = W[(size_t)(k0 + kk) * N + n0 + (lane & 31)]; }
    LDS_WAIT();
    const int c = lane & 7;
#pragma unroll
    for (int j = 0; j < 4; ++j) { const int n = (lane >> 3) + 8 * j; const LAS float* s = scr + (8 * c) * 33 + n;
        u32x4 o; o.x = pk2(s[0 * 33], s[1 * 33]); o.y = pk2(s[2 * 33], s[3 * 33]); o.z = pk2(s[4 * 33], s[5 * 33]); o.w = pk2(s[6 * 33], s[7 * 33]);
        *(u32x4*)(WT + (size_t)(WIN ? win_row(n0 + n) : drow + n) * K + k0 + 8 * c) = o; }
    LDS_WAIT();
}

__device__ __forceinline__ void build_tables(ArgsP ap, LAS unsigned char* lds, int g, int tid) {
    LAS float* lamp = (LAS float*)(lds);
    LAS float* bbar = (LAS float*)(lds + 8704);
    LAS float* cc = (LAS float*)(lds + 8704 + 8192);
    unsigned char* img = ap->ws + WS_TAB + (size_t)g * TAB_BYTES;
    __syncthreads();
    const float step = expf(ap->in[I_LSTEP][g]);
    for (int i = tid; i < 17 * 64; i += 512) { const int d = i >> 6, p = i & 63;
        const float lr = fminf(ap->in[I_LRE][g * 64 + p], -1e-4f), li = ap->in[I_LIM][g * 64 + p];
        const float er = expf(lr * step * (float)d); float sn, cs; sincosf(li * step * (float)d, &sn, &cs);
        lamp[i * 2] = er * cs; lamp[i * 2 + 1] = er * sn;
        if (d == 16) { ((float*)(img + TAB_LAMT))[p * 2] = er * cs; ((float*)(img + TAB_LAMT))[p * 2 + 1] = er * sn; } }
    for (int i = tid; i < 64 * 16; i += 512) { const int p = i >> 4;
        const float lr = fminf(ap->in[I_LRE][g * 64 + p], -1e-4f), li = ap->in[I_LIM][g * 64 + p];
        const float ar = lr * step, ai = li * step;
        float sn, cs; sincosf(ai, &sn, &cs); const float em1 = expm1f(ar), ea = em1 + 1.0f; const float sh = sinf(0.5f * ai);
        const float nr = em1 * cs - 2.0f * sh * sh, ni = ea * sn;
        const float den = 1.0f / (lr * lr + li * li);
        const float qr = (nr * lr + ni * li) * den, qi = (ni * lr - nr * li) * den;
        const float br = ap->in[I_BRE][(size_t)g * 1024 + i], bi = ap->in[I_BIM][(size_t)g * 1024 + i];
        bbar[i * 2] = qr * br - qi * bi; bbar[i * 2 + 1] = qr * bi + qi * br; }
    for (int i = tid; i < 16 * 64; i += 512) { const int h = i >> 6, p = i & 63; cc[(p * 16 + h) * 2] = ap->in[I_CRE][(size_t)g * 1024 + i]; cc[(p * 16 + h) * 2 + 1] = ap->in[I_CIM][(size_t)g * 1024 + i]; }
    for (int i = tid; i < 128; i += 512) ((unsigned*)(img + TAB_KTAB))[i] = 0u;
    __syncthreads();
    if (tid < 256) { const int d = tid >> 4, h = tid & 15; float acc[16];
#pragma unroll
        for (int e = 0; e < 16; ++e) acc[e] = 0.f;
        for (int p = 0; p < 64; ++p) { const float lr = lamp[(d * 64 + p) * 2], li = lamp[(d * 64 + p) * 2 + 1], cr = cc[(p * 16 + h) * 2], ci = cc[(p * 16 + h) * 2 + 1];
            const float tr = cr * lr - ci * li, ti = cr * li + ci * lr;
#pragma unroll
            for (int q = 0; q < 8; ++q) { const f32x4 bb = *(const LAS f32x4*)(bbar + p * 32 + 4 * q); acc[2 * q] += tr * bb[0] - ti * bb[1]; acc[2 * q + 1] += tr * bb[2] - ti * bb[3]; } }
        if (d == 0) {
#pragma unroll
            for (int e = 0; e < 16; ++e) if (e == h) acc[e] += ap->in[I_DSKIP][16 * g + h]; }
        u32x4 o0, o1; o0.x = pk2(acc[0], acc[1]); o0.y = pk2(acc[2], acc[3]); o0.z = pk2(acc[4], acc[5]); o0.w = pk2(acc[6], acc[7]);
        o1.x = pk2(acc[8], acc[9]); o1.y = pk2(acc[10], acc[11]); o1.z = pk2(acc[12], acc[13]); o1.w = pk2(acc[14], acc[15]);
        u32x4* dst = (u32x4*)(img + TAB_KTAB + 512 + tid * 32); dst[0] = o0; dst[1] = o1; }
    for (int i = tid; i < 128 * 128; i += 512) { const int n = i >> 7, k = (i & 127) * 2, p = n & 63, j = k >> 4, hp = k & 15;
        const float lr = lamp[((15 - j) * 64 + p) * 2], li = lamp[((15 - j) * 64 + p) * 2 + 1];
        const f32x4 bb = *(const LAS f32x4*)(bbar + (p * 16 + hp) * 2);
        const float v0 = n < 64 ? (lr * bb[0] - li * bb[1]) : (lr * bb[1] + li * bb[0]), v1 = n < 64 ? (lr * bb[2] - li * bb[3]) : (lr * bb[3] + li * bb[2]);
        *(unsigned*)(img + TAB_M3 + n * 528 + k * 2) = pk2(v0, v1); }
    for (int i = tid; i < 256 * 64; i += 512) { const int n = i >> 6, q = (i & 63) * 2, p = q & 63, ii = n >> 4, h = n & 15;
        float v[2];
#pragma unroll
        for (int e = 0; e < 2; ++e) { const float lr = lamp[((ii + 1) * 64 + p + e) * 2], li = lamp[((ii + 1) * 64 + p + e) * 2 + 1], cr = cc[((p + e) * 16 + h) * 2], ci = cc[((p + e) * 16 + h) * 2 + 1];
            v[e] = q < 64 ? (cr * lr - ci * li) : -(cr * li + ci * lr); }
        *(unsigned*)(img + TAB_M2 + n * 272 + q * 2) = pk2(v[0], v[1]); }
    __syncthreads();
}
__device__ __forceinline__ void p0_prologue(ArgsP ap, LAS unsigned char* lds, int wid0) {
    int tid_ = wid0 * 64 + lane_id(); asm volatile("" : "+v"(tid_));
    const int tid = tid_, lane = tid & 63, wave = tid >> 6, G = gridDim.x;
    unsigned char* ws = ap->ws;
    if ((int)blockIdx.x < 96) {
        LAS float* cact = (LAS float*)(lds + 72 * 1024);
        LAS float* red = (LAS float*)(lds + 104 * 1024);
        const float* c = ap->in[I_C];
        for (int i = tid; i < NB * D; i += 512) cact[i] = siluf_(c[i]);
        __syncthreads();
        for (int item = blockIdx.x; item < 96; item += G) {
            const int col = item * 64 + lane, k0 = wave * 128;
            const float* wp = ap->in[I_WADA] + (size_t)k0 * NMOD + col;
            float acc[NB];
#pragma unroll
            for (int b = 0; b < NB; ++b) acc[b] = 0.f;
#pragma unroll 16
            for (int k = 0; k < 128; ++k) { const float w = wp[(size_t)k * NMOD];
#pragma unroll
                for (int b = 0; b < NB; ++b) acc[b] += cact[b * D + k0 + k] * w; }
#pragma unroll
            for (int b = 0; b < NB; ++b) red[(wave * NB + b) * 64 + lane] = acc[b];
            __syncthreads();
            { const int b = wave; float s = ap->in[I_BADA][col];
#pragma unroll
              for (int w = 0; w < 8; ++w) s += red[(w * NB + b) * 64 + lane];
              ((float*)(ws + WS_MOD))[b * NMOD + col] = s; }
            asm volatile("s_waitcnt vmcnt(0)" ::: "memory");
            __syncthreads();
            if (tid == 0) { __builtin_amdgcn_fence(__ATOMIC_RELEASE, "agent"); asm volatile("s_waitcnt vmcnt(0)" ::: "memory");
                __hip_atomic_fetch_add((unsigned*)(ws + WS_BAR) + 64, 1u, __ATOMIC_RELAXED, __HIP_MEMORY_SCOPE_AGENT); }
        }
    }
    for (int w = blockIdx.x; w < 128; w += G) if (w >= 96) build_tables(ap, lds, w - 96, tid);
    LAS float* scr = (LAS float*)(lds + wave * 8704);
    const bool split = (G >= 256);
    if (split && (int)blockIdx.x < 128) return;
    const int gw = (split ? (int)blockIdx.x - 128 : (int)blockIdx.x) * 8 + wave, NGW = (split ? G - 128 : G) * 8;
    constexpr int I1 = 16 * 64, I2 = 8 * 16, I3 = 16 * 32, I4 = 16 * 176, I5 = 44 * 32, NIT = I1 + I2 + I3 + I4 + I5;
    for (int it = gw; it < NIT; it += NGW) {
        int r = it;
        if (r < I1) { const int nb = r % 64, kb = r / 64; transpose_item<true>(ap->in[I_WIN], D, DIN, (bf16_t*)(ws + WS_WIN), 0, 64 * kb, 32 * nb, scr, lane); continue; } r -= I1;
        if (r < I2) { const int nb = r % 16, kb = r / 16; transpose_item(ap->in[I_GLUW], DSSM, DSSM, (bf16_t*)(ws + WS_GLU), 32 * nb, 64 * kb, 32 * nb, scr, lane); continue; } r -= I2;
        if (r < I3) { const int nb = r % 32, kb = r / 32; transpose_item(ap->in[I_WOUT], D, D, (bf16_t*)(ws + WS_WOUT), 32 * nb, 64 * kb, 32 * nb, scr, lane); continue; } r -= I3;
        if (r < I4) { const int nb = r % 176, kb = r / 176; const int n0 = 32 * nb; const int j = n0 < DFF ? n0 : n0 - DFF;
            const int drow = (j / 128) * 256 + (n0 < DFF ? 0 : 128) + (j % 128);
            transpose_item(ap->in[I_WUP], D, NUP, (bf16_t*)(ws + WS_WUP), drow, 64 * kb, n0, scr, lane); continue; } r -= I4;
        { const int nb = r % 32, kb = r / 32; transpose_item(ap->in[I_WDN], DFF, D, (bf16_t*)(ws + WS_WDN), 32 * nb, 64 * kb, 32 * nb, scr, lane); }
    }
}

__device__ __forceinline__ void p1_rows(ArgsP ap, int wid0, bool wait_mod) {
    int tid_ = wid0 * 64 + lane_id(); asm volatile("" : "+v"(tid_));
    const int lane = tid_ & 63, wave = tid_ >> 6, G = gridDim.x;
    const float* mod = (const float*)(ap->ws + WS_MOD);
    bf16_t* H = (bf16_t*)(ap->ws + WS_H);
    if (wait_mod) {
        if (tid_ == 0) { unsigned* cnt = (unsigned*)(ap->ws + WS_BAR) + 64; unsigned sp = 0;
            while (__hip_atomic_load(cnt, __ATOMIC_RELAXED, __HIP_MEMORY_SCOPE_AGENT) < 96u) { __builtin_amdgcn_s_sleep(2); if (++sp > (1u << 22)) break; }
            __builtin_amdgcn_fence(__ATOMIC_ACQUIRE, "agent"); asm volatile("s_waitcnt vmcnt(0)" ::: "memory"); }
        __syncthreads();
    }
    for (int base = (blockIdx.x * 8 + wave) * 16; base < M; base += G * 8 * 16) {
        const int b = base / SEQ;
        f32x4 gs[4], sh[4];
#pragma unroll
        for (int j = 0; j < 4; ++j) { const int col = 4 * lane + 256 * j;
            const f32x4 g = *(const f32x4*)(ap->in[I_GPREMIX] + col), sc = *(const f32x4*)(mod + b * NMOD + D + col);
            gs[j] = g * (sc + 1.0f); sh[j] = *(const f32x4*)(mod + b * NMOD + col); }
#pragma unroll 1
        for (int rb = 0; rb < 16; rb += 4) {
            f32x4 v[4][4];
#pragma unroll
            for (int r = 0; r < 4; ++r) { const f32x4* xr = (const f32x4*)(ap->in[I_X] + (size_t)(base + rb + r) * D) + lane;
#pragma unroll
                for (int j = 0; j < 4; ++j) v[r][j] = xr[64 * j]; }
#pragma unroll
            for (int r = 0; r < 4; ++r) { const size_t row = base + rb + r; float ss = 0.f;
#pragma unroll
                for (int j = 0; j < 4; ++j) ss += (v[r][j].x * v[r][j].x + v[r][j].y * v[r][j].y) + (v[r][j].z * v[r][j].z + v[r][j].w * v[r][j].w);
                const float rs = rsqrtf(wave_sum(ss) * (1.0f / D) + EPS);
                u32x2* o = (u32x2*)(H + row * D) + lane;
#pragma unroll
                for (int j = 0; j < 4; ++j) { const f32x4 h = v[r][j] * rs * gs[j] + sh[j]; u32x2 w; w.x = pk2(h.x, h.y); w.y = pk2(h.z, h.w); o[64 * j] = w; }
            }
        }
    }
}

constexpr int L_KTAB = 0, L_XS = 8704, L_MT = 78336, L_CARRY = 147968;
constexpr int L_BBAR = L_XS, L_CC = L_XS + 8192, L_LAMP = L_XS + 16384;
__device__ __forceinline__ void ssm_unit(ArgsP ap, LAS unsigned char* lds, int unit, int wid0) {
    int tid_ = wid0 * 64 + lane_id(); asm volatile("" : "+v"(tid_));
    const int tid = tid_, lane = tid & 63, wave = __builtin_amdgcn_readfirstlane(tid >> 6), b = unit >> 5, g = unit & 31;
    const bf16_t* UB = (const bf16_t*)(ap->ws + WS_U);
    bf16_t* Z = (bf16_t*)(ap->ws + WS_Z);
    float* SS = (float*)(ap->ws + WS_SS) + (size_t)unit * NCH * 128;
    const unsigned char* img = ap->ws + WS_TAB + (size_t)g * TAB_BYTES;
    __syncthreads();
    { u32x4 t0[2], t1[9];
#pragma unroll
      for (int k = 0; k < 2; ++k) { const int i = tid + 512 * k; if (i < 8704 / 16) t0[k] = ((const u32x4*)(img + TAB_KTAB))[i]; }
#pragma unroll
      for (int k = 0; k < 9; ++k) { const int i = tid + 512 * k; if (i < 67584 / 16) t1[k] = ((const u32x4*)(img + TAB_M3))[i]; }
#pragma unroll
      for (int k = 0; k < 2; ++k) { const int i = tid + 512 * k; if (i < 8704 / 16) ((LAS u32x4*)(lds + L_KTAB))[i] = t0[k]; }
#pragma unroll
      for (int k = 0; k < 9; ++k) { const int i = tid + 512 * k; if (i < 67584 / 16) ((LAS u32x4*)(lds + L_MT))[i] = t1[k]; } }
    __syncthreads();
    u32x4 m2r[9];
#pragma unroll
    for (int k = 0; k < 9; ++k) { const int i = tid + 512 * k; if (i < 69632 / 16) m2r[k] = ((const u32x4*)(img + TAB_M2))[i]; }
    const int r32 = lane & 31, hh = lane >> 5, c0 = wave * 32;
    const bf16_t* up = UB + ((size_t)b * SEQ + (size_t)(c0 + r32) * TCH) * DSSM + 16 * g + 8 * hh;
    {
    bf16x8 ufr[16];
#pragma unroll
    for (int j = 0; j < 16; ++j) ufr[j] = *(const bf16x8*)(up + (size_t)j * DSSM);
#pragma unroll
    for (int nb = 0; nb < 4; ++nb) {
        __builtin_amdgcn_sched_barrier(0);
        f32x16 acc;
#pragma unroll
        for (int e = 0; e < 16; ++e) acc[e] = 0.f;
#pragma unroll
        for (int j = 0; j < 16; ++j) { const bf16x8 bf = *(const LAS bf16x8*)(lds + L_MT + (32 * nb + r32) * 528 + (16 * j + 8 * hh) * 2);
            acc = __builtin_amdgcn_mfma_f32_32x32x16_bf16(ufr[j], bf, acc, 0, 0, 0); }
#pragma unroll
        for (int e = 0; e < 16; ++e) { const int ch = c0 + (e & 3) + 8 * (e >> 2) + 4 * hh; SS[(size_t)ch * 128 + 32 * nb + r32] = acc[e]; }
    }
    }
    __threadfence_block();
    __syncthreads();
#pragma unroll
    for (int k = 0; k < 9; ++k) { const int i = tid + 512 * k; if (i < 69632 / 16) ((LAS u32x4*)(lds + L_MT))[i] = m2r[k]; }
    const int p = lane, sb = wave;
    const float ltr = ((const float*)(img + TAB_LAMT))[p * 2], lti = ((const float*)(img + TAB_LAMT))[p * 2 + 1];
    __syncthreads();
    float er[32], ei[32];
    { float xr = 0.f, xi = 0.f;
      const float* sp = SS + (size_t)(32 * sb) * 128 + p;
#pragma unroll
      for (int k = 0; k < 32; ++k) { er[k] = sp[(size_t)k * 128]; ei[k] = sp[(size_t)k * 128 + 64]; }
#pragma unroll
      for (int k = 0; k < 32; ++k) { const float sr = er[k], si = ei[k]; er[k] = xr; ei[k] = xi;
          const float nr = ltr * xr - lti * xi + sr, ni = ltr * xi + lti * xr + si; xr = nr; xi = ni; }
      LAS float* carry = (LAS float*)(lds + L_CARRY);
      carry[(sb * 64 + p) * 2] = xr; carry[(sb * 64 + p) * 2 + 1] = xi; }
    __syncthreads();
    { float l32r = ltr, l32i = lti;
#pragma unroll
      for (int s = 0; s < 5; ++s) { const float nr = l32r * l32r - l32i * l32i, ni = 2.0f * l32r * l32i; l32r = nr; l32i = ni; }
      const LAS float* carry = (const LAS float*)(lds + L_CARRY);
      float xr = 0.f, xi = 0.f;
      for (int s = 0; s < sb; ++s) { const float nr = l32r * xr - l32i * xi + carry[(s * 64 + p) * 2], ni = l32r * xi + l32i * xr + carry[(s * 64 + p) * 2 + 1]; xr = nr; xi = ni; }
      float pr = 1.f, pi = 0.f;
#pragma unroll
      for (int k = 0; k < 32; ++k) { const float vr = er[k] + pr * xr - pi * xi, vi = ei[k] + pr * xi + pi * xr;
          LAS bf16_t* xs = (LAS bf16_t*)(lds + L_XS + (32 * sb + k) * 272);
          const unsigned w = pk2(vr, vi); xs[p] = (bf16_t)(w & 0xffffu); xs[64 + p] = (bf16_t)(w >> 16);
          const float nr = pr * ltr - pi * lti, ni = pr * lti + pi * ltr; pr = nr; pi = ni; } }
    __syncthreads();
    __builtin_amdgcn_sched_barrier(0);
    bf16x8 ufr[16];
    { int l2 = lane_id(); asm volatile("" : "+v"(l2)); const int r2 = l2 & 31, h2 = (l2 >> 5) & 1;
      const bf16_t* up2 = UB + ((size_t)b * SEQ + (size_t)(c0 + r2) * TCH) * DSSM + 16 * g + 8 * h2;
#pragma unroll
      for (int j = 0; j < 16; ++j) ufr[j] = *(const bf16x8*)(up2 + (size_t)j * DSSM); }
#pragma unroll
    for (int half = 0; half < 2; ++half) {
        __builtin_amdgcn_sched_barrier(0);
        f32x16 acc[4];
#pragma unroll
        for (int q = 0; q < 4; ++q)
#pragma unroll
            for (int e = 0; e < 16; ++e) acc[q][e] = 0.f;
#pragma unroll
        for (int j = 0; j < 8 * half + 8; ++j)
#pragma unroll
            for (int q = 0; q < 4; ++q) { const int nb = 4 * half + q;
                if (j <= 2 * nb + 1) { int d1 = 2 * nb - j + (r32 >> 4) + 1; d1 = d1 < 0 ? 0 : d1;
                    const bf16x8 bf = *(const LAS bf16x8*)(lds + L_KTAB + d1 * 512 + (lane & 15) * 32 + 16 * hh);
                    acc[q] = __builtin_amdgcn_mfma_f32_32x32x16_bf16(ufr[j], bf, acc[q], 0, 0, 0); } }
#pragma unroll
        for (int ks = 0; ks < 8; ++ks) { const bf16x8 af = *(const LAS bf16x8*)(lds + L_XS + (c0 + r32) * 272 + (16 * ks + 8 * hh) * 2);
#pragma unroll
            for (int q = 0; q < 4; ++q) { const int nb = 4 * half + q;
                const bf16x8 bf = *(const LAS bf16x8*)(lds + L_MT + (32 * nb + r32) * 272 + (16 * ks + 8 * hh) * 2);
                acc[q] = __builtin_amdgcn_mfma_f32_32x32x16_bf16(af, bf, acc[q], 0, 0, 0); } }
#pragma unroll
        for (int q = 0; q < 4; ++q) { __builtin_amdgcn_sched_barrier(0); const int n = 32 * (4 * half + q) + r32, ii = n >> 4, ch = 16 * g + (n & 15);
#pragma unroll
            for (int e = 0; e < 16; ++e) { const int chunk = c0 + (e & 3) + 8 * (e >> 2) + 4 * hh; const size_t t = (size_t)b * SEQ + (size_t)chunk * TCH + ii;
                Z[t * DSSM + ch] = (bf16_t)(pk2(gelu_tanh(acc[q][e]), 0.f) & 0xffffu); } }
    }
    __syncthreads();
}
__device__ __forceinline__ void fix_conv_rows(ArgsP ap, int wid0) {
    const int lane = lane_id(), G = gridDim.x;
    const float* HTI = (const float*)(ap->ws + WS_HT);
    bf16_t* Y = (bf16_t*)(ap->ws + WS_Y);
    const int ch = 8 * lane;
    for (int it = blockIdx.x * 8 + wid0; it < (M / 256) * 2; it += G * 8) {
        const int pm = it >> 1, r = it & 1;
        if ((pm & 15) == 0) continue;
        const float* hp = HTI + ((size_t)(pm - 1) * 6) * 512 + ch, *hc = HTI + ((size_t)pm * 6) * 512 + ch;
        float yb[8]; float ss = 0.f;
#pragma unroll
        for (int e = 0; e < 8; ++e) {
            const float pm2 = hp[2 * 512 + e], pm1 = hp[3 * 512 + e], p0 = hc[e], p1 = hc[512 + e];
            const float w0 = ap->in[I_CONVW][ch + e], w1 = ap->in[I_CONVW][512 + ch + e], w2 = ap->in[I_CONVW][1024 + ch + e];
            const float cv = r == 0 ? (w0 * pm2 + w1 * pm1 + w2 * p0) : (w0 * pm1 + w1 * p0 + w2 * p1);
            yb[e] = hc[(4 + r) * 512 + e] * cv; ss += yb[e] * yb[e]; }
        ss += __shfl_xor(ss, 1); ss += __shfl_xor(ss, 2); ss += __shfl_xor(ss, 4);
        const float rs = rsqrtf(ss * (1.0f / 64.0f) + EPS);
        u32x4 w;
        w.x = pk2(yb[0] * rs * ap->in[I_GOCONV][ch + 0], yb[1] * rs * ap->in[I_GOCONV][ch + 1]); w.y = pk2(yb[2] * rs * ap->in[I_GOCONV][ch + 2], yb[3] * rs * ap->in[I_GOCONV][ch + 3]);
        w.z = pk2(yb[4] * rs * ap->in[I_GOCONV][ch + 4], yb[5] * rs * ap->in[I_GOCONV][ch + 5]); w.w = pk2(yb[6] * rs * ap->in[I_GOCONV][ch + 6], yb[7] * rs * ap->in[I_GOCONV][ch + 7]);
        *(u32x4*)(Y + ((size_t)pm * 256 + r) * D + 512 + ch) = w;
    }
}
__device__ __forceinline__ void fix_panel(ArgsP ap, int pm, int tid) {
    if ((pm & 15) == 0) return;
    const float* HT = (const float*)(ap->ws + WS_HT);
    const float* fcw = ap->in[I_FCW];
    bf16_t* Gm = (bf16_t*)(ap->ws + WS_G);
    const float* hp = HT + ((size_t)(pm - 1) * 4) * NUP, *hc = HT + ((size_t)pm * 4) * NUP;
    for (int j = tid; j < DFF; j += 512) {
        const int ia = (j >> 7) * 256 + (j & 127), iv = ia + 128;
        const float am2 = hp[2 * NUP + ia], am1 = hp[3 * NUP + ia], a0 = hc[ia], a1 = hc[NUP + ia];
        const float vm2 = hp[2 * NUP + iv], vm1 = hp[3 * NUP + iv], v0 = hc[iv], v1 = hc[NUP + iv];
        const float wa0 = fcw[j], wa1 = fcw[NUP + j], wa2 = fcw[2 * NUP + j], wv0 = fcw[DFF + j], wv1 = fcw[NUP + DFF + j], wv2 = fcw[2 * NUP + DFF + j];
        const float ca0 = wa0 * am2 + wa1 * am1 + wa2 * a0, ca1 = wa0 * am1 + wa1 * a0 + wa2 * a1;
        const float cv0 = wv0 * vm2 + wv1 * vm1 + wv2 * v0, cv1 = wv0 * vm1 + wv1 * v0 + wv2 * v1;
        Gm[((size_t)pm * 256) * DFF + j] = (bf16_t)(pk2(siluf_(ca0) * cv0, 0.f) & 0xffffu);
        Gm[((size_t)pm * 256 + 1) * DFF + j] = (bf16_t)(pk2(siluf_(ca1) * cv1, 0.f) & 0xffffu);
    }
}
__global__ void __launch_bounds__(512, 2) hymba_fwd(Args a_unused) {
    extern __shared__ __attribute__((aligned(16))) unsigned char shm[];
    LAS unsigned char* lds = (LAS unsigned char*)shm;
    cg::grid_group grid = cg::this_grid();
    const int wid0 = __builtin_amdgcn_readfirstlane(threadIdx.x >> 6);
    if (threadIdx.x < 4) ((LAS unsigned*)(lds + L_BARST))[threadIdx.x] = 0u;
    __syncthreads();
    XcdBarrier xbar = xcd_barrier_post((unsigned*)(opaque_args()->ws + WS_BAR), (volatile LAS unsigned*)(lds + L_BARST));
    if (opaque_args()->ph_lo < 0) grid.sync();
    const int G = gridDim.x;
#define SEAM() xcd_barrier(xbar)
    p0_prologue(opaque_args(), lds, wid0);
    p1_rows(opaque_args(), wid0, true);
    SEAM();
    {
        ArgsP ap = opaque_args(); unsigned char* ws = ap->ws;
        pg8::Gemm g{(const bf16_t*)(ws + WS_H), (const bf16_t*)(ws + WS_WIN), M, DIN, D}; pg8::StaticOrder S; S.init(M, DIN, G, blockIdx.x);
        pg8::EpiIn E{(bf16_t*)(ws + WS_Y), (bf16_t*)(ws + WS_U), (float*)(ws + WS_HT), ap->in[I_CONVW], ap->in[I_GOCONV], (LAS float*)(lds + pg8::STAGE_BYTES)};
        pg8::gemm_phase<pg8::EpiIn, true, true>(lds, g, S, E, wid0);
    }
    SEAM();
    fix_conv_rows(opaque_args(), wid0);
    for (int u = blockIdx.x; u < NB * NGRP; u += G) ssm_unit(opaque_args(), lds, u, wid0);
    SEAM();
    {
        ArgsP ap = opaque_args(); unsigned char* ws = ap->ws;
        pg8::Gemm g{(const bf16_t*)(ws + WS_Z), (const bf16_t*)(ws + WS_GLU), M, DSSM, DSSM}; pg8::StaticOrder S; S.init(M, DSSM, G, blockIdx.x);
        pg8::EpiGlu E{(const bf16_t*)(ws + WS_Z), (bf16_t*)(ws + WS_Y), ap->in[I_GLUB], ap->in[I_GOSSM]};
        pg8::gemm_phase<pg8::EpiGlu, true, true>(lds, g, S, E, wid0);
    }
    SEAM();
    {
        ArgsP ap = opaque_args(); unsigned char* ws = ap->ws;
        pg8::Gemm g{(const bf16_t*)(ws + WS_Y), (const bf16_t*)(ws + WS_WOUT), M, D, D}; pg8::StaticOrder S; S.init(M, D, G, blockIdx.x);
        pg8::EpiOutNorm E{ap->in[I_X], ap->out, (bf16_t*)(ws + WS_H), (const float*)(ws + WS_MOD), ap->in[I_GPOSTMIX], ap->in[I_GPREFFN],
                          (float*)(ws + WS_XG) + (size_t)M * 4, (unsigned*)(ws + WS_CNT) + 128 * 64, (LAS float*)(lds + pg8::STAGE_BYTES)};
        pg8::gemm_phase<pg8::EpiOutNorm, true, true>(lds, g, S, E, wid0);
    }
    SEAM();
    {
        ArgsP ap = opaque_args(); unsigned char* ws = ap->ws;
        pg8::Gemm g{(const bf16_t*)(ws + WS_H), (const bf16_t*)(ws + WS_WUP), M, NUP, D}; pg8::StaticOrder S; S.init(M, NUP, G, blockIdx.x);
        pg8::EpiUp E{(bf16_t*)(ws + WS_G), (float*)(ws + WS_HT), ap->in[I_FCW], (LAS float*)(lds + pg8::STAGE_BYTES)};
        pg8::gemm_phase<pg8::EpiUp, true, true>(lds, g, S, E, wid0);
    }
    SEAM();
    {
        ArgsP ap = opaque_args(); unsigned char* ws = ap->ws;
        pg8::Gemm g{(const bf16_t*)(ws + WS_G), (const bf16_t*)(ws + WS_WDN), M, D, DFF}; pg8::StaticOrder S; S.init(M, D, G, blockIdx.x);
        { pg8::Unit fu; const int ftid = wid0 * 64 + lane_id(); for (int i = 0; S.next(i, fu); ++i) fix_panel(ap, fu.pm, ftid);
          asm volatile("s_waitcnt vmcnt(0)" ::: "memory"); __syncthreads(); }
        pg8::EpiDownNorm E{ap->out, (const float*)(ws + WS_MOD), ap->in[I_GPOSTFFN], (float*)(ws + WS_XG), (unsigned*)(ws + WS_CNT), (LAS float*)(lds + pg8::STAGE_BYTES)};
        pg8::gemm_phase<pg8::EpiDownNorm, true, true>(lds, g, S, E, wid0);
    }
#undef SEAM
}

extern "C" void kernel_launch(void* const* d_in, const int* in_sizes, int n_in, void* d_out, int out_size, void* d_ws, size_t ws_size, hipStream_t stream) {
    static int grid = 0;
    if (grid == 0) {
        if (n_in != 26 || in_sizes[0] != M * D || out_size != M * D || ws_size < WS_END) { fprintf(stderr, "kernel_launch: unexpected shapes (n_in %d, ws %zu)\n", n_in, ws_size); grid = -1; return; }
        int dev = 0, cus = 0, per_cu = 0;
        hipGetDevice(&dev); hipDeviceGetAttribute(&cus, hipDeviceAttributeMultiprocessorCount, dev);
        if (hipFuncSetAttribute((const void*)hymba_fwd, hipFuncAttributeMaxDynamicSharedMemorySize, LDS_BYTES) != hipSuccess) { fprintf(stderr, "kernel_launch: hipFuncSetAttribute failed\n"); }
        if (hipOccupancyMaxActiveBlocksPerMultiprocessor(&per_cu, (const void*)hymba_fwd, 512, LDS_BYTES) != hipSuccess || per_cu < 1) per_cu = 1;
        (void)hipGetLastError();
        grid = cus * per_cu;
        if (grid > 256) grid = 256;
    }
    if (grid < 0) return;
    Args a{};
    for (int i = 0; i < 26; ++i) a.in[i] = (const float*)d_in[i];
    a.out = (float*)d_out; a.ws = (unsigned char*)d_ws;
    (void)hipMemsetAsync((char*)d_ws + WS_BAR, 0, CTL_ZERO, stream);
    a.ph_lo = 0; a.ph_hi = 0;
    void* args[] = {&a};
    hipError_t e = hipLaunchCooperativeKernel((const void*)hymba_fwd, dim3(grid), dim3(512), args, LDS_BYTES, stream);
    if (e != hipSuccess) fprintf(stderr, "cooperative launch failed: %s (grid %d)\n", hipGetErrorString(e), grid);

}
```

```cpp
#include <hip/hip_runtime.h>
#include <hip/hip_cooperative_groups.h>
#include <cstdio>
#include <cstdint>
namespace cg = cooperative_groups;


#define LAS __attribute__((address_space(3)))
typedef unsigned short bf16_t;
typedef short bf16x8 __attribute__((ext_vector_type(8)));
typedef float f32x4 __attribute__((ext_vector_type(4)));
typedef float f32x16 __attribute__((ext_vector_type(16)));
typedef unsigned u32x4 __attribute__((ext_vector_type(4)));
typedef unsigned u32x2 __attribute__((ext_vector_type(2)));

constexpr int NB = 8, SEQ = 4096, D = 1024, M = NB * SEQ;
constexpr int DSSM = 512, DIN = 2048, DFF = 2816, NUP = 2 * DFF, NMOD = 6 * D;
constexpr int NGRP = 32, TCH = 16, NCH = SEQ / TCH;
constexpr float EPS = 1e-6f;

constexpr size_t MiB = 1u << 20;
constexpr size_t WS_MOD = 0, WS_WIN = 1 * MiB, WS_GLU = 5 * MiB, WS_WOUT = 6 * MiB, WS_WUP = 8 * MiB, WS_WDN = 19 * MiB,
                 WS_HT = 25 * MiB, WS_SS = 36 * MiB, WS_H = 68 * MiB, WS_PROJ = 132 * MiB, WS_Z = 260 * MiB, WS_Y = 292 * MiB,
                 WS_T = 356 * MiB, WS_G = 132 * MiB, WS_TAB = 420 * MiB, WS_XG = 426 * MiB, WS_END = 428 * MiB;
constexpr int TAB_KTAB = 0, TAB_M3 = 8704, TAB_M2 = 76288, TAB_LAMT = 145920, TAB_BYTES = 146432;

constexpr size_t WS_CNT = 512 * 1024 + 16384;
constexpr size_t CTL_ZERO = 16384 + 3 * 128 * 256;
constexpr size_t WS_BAR = 512 * 1024;
constexpr size_t WS_U = WS_PROJ;
constexpr int L_BARST = 152064, LDS_BYTES = 152080;

__device__ __forceinline__ unsigned pk2(float lo, float hi) { unsigned r; asm("v_cvt_pk_bf16_f32 %0, %1, %2" : "=v"(r) : "v"(lo), "v"(hi)); return r; }
__device__ __forceinline__ float bflo(unsigned w) { return __uint_as_float(w << 16); }
__device__ __forceinline__ float bfhi(unsigned w) { return __uint_as_float(w & 0xffff0000u); }
__device__ __forceinline__ float bf1(bf16_t h) { return __uint_as_float(((unsigned)h) << 16); }
__device__ __forceinline__ float wave_sum(float v) {
#pragma unroll
    for (int o = 1; o < 64; o <<= 1) v += __shfl_xor(v, o);
    return v;
}
__device__ __forceinline__ float sigmoidf_(float x) { return __builtin_amdgcn_rcpf(1.0f + __expf(-x)); }
__device__ __forceinline__ float siluf_(float x) { return x * __builtin_amdgcn_rcpf(1.0f + __expf(-x)); }
__device__ __forceinline__ float gelu_tanh(float y) {
    const float y2 = y * y;
    const float t = y * (-2.302208198f + -0.1029432397f * y2);
    return y * __builtin_amdgcn_rcpf(1.0f + __builtin_amdgcn_exp2f(t));
}
__device__ __forceinline__ int lane_id() { return (int)__builtin_amdgcn_mbcnt_hi(~0u, __builtin_amdgcn_mbcnt_lo(~0u, 0u)); }
#define LDS_WAIT() asm volatile("s_waitcnt lgkmcnt(0)" ::: "memory")

namespace pg8 {
constexpr int BM = 256, BK = 64, HALF = 128, HTB = HALF * BK * 2, STAGE_BYTES = 8 * HTB, NXCD = 8, WGM = 8;
__host__ __device__ __forceinline__ int lds_byte(int r, int c) { const int st = (r >> 4) * 2 + (c >> 5), rr = r & 15, cc = c & 31, ob = rr * 64 + cc * 2; return st * 1024 + (ob ^ (((ob >> 9) & 1) << 5)); }
__host__ __device__ __forceinline__ void stage_rc(int b, int& R, int& C) { const int st = b / 1024, sb = b % 1024, swz = sb ^ (((sb >> 9) & 1) << 5); R = (st >> 1) * 16 + swz / 64; C = (st & 1) * 32 + (swz % 64) / 2; }
__host__ __device__ __forceinline__ int perm32(int rho) { const int n = rho >> 4, i = rho & 15; return 8 * (i >> 2) + 4 * n + (i & 3); }
struct Unit { int pm, pn; };
struct Gemm { const bf16_t* A; const bf16_t* Bt; int M, N, K; };
struct StaticOrder {
    int nM, nN, nwg, G, c;
    __device__ void init(int M_, int N_, int G_, int c_) { nM = M_ / BM; nN = N_ / BM; nwg = nM * nN; G = G_; c = c_; }
    __device__ bool next(int i, Unit& u) const {
        const long L = (long)i * G + c; if (L >= nwg) return false;
        int wgid = (int)L; { const int q = nwg / NXCD, r = nwg % NXCD, xcd = wgid % NXCD, off = wgid / NXCD; wgid = (xcd < r ? xcd * (q + 1) : r * (q + 1) + (xcd - r) * q) + off; }
        const int nig = WGM * nN, gid = wgid / nig, fm = gid * WGM, gsz = (nM - fm) < WGM ? (nM - fm) : WGM;
        u.pm = fm + ((wgid % nig) % gsz); u.pn = (wgid % nig) / gsz; return true;
    }
};

template <class Epi, bool ALIGN_EPI, bool SP2>
__device__ __forceinline__ void gemm_phase(LAS unsigned char* lds, const Gemm g, const StaticOrder& S, const Epi& E, int wid0) {
    int tid_ = wid0 * 64 + lane_id(); asm volatile("" : "+v"(tid_));
    const int tid = tid_, wid = __builtin_amdgcn_readfirstlane(tid >> 6), lane = tid & 63, wr = wid >> 2, wc = wid & 3, fr = lane & 15, fq = lane >> 4;
    const int K = g.K, nt = K / BK;
    unsigned voffA[2], voffB[2];
#pragma unroll
    for (int i = 0; i < 2; ++i) { int R, C; stage_rc(tid * 16 + i * 8192, R, C); const int Rb = Epi::PERM ? ((R & ~31) + perm32(R & 31)) : R;
        const int Ra = Epi::PERM_A ? ((R & ~63) + 4 * (R & 15) + ((R >> 4) & 3)) : R;
        voffA[i] = (unsigned)(Ra * K + C) * 2u; voffB[i] = (unsigned)(Rb * K + C) * 2u; }
    const size_t kstep = (size_t)(BK * 2);
    const size_t hstep = (size_t)HALF * K * 2;
    const size_t tstep = 2 * hstep;
    const unsigned ldsw = (unsigned)wid * 1024u;
    const int aoff = lds_byte(wr * 64 + fr, fq * 8), boff = lds_byte(wc * 32 + fr, fq * 8);
#define PG8_SA(b, h) (((b) * 2 + (h)) * HTB)
#define PG8_SB(b, h) ((4 + (b) * 2 + (h)) * HTB)
#define PG8_STAGE(bufoff, gbase, voff) do { _Pragma("unroll") for (int _i = 0; _i < 2; ++_i) \
        __builtin_amdgcn_global_load_lds((const unsigned*)((const char*)(gbase) + (voff)[_i]), (LAS unsigned*)(lds + (bufoff) + ldsw + _i * 8192), 16, 0, 0); } while (0)
#define PG8_LDA(dst, b, h) do { _Pragma("unroll") for (int m = 0; m < 4; ++m) _Pragma("unroll") for (int k = 0; k < 2; ++k) dst[m][k] = *(const LAS bf16x8*)(lds + PG8_SA(b, h) + aoff + m * 2048 + k * 1024); } while (0)
#define PG8_LDB(dst, b, h) do { _Pragma("unroll") for (int n = 0; n < 2; ++n) _Pragma("unroll") for (int k = 0; k < 2; ++k) dst[n][k] = *(const LAS bf16x8*)(lds + PG8_SB(b, h) + boff + n * 2048 + k * 1024); } while (0)
#define PG8_MMA(ai, bj, At, Bt) do { __builtin_amdgcn_s_setprio(1); _Pragma("unroll") for (int m = 0; m < 4; ++m) _Pragma("unroll") for (int n = 0; n < 2; ++n) _Pragma("unroll") for (int k = 0; k < 2; ++k) \
        acc[ai][bj][m][n] = __builtin_amdgcn_mfma_f32_16x16x32_bf16(Bt[n][k], At[m][k], acc[ai][bj][m][n], 0, 0, 0); __builtin_amdgcn_s_setprio(0); } while (0)
#define PG8_WAIT_V(n) asm volatile("s_waitcnt vmcnt(" #n ")" ::: "memory")
#define PG8_WAIT_L(n) asm volatile("s_waitcnt lgkmcnt(" #n ")" ::: "memory")
#define PG8_BAR __builtin_amdgcn_s_barrier()
#define PG8_SCHED __builtin_amdgcn_sched_barrier(0)
    Unit cur, nxt; int ui = 0;
    if (!S.next(0, cur)) return;
    f32x4 acc[2][2][4][2];
#pragma unroll
    for (int a = 0; a < 2; ++a)
#pragma unroll
        for (int b = 0; b < 2; ++b)
#pragma unroll
            for (int m = 0; m < 4; ++m)
#pragma unroll
                for (int n = 0; n < 2; ++n) acc[a][b][m][n] = (f32x4){0.f, 0.f, 0.f, 0.f};
    bf16x8 At[4][2], B0[2][2], B1[2][2];
    const char* cA = (const char*)g.A + (size_t)cur.pm * tstep; const char* cB = (const char*)g.Bt + (size_t)cur.pn * tstep;
    E.begin(cur);
    if constexpr (SP2) {
        PG8_STAGE(PG8_SB(0, 0), cB, voffB); PG8_STAGE(PG8_SB(0, 1), cB + hstep, voffB); PG8_STAGE(PG8_SA(0, 0), cA, voffA); PG8_STAGE(PG8_SA(0, 1), cA + hstep, voffA);
        if (wr == 1) PG8_BAR;
        PG8_WAIT_V(2); PG8_BAR;
        PG8_STAGE(PG8_SB(1, 0), cB + kstep, voffB); PG8_STAGE(PG8_SA(1, 0), cA + kstep, voffA); PG8_STAGE(PG8_SB(1, 1), cB + hstep + kstep, voffB);
        PG8_WAIT_V(6); PG8_BAR;
    } else {
        PG8_STAGE(PG8_SB(0, 0), cB, voffB); PG8_STAGE(PG8_SA(0, 0), cA, voffA); PG8_STAGE(PG8_SB(0, 1), cB + hstep, voffB); PG8_STAGE(PG8_SA(0, 1), cA + hstep, voffA);
        if (wr == 1) PG8_BAR;
        PG8_WAIT_V(4); PG8_BAR;
        PG8_STAGE(PG8_SB(1, 0), cB + kstep, voffB); PG8_STAGE(PG8_SA(1, 0), cA + kstep, voffA); PG8_STAGE(PG8_SB(1, 1), cB + hstep + kstep, voffB);
        PG8_WAIT_V(6); PG8_BAR;
    }
    for (;;) {
        const bool has_next = S.next(ui + 1, nxt);
        const char* nA = has_next ? (const char*)g.A + (size_t)nxt.pm * tstep : cA; const char* nB = has_next ? (const char*)g.Bt + (size_t)nxt.pn * tstep : cB;
        for (int t = 0; t < nt; t += 2) {
            const bool last = (t == nt - 2);
            const char* a1 = cA + (size_t)(t + 1) * kstep;
            const char* a2 = last ? nA : cA + (size_t)(t + 2) * kstep; const char* b2 = last ? nB : cB + (size_t)(t + 2) * kstep;
            const char* a3 = a2 + kstep; const char* b3 = b2 + kstep;
            if constexpr (SP2) {
            PG8_LDB(B0, 0, 0); PG8_LDB(B1, 0, 1); PG8_SCHED; PG8_LDA(At, 0, 0); PG8_STAGE(PG8_SA(1, 1), a1 + hstep, voffA);
            PG8_WAIT_V(8); PG8_WAIT_L(0); PG8_BAR; PG8_MMA(0, 0, At, B0); PG8_MMA(0, 1, At, B1); PG8_BAR; PG8_SCHED;
            PG8_LDA(At, 0, 1); PG8_STAGE(PG8_SB(0, 0), b2, voffB); PG8_STAGE(PG8_SB(0, 1), b2 + hstep, voffB); PG8_STAGE(PG8_SA(0, 0), a2, voffA);
            PG8_WAIT_V(8); PG8_WAIT_L(0); PG8_BAR; PG8_MMA(1, 0, At, B0); PG8_MMA(1, 1, At, B1); PG8_BAR; PG8_SCHED;
            PG8_LDB(B0, 1, 0); PG8_LDB(B1, 1, 1); PG8_SCHED; PG8_LDA(At, 1, 0); PG8_STAGE(PG8_SA(0, 1), a2 + hstep, voffA);
            PG8_WAIT_V(8); PG8_WAIT_L(0); PG8_BAR; PG8_MMA(0, 0, At, B0); PG8_MMA(0, 1, At, B1); PG8_BAR; PG8_SCHED;
            PG8_LDA(At, 1, 1); PG8_STAGE(PG8_SB(1, 0), b3, voffB); PG8_STAGE(PG8_SB(1, 1), b3 + hstep, voffB); PG8_STAGE(PG8_SA(1, 0), a3, voffA);
            PG8_WAIT_V(8); PG8_WAIT_L(0); PG8_BAR; PG8_MMA(1, 0, At, B0); PG8_MMA(1, 1, At, B1); PG8_BAR; PG8_SCHED;
            } else {
            PG8_LDB(B0, 0, 0); PG8_SCHED; PG8_LDA(At, 0, 0); PG8_STAGE(PG8_SA(1, 1), a1 + hstep, voffA);
            PG8_WAIT_L(8); PG8_BAR; PG8_WAIT_L(0); PG8_MMA(0, 0, At, B0); PG8_BAR; PG8_SCHED;
            PG8_LDB(B1, 0, 1); PG8_STAGE(PG8_SB(0, 0), b2, voffB);
            PG8_BAR; PG8_WAIT_L(0); PG8_MMA(0, 1, At, B1); PG8_BAR;
            PG8_LDA(At, 0, 1); PG8_STAGE(PG8_SA(0, 0), a2, voffA);
            PG8_BAR; PG8_WAIT_L(0); PG8_MMA(1, 0, At, B0); PG8_BAR; PG8_SCHED;
            PG8_STAGE(PG8_SB(0, 1), b2 + hstep, voffB);
            PG8_WAIT_V(6); PG8_BAR; PG8_MMA(1, 1, At, B1); PG8_BAR;
            PG8_LDB(B0, 1, 0); PG8_SCHED; PG8_LDA(At, 1, 0); PG8_STAGE(PG8_SA(0, 1), a2 + hstep, voffA);
            PG8_WAIT_L(8); PG8_BAR; PG8_WAIT_L(0); PG8_MMA(0, 0, At, B0); PG8_BAR; PG8_SCHED;
            PG8_LDB(B1, 1, 1); PG8_STAGE(PG8_SB(1, 0), b3, voffB);
            PG8_BAR; PG8_WAIT_L(0); PG8_MMA(0, 1, At, B1); PG8_BAR;
            PG8_LDA(At, 1, 1); PG8_STAGE(PG8_SA(1, 0), a3, voffA);
            PG8_BAR; PG8_WAIT_L(0); PG8_MMA(1, 0, At, B0); PG8_BAR; PG8_SCHED;
            PG8_STAGE(PG8_SB(1, 1), b3 + hstep, voffB);
            PG8_WAIT_V(6); PG8_BAR; PG8_MMA(1, 1, At, B1); PG8_BAR;
            }
        }
        if constexpr (ALIGN_EPI) { if (wr == 0) PG8_BAR; }
        E(acc, cur, wr, wc, fr, fq, has_next ? nxt.pn : -1, ui);
        if (!has_next) break;
#pragma unroll
        for (int a = 0; a < 2; ++a)
#pragma unroll
            for (int b = 0; b < 2; ++b)
#pragma unroll
                for (int m = 0; m < 4; ++m)
#pragma unroll
                    for (int n = 0; n < 2; ++n) acc[a][b][m][n] = (f32x4){0.f, 0.f, 0.f, 0.f};
        cur = nxt; cA = nA; cB = nB; ++ui;
        if constexpr (ALIGN_EPI) { if (wr == 1) PG8_BAR; }
    }
    PG8_WAIT_V(0);
    if constexpr (!ALIGN_EPI) { if (wr == 0) PG8_BAR; }
    PG8_BAR;
#undef PG8_SA
#undef PG8_SB
#undef PG8_STAGE
#undef PG8_LDA
#undef PG8_LDB
#undef PG8_MMA
#undef PG8_WAIT_V
#undef PG8_WAIT_L
#undef PG8_SCHED
}

struct EpiGlu {
    static constexpr bool PERM = true, PERM_A = false;
    const bf16_t* Z; bf16_t* Y; const float* glu_b; const float* gss;
    __device__ __forceinline__ void begin(const Unit&) const {}
    __device__ __forceinline__ void operator()(const f32x4 (&acc)[2][2][4][2], const Unit& u, int wr, int wc, int fr, int fq, int, int) const {
        const int row0 = u.pm * BM + wr * 64 + fr, col0 = u.pn * BM + wc * 32 + 8 * fq;
#pragma unroll
        for (int bj = 0; bj < 2; ++bj) {
            const int cb = col0 + bj * HALF;
            const f32x4 b0 = *(const f32x4*)(glu_b + cb), b1 = *(const f32x4*)(glu_b + cb + 4);
            const f32x4 g0 = *(const f32x4*)(gss + cb), g1 = *(const f32x4*)(gss + cb + 4);
#pragma unroll
            for (int ai = 0; ai < 2; ++ai)
#pragma unroll
                for (int m = 0; m < 4; ++m) {
                    const size_t row = (size_t)(row0 + ai * HALF + m * 16);
                    const u32x4 zr = *(const u32x4*)(Z + row * DSSM + cb);
                    float z[8] = {bflo(zr.x), bfhi(zr.x), bflo(zr.y), bfhi(zr.y), bflo(zr.z), bfhi(zr.z), bflo(zr.w), bfhi(zr.w)};
                    float y[8]; float ss = 0.f;
#pragma unroll
                    for (int e = 0; e < 4; ++e) { y[e] = z[e] * sigmoidf_(acc[ai][bj][m][0][e] + b0[e]); y[4 + e] = z[4 + e] * sigmoidf_(acc[ai][bj][m][1][e] + b1[e]); }
#pragma unroll
                    for (int e = 0; e < 8; ++e) ss += y[e] * y[e];
                    ss += __shfl_xor(ss, 16);
                    const float rs = rsqrtf(ss * (1.0f / 16.0f) + EPS);
                    u32x4 w; w.x = pk2(y[0] * rs * g0[0], y[1] * rs * g0[1]); w.y = pk2(y[2] * rs * g0[2], y[3] * rs * g0[3]);
                    w.z = pk2(y[4] * rs * g1[0], y[5] * rs * g1[1]); w.w = pk2(y[6] * rs * g1[2], y[7] * rs * g1[3]);
                    *(u32x4*)(Y + row * D + cb) = w;
                }
        }
    }
};
__device__ __forceinline__ void fmac_shr1(float& o, float src, float w) { asm volatile("s_nop 1\n\tv_fmac_f32_dpp %0, %1, %2 row_shr:1 row_mask:0xf bank_mask:0xf bound_ctrl:1" : "+v"(o) : "v"(src), "v"(w)); }
__device__ __forceinline__ void fmac_shr1b(float& o, float src, float w) { asm volatile("v_fmac_f32_dpp %0, %1, %2 row_shr:1 row_mask:0xf bank_mask:0xf bound_ctrl:1" : "+v"(o) : "v"(src), "v"(w)); }
__device__ __forceinline__ void fmac_shr2(float& o, float src, float w) { asm volatile("v_fmac_f32_dpp %0, %1, %2 row_shr:2 row_mask:0xf bank_mask:0xf bound_ctrl:1" : "+v"(o) : "v"(src), "v"(w)); }
__device__ __forceinline__ void fmac_ror1(float& o, float src, float w) { asm volatile("v_fmac_f32_dpp %0, %1, %2 row_ror:1 row_mask:0xf bank_mask:0xf" : "+v"(o) : "v"(src), "v"(w)); }
__device__ __forceinline__ void fmac_ror2(float& o, float src, float w) { asm volatile("v_fmac_f32_dpp %0, %1, %2 row_ror:2 row_mask:0xf bank_mask:0xf" : "+v"(o) : "v"(src), "v"(w)); }
struct EpiUp {
    static constexpr bool PERM = true, PERM_A = false;
    bf16_t* G; float* HT; const float* fcw; LAS float* xb;
    __device__ __forceinline__ void begin(const Unit& u) const {
        const int tq = __builtin_amdgcn_readfirstlane(threadIdx.x >> 6) * 64 + lane_id();
        const int c0w = tq & 255, oc0 = (c0w < 128 ? 0 : DFF - 128) + u.pn * HALF + c0w;
        LAS float* wt = xb + 2048;
        wt[tq] = fcw[(size_t)(tq >> 8) * NUP + oc0]; if (tq < 256) wt[512 + tq] = fcw[2 * (size_t)NUP + oc0];
    }
    __device__ __forceinline__ void operator()(f32x4 (&acc)[2][2][4][2], const Unit& u, int wr, int wc, int fr_, int fq_, int next_pn, int ui) const {
        int lq = lane_id(); asm volatile("" : "+v"(lq));
        const int fr = lq & 15, fq = (lq >> 4) & 3;
        const int ct0 = wc * 32 + 8 * fq;
        LAS float* wt = xb + 2048 + (ui & 1) * 768;
        LAS float* wtn = xb + 2048 + ((ui + 1) & 1) * 768;
        const int tq = (wr * 4 + wc) * 64 + lq;
        const int c0w = tq & 255, oc0 = (c0w < 128 ? 0 : DFF - 128) + (next_pn < 0 ? 0 : next_pn) * HALF + c0w;
        const float wq0 = fcw[(size_t)(tq >> 8) * NUP + oc0];
        const float wq1 = (tq < 256) ? fcw[2 * (size_t)NUP + oc0] : 0.f;
        if (fr >= 14) {
#pragma unroll
            for (int ai = 0; ai < 2; ++ai)
#pragma unroll
                for (int bj = 0; bj < 2; ++bj)
#pragma unroll
                    for (int n = 0; n < 2; ++n) *(LAS f32x4*)(xb + ((ai * 2 + wr) * 2 + (fr - 14)) * 256 + bj * HALF + ct0 + 4 * n) = acc[ai][bj][3][n];
        }
        if (wr == 0 && fr < 2) {
            float* hp = HT + ((size_t)u.pm * 4 + fr) * NUP + (size_t)u.pn * 256 + ct0;
#pragma unroll
            for (int bj = 0; bj < 2; ++bj)
#pragma unroll
                for (int n = 0; n < 2; ++n) *(f32x4*)(hp + bj * HALF + 4 * n) = acc[0][bj][0][n];
        }
        if (wr == 1 && fr >= 14) {
            float* hp = HT + ((size_t)u.pm * 4 + 2 + (fr - 14)) * NUP + (size_t)u.pn * 256 + ct0;
#pragma unroll
            for (int bj = 0; bj < 2; ++bj)
#pragma unroll
                for (int n = 0; n < 2; ++n) *(f32x4*)(hp + bj * HALF + 4 * n) = acc[1][bj][3][n];
        }
        LDS_WAIT(); __builtin_amdgcn_s_barrier(); asm volatile("" ::: "memory");
#pragma unroll
        for (int bj = 0; bj < 2; ++bj)
#pragma unroll
            for (int n = 0; n < 2; ++n) {
                __builtin_amdgcn_sched_barrier(0);
                const int tc = bj * HALF + ct0 + 4 * n;
                const f32x4 w0 = *(const LAS f32x4*)(wt + tc), w1 = *(const LAS f32x4*)(wt + 256 + tc), w2 = *(const LAS f32x4*)(wt + 512 + tc);
                const int b0 = wr, b1 = 2 + wr;
                const f32x4 q14 = *(const LAS f32x4*)(xb + ((b0 > 0 ? b0 - 1 : 0) * 2 + 0) * 256 + tc), q15 = *(const LAS f32x4*)(xb + ((b0 > 0 ? b0 - 1 : 0) * 2 + 1) * 256 + tc);
                const f32x4 s14 = *(const LAS f32x4*)(xb + ((b1 - 1) * 2 + 0) * 256 + tc), s15 = *(const LAS f32x4*)(xb + ((b1 - 1) * 2 + 1) * 256 + tc);
#pragma unroll
                for (int e = 0; e < 4; ++e) {
                    const float w1m = (fr == 0) ? w1[e] : 0.f, w0m = (fr < 2) ? w0[e] : 0.f;
#pragma unroll
                    for (int ai = 0; ai < 2; ++ai) {
                        const float r14 = ai ? s14[e] : q14[e], r15 = ai ? s15[e] : q15[e];
                        float h = w1m * r15 + w0m * ((fr == 0) ? r14 : r15);
                        if (ai == 0 && b0 == 0) h = 0.f;
#pragma unroll
                        for (int m = 3; m >= 0; --m) {
                            const float cur = acc[ai][bj][m][n][e];
                            float v = w2[e] * cur;
                            fmac_shr1(v, cur, w1[e]); fmac_shr2(v, cur, w0[e]);
                            if (m > 0) { const float pb = acc[ai][bj][m - 1][n][e]; fmac_ror1(v, pb, w1m); fmac_ror2(v, pb, w0m); }
                            else v += h;
                            acc[ai][bj][m][n][e] = v;
                        }
                    }
                }
            }
        const int row0 = u.pm * BM + wr * 64 + fr, col0 = u.pn * HALF + ct0;
#pragma unroll
        for (int ai = 0; ai < 2; ++ai)
#pragma unroll
            for (int m = 0; m < 4; ++m) {
                __builtin_amdgcn_sched_barrier(0);
                const f32x4 a0 = acc[ai][0][m][0], a1 = acc[ai][0][m][1], v0 = acc[ai][1][m][0], v1 = acc[ai][1][m][1];
                u32x4 w; w.x = pk2(siluf_(a0[0]) * v0[0], siluf_(a0[1]) * v0[1]); w.y = pk2(siluf_(a0[2]) * v0[2], siluf_(a0[3]) * v0[3]);
                w.z = pk2(siluf_(a1[0]) * v1[0], siluf_(a1[1]) * v1[1]); w.w = pk2(siluf_(a1[2]) * v1[2], siluf_(a1[3]) * v1[3]);
                *(u32x4*)(G + (size_t)(row0 + ai * HALF + m * 16) * DFF + col0) = w;
            }
        wtn[tq] = wq0; if (tq < 256) wtn[512 + tq] = wq1;
    }
};

__device__ __forceinline__ void panel_rms(const f32x4 (&v)[2][2][4][2], const Unit& u, int wr, int wc, int fr, int fq, int tid, float* xg, unsigned* cnt, LAS float* tab) {
#pragma unroll
    for (int ai = 0; ai < 2; ++ai)
#pragma unroll
        for (int m = 0; m < 4; ++m) { float ss = 0.f;
#pragma unroll
            for (int bj = 0; bj < 2; ++bj)
#pragma unroll
                for (int n = 0; n < 2; ++n) { const f32x4 x = v[ai][bj][m][n]; ss += (x[0] * x[0] + x[1] * x[1]) + (x[2] * x[2] + x[3] * x[3]); }
            ss += __shfl_xor(ss, 16); ss += __shfl_xor(ss, 32);
            if (fq == 0) tab[(ai * HALF + wr * 64 + m * 16 + fr) * 4 + wc] = ss; }
    LDS_WAIT(); __builtin_amdgcn_s_barrier(); asm volatile("" ::: "memory");
    if (tid < 256) { const f32x4 p = *(const LAS f32x4*)(tab + tid * 4);
        __hip_atomic_store(xg + ((size_t)u.pm * 256 + tid) * 4 + u.pn, (p[0] + p[1]) + (p[2] + p[3]), __ATOMIC_RELAXED, __HIP_MEMORY_SCOPE_AGENT);
        asm volatile("s_waitcnt vmcnt(0)" ::: "memory");
        if ((tid & 63) == 0) __hip_atomic_fetch_add(cnt + 64 * u.pm, 1u, __ATOMIC_RELAXED, __HIP_MEMORY_SCOPE_AGENT); }
    if (tid < 64) { unsigned sp = 0;
        while ((unsigned)__builtin_amdgcn_readfirstlane(__hip_atomic_load(cnt + 64 * u.pm, __ATOMIC_RELAXED, __HIP_MEMORY_SCOPE_AGENT)) < 16u) { __builtin_amdgcn_s_sleep(1); if (++sp > (1u << 20)) break; }
        __builtin_amdgcn_fence(__ATOMIC_ACQUIRE, "agent"); asm volatile("s_waitcnt vmcnt(0)" ::: "memory"); }
    asm volatile("" ::: "memory"); __builtin_amdgcn_s_barrier(); asm volatile("" ::: "memory");
    if (tid < 256) { const float* q = xg + ((size_t)u.pm * 256 + tid) * 4; float s = 0.f;
#pragma unroll
        for (int k = 0; k < 4; ++k) s += __hip_atomic_load(q + k, __ATOMIC_RELAXED, __HIP_MEMORY_SCOPE_AGENT);
        tab[1024 + tid] = rsqrtf(s * (1.0f / D) + EPS); }
    LDS_WAIT(); __builtin_amdgcn_s_barrier(); asm volatile("" ::: "memory");
}
struct EpiDownNorm {
    static constexpr bool PERM = true, PERM_A = false;
    float* out; const float* mod; const float* gpost; float* xg; unsigned* cnt; LAS float* tab;
    __device__ __forceinline__ void begin(const Unit&) const {}
    __device__ __forceinline__ void operator()(const f32x4 (&acc)[2][2][4][2], const Unit& u, int wr, int wc, int fr_, int fq_, int, int) const {
        int lq = lane_id(); asm volatile("" : "+v"(lq));
        const int fr = lq & 15, fq = (lq >> 4) & 3, tid = (wr * 4 + wc) * 64 + lq;
        panel_rms(acc, u, wr, wc, fr, fq, tid, xg, cnt, tab);
        const int row0 = u.pm * BM + wr * 64 + fr, col0 = u.pn * BM + wc * 32 + 8 * fq, b = u.pm >> 4;
#pragma unroll
        for (int bj = 0; bj < 2; ++bj) {
            __builtin_amdgcn_sched_barrier(0);
            const int cb = col0 + bj * HALF;
            const f32x4 c0 = *(const f32x4*)(mod + b * NMOD + 5 * D + cb) * *(const f32x4*)(gpost + cb), c1 = *(const f32x4*)(mod + b * NMOD + 5 * D + cb + 4) * *(const f32x4*)(gpost + cb + 4);
#pragma unroll
            for (int ai = 0; ai < 2; ++ai)
#pragma unroll
                for (int m = 0; m < 4; ++m) { const int rl = ai * HALF + wr * 64 + m * 16 + fr; const float rs = tab[1024 + rl];
                    float* op = out + (size_t)(row0 + ai * HALF + m * 16) * D + cb;
                    const f32x4 x0 = *(const f32x4*)op, x1 = *(const f32x4*)(op + 4);
                    *(f32x4*)op = x0 + c0 * (acc[ai][bj][m][0] * rs); *(f32x4*)(op + 4) = x1 + c1 * (acc[ai][bj][m][1] * rs); }
        }
    }
};

struct EpiOutNorm {
    static constexpr bool PERM = true, PERM_A = false;
    const float* x; float* out; bf16_t* H; const float* mod; const float* gpostmix; const float* gpreffn; float* xg; unsigned* cnt; LAS float* tab;
    __device__ __forceinline__ void begin(const Unit&) const {}
    __device__ __forceinline__ void operator()(f32x4 (&acc)[2][2][4][2], const Unit& u, int wr, int wc, int fr_, int fq_, int, int) const {
        int lq = lane_id(); asm volatile("" : "+v"(lq));
        const int fr = lq & 15, fq = (lq >> 4) & 3, tid = (wr * 4 + wc) * 64 + lq;
        panel_rms(acc, u, wr, wc, fr, fq, tid, xg, cnt, tab);
        const int row0 = u.pm * BM + wr * 64 + fr, col0 = u.pn * BM + wc * 32 + 8 * fq, b = u.pm >> 4;
        const float* mb = mod + b * NMOD;
#pragma unroll
        for (int bj = 0; bj < 2; ++bj) {
            __builtin_amdgcn_sched_barrier(0);
            const int cb = col0 + bj * HALF;
            const f32x4 c0 = *(const f32x4*)(mb + 2 * D + cb) * *(const f32x4*)(gpostmix + cb), c1 = *(const f32x4*)(mb + 2 * D + cb + 4) * *(const f32x4*)(gpostmix + cb + 4);
#pragma unroll
            for (int ai = 0; ai < 2; ++ai)
#pragma unroll
                for (int m = 0; m < 4; ++m) { const int rl = ai * HALF + wr * 64 + m * 16 + fr; const float rs = tab[1024 + rl];
                    const size_t off = (size_t)(row0 + ai * HALF + m * 16) * D + cb;
                    const f32x4 x0 = *(const f32x4*)(x + off), x1 = *(const f32x4*)(x + off + 4);
                    const f32x4 y0 = x0 + c0 * (acc[ai][bj][m][0] * rs), y1 = x1 + c1 * (acc[ai][bj][m][1] * rs);
                    *(f32x4*)(out + off) = y0; *(f32x4*)(out + off + 4) = y1;
                    acc[ai][bj][m][0] = y0; acc[ai][bj][m][1] = y1; }
        }
        __builtin_amdgcn_sched_barrier(0);
        panel_rms(acc, u, wr, wc, fr, fq, tid, xg + (size_t)M * 4, cnt + 128 * 64, tab);
#pragma unroll
        for (int bj = 0; bj < 2; ++bj) {
            __builtin_amdgcn_sched_barrier(0);
            const int cb = col0 + bj * HALF;
            const f32x4 g0 = *(const f32x4*)(gpreffn + cb) * (*(const f32x4*)(mb + 4 * D + cb) + 1.0f), g1 = *(const f32x4*)(gpreffn + cb + 4) * (*(const f32x4*)(mb + 4 * D + cb + 4) + 1.0f);
            const f32x4 s0 = *(const f32x4*)(mb + 3 * D + cb), s1 = *(const f32x4*)(mb + 3 * D + cb + 4);
#pragma unroll
            for (int ai = 0; ai < 2; ++ai)
#pragma unroll
                for (int m = 0; m < 4; ++m) { const int rl = ai * HALF + wr * 64 + m * 16 + fr; const float rs = tab[1024 + rl];
                    const f32x4 h0 = acc[ai][bj][m][0] * rs * g0 + s0, h1 = acc[ai][bj][m][1] * rs * g1 + s1;
                    u32x4 w; w.x = pk2(h0[0], h0[1]); w.y = pk2(h0[2], h0[3]); w.z = pk2(h1[0], h1[1]); w.w = pk2(h1[2], h1[3]);
                    *(u32x4*)(H + (size_t)(row0 + ai * HALF + m * 16) * D + cb) = w; }
        }
    }
};

struct EpiIn {
    static constexpr bool PERM = true, PERM_A = true;
    bf16_t* Y; bf16_t* U; float* HTI; const float* convw; const float* gconv; LAS float* xb;
    __device__ __forceinline__ void begin(const Unit&) const {
        const int t = __builtin_amdgcn_readfirstlane(threadIdx.x >> 6) * 64 + lane_id();
        LAS float* wl = xb + 512 + 1024;
#pragma unroll
        for (int k = 0; k < 3; ++k) wl[k * 512 + t] = convw[k * 512 + t];
        wl[3 * 512 + t] = gconv[t];
    }
    __device__ __forceinline__ void operator()(f32x4 (&acc)[2][2][4][2], const Unit& u, int wr, int wc, int fr_, int fq_, int, int) const {
        int lq = lane_id(); asm volatile("" : "+v"(lq));
        const int fr = lq & 15, fq = (lq >> 4) & 3;
        const int ch4 = 16 * wc + 4 * fq, gch = 64 * u.pn + ch4;
        LAS float* tab = xb + 512;
        const LAS float* wl = xb + 512 + 1024;
#pragma unroll
        for (int ai = 0; ai < 2; ++ai)
#pragma unroll
            for (int m = 0; m < 4; ++m) acc[ai][0][m][0] = acc[ai][0][m][0] * acc[ai][0][m][1];
        if (fr == 15) {
#pragma unroll
            for (int ai = 0; ai < 2; ++ai) { *(LAS f32x4*)(xb + ((ai * 2 + wr) * 2 + 0) * 64 + ch4) = acc[ai][0][2][0]; *(LAS f32x4*)(xb + ((ai * 2 + wr) * 2 + 1) * 64 + ch4) = acc[ai][0][3][0]; }
        }
        if (wr == 0 && fr == 0) { float* hp = HTI + ((size_t)u.pm * 6) * 512 + gch;
            *(f32x4*)(hp) = acc[0][0][0][0]; *(f32x4*)(hp + 512) = acc[0][0][1][0]; *(f32x4*)(hp + 4 * 512) = acc[0][1][0][0]; *(f32x4*)(hp + 5 * 512) = acc[0][1][1][0]; }
        if (wr == 1 && fr == 15) { float* hp = HTI + ((size_t)u.pm * 6 + 2) * 512 + gch; *(f32x4*)(hp) = acc[1][0][2][0]; *(f32x4*)(hp + 512) = acc[1][0][3][0]; }
        LDS_WAIT(); __builtin_amdgcn_s_barrier(); asm volatile("" ::: "memory");
        const f32x4 w0 = *(const LAS f32x4*)(wl + gch), w1 = *(const LAS f32x4*)(wl + 512 + gch), w2 = *(const LAS f32x4*)(wl + 1024 + gch);
#pragma unroll
        for (int ai = 0; ai < 2; ++ai) {
            __builtin_amdgcn_sched_barrier(0);
            const int blk = ai * 2 + wr, pblk = blk > 0 ? blk - 1 : 0;
            const bool halo = (fr == 0) && (blk > 0);
            const f32x4 h2 = *(const LAS f32x4*)(xb + (pblk * 2 + 0) * 64 + ch4), h3 = *(const LAS f32x4*)(xb + (pblk * 2 + 1) * 64 + ch4);
#pragma unroll
            for (int e = 0; e < 4; ++e) {
                const float w1m = halo ? w1[e] : 0.f, w0m = halo ? w0[e] : 0.f;
                const float c0 = acc[ai][0][0][0][e], c1 = acc[ai][0][1][0][e], c2 = acc[ai][0][2][0][e], c3 = acc[ai][0][3][0][e];
                float o1 = w2[e] * c1 + w1[e] * c0 + w0m * h3[e];
                float o0 = w2[e] * c0 + w1m * h3[e] + w0m * h2[e];
                fmac_shr1(o1, c3, w0[e]); fmac_shr1b(o0, c3, w1[e]); fmac_shr1b(o0, c2, w0[e]);
                acc[ai][0][3][0][e] = acc[ai][1][3][0][e] * (w2[e] * c3 + w1[e] * c2 + w0[e] * c1);
                acc[ai][0][2][0][e] = acc[ai][1][2][0][e] * (w2[e] * c2 + w1[e] * c1 + w0[e] * c0);
                acc[ai][0][1][0][e] = acc[ai][1][1][0][e] * o1; acc[ai][0][0][0][e] = acc[ai][1][0][0][e] * o0;
            }
        }
#pragma unroll
        for (int ai = 0; ai < 2; ++ai)
#pragma unroll
            for (int m = 0; m < 4; ++m) { const f32x4 y = acc[ai][0][m][0]; float ss = (y[0] * y[0] + y[1] * y[1]) + (y[2] * y[2] + y[3] * y[3]);
                ss += __shfl_xor(ss, 16); ss += __shfl_xor(ss, 32);
                if (fq == 0) tab[(ai * HALF + wr * 64 + 4 * fr + m) * 4 + wc] = ss; }
        LDS_WAIT(); __builtin_amdgcn_s_barrier(); asm volatile("" ::: "memory");
        const f32x4 gg = *(const LAS f32x4*)(wl + 1536 + gch);
        const int row0 = u.pm * BM + wr * 64 + 4 * fr;
#pragma unroll
        for (int ai = 0; ai < 2; ++ai)
#pragma unroll
            for (int m = 0; m < 4; ++m) { const int rl = ai * HALF + wr * 64 + 4 * fr + m; const f32x4 pp = *(const LAS f32x4*)(tab + rl * 4);
                const float rs = rsqrtf(((pp[0] + pp[1]) + (pp[2] + pp[3])) * (1.0f / 64.0f) + EPS);
                const f32x4 y = acc[ai][0][m][0] * rs * gg, uu = acc[ai][1][m][1];
                const size_t row = (size_t)(row0 + ai * HALF + m);
                u32x2 wy; wy.x = pk2(y[0], y[1]); wy.y = pk2(y[2], y[3]); *(u32x2*)(Y + row * D + 512 + gch) = wy;
                u32x2 wu; wu.x = pk2(uu[0], uu[1]); wu.y = pk2(uu[2], uu[3]); *(u32x2*)(U + row * DSSM + gch) = wu; }
    }
};
#undef PG8_BAR
}

#define XB_TMO      128
#define XB_XCNT(j)  (256  + 64 * (j))
#define XB_XSUB(j)  (1280 + 64 * (j))
#define XB_XGEN(j)  (2304 + 64 * (j))
#define XB_TOP      3328
#define XB_TOPGEN   3392
#define XCD_BAR_WORDS 3456
#define XB_SPIN_CAP (1u << 18)

__device__ __forceinline__ unsigned xb_ld(unsigned* p)              { return __hip_atomic_load(p, __ATOMIC_RELAXED, __HIP_MEMORY_SCOPE_AGENT); }
__device__ __forceinline__ unsigned xb_add(unsigned* p, unsigned v) { return __hip_atomic_fetch_add(p, v, __ATOMIC_RELAXED, __HIP_MEMORY_SCOPE_AGENT); }
__device__ __forceinline__ unsigned xb_xcc_id() { return (unsigned)__builtin_amdgcn_s_getreg((3 << 11) | 20) & 0xFu; }
#define XB_SPIN(cond, bar) do { unsigned _sp = 0; while (cond) { __builtin_amdgcn_s_sleep(1); \
    if ((++_sp & 255u) == 0u) { if (xb_ld(&(bar)[XB_TMO])) break; if (_sp > XB_SPIN_CAP) { atomicAdd(&(bar)[XB_TMO], 1u); break; } } } } while (0)

struct XcdBarrier {
    unsigned* bar; unsigned x;
    volatile LAS unsigned* st;
};

__device__ __forceinline__ XcdBarrier xcd_barrier_post(unsigned* bar, volatile LAS unsigned* st) {
    XcdBarrier b; b.bar = bar; b.x = xb_xcc_id(); b.st = st;
    if (threadIdx.x == 0) (void)xb_add(&bar[XB_XCNT(b.x)], 1u);
    return b;
}
__device__ __forceinline__ void xcd_barrier_complete(unsigned* bar, unsigned x, unsigned& nloc, unsigned& nx) {
    const unsigned G = gridDim.x * gridDim.y * gridDim.z;
    unsigned sum, cnt, mine, sp = 0u;
    for (;;) {
        sum = 0u; cnt = 0u; mine = 0u;
#pragma unroll
        for (unsigned j = 0; j < 16; ++j) { const unsigned c = xb_ld(&bar[XB_XCNT(j)]); sum += c; cnt += (c > 0u) ? 1u : 0u; mine = (j == x) ? c : mine; }
        if (sum == G) break;
        __builtin_amdgcn_s_sleep(1);
        if ((++sp & 255u) == 0u) { if (xb_ld(&bar[XB_TMO])) break; if (sp > XB_SPIN_CAP) { atomicAdd(&bar[XB_TMO], 1u); break; } }
    }
    nloc = mine > 0u ? mine : 1u; nx = cnt > 0u ? cnt : 1u;
}

__device__ __forceinline__ void xcd_barrier(const XcdBarrier& b) {
    asm volatile("s_waitcnt vmcnt(0)" ::: "memory");
    __syncthreads();
    if (threadIdx.x == 0) {
        unsigned* bar = b.bar;
        __builtin_amdgcn_s_waitcnt(0);
        unsigned nloc = b.st[0], nx = b.st[1];
        if (nloc == 0u) { xcd_barrier_complete(bar, b.x, nloc, nx); b.st[0] = nloc; b.st[1] = nx; }
        const unsigned old = xb_add(&bar[XB_XSUB(b.x)], 1u);
        const unsigned gen = old / nloc;
        if (old + 1u == (gen + 1u) * nloc) {
            __builtin_amdgcn_fence(__ATOMIC_RELEASE, "agent");
            asm volatile("s_waitcnt vmcnt(0)" ::: "memory");
            const unsigned og = xb_add(&bar[XB_TOP], 1u);
            const unsigned tg = og / nx;
            if (og + 1u == (tg + 1u) * nx) xb_add(&bar[XB_TOPGEN], 1u);
            else XB_SPIN(xb_ld(&bar[XB_TOPGEN]) == tg, bar);
            __builtin_amdgcn_fence(__ATOMIC_ACQUIRE, "agent");
            xb_add(&bar[XB_XGEN(b.x)], 1u);
            asm volatile("s_waitcnt vmcnt(0)" ::: "memory");
        } else {
            XB_SPIN(xb_ld(&bar[XB_XGEN(b.x)]) == gen, bar);
            __builtin_amdgcn_fence(__ATOMIC_ACQUIRE, "agent");
            asm volatile("s_waitcnt vmcnt(0)" ::: "memory");
        }
    }
    __syncthreads();
}


struct Args { const float* in[26]; float* out; unsigned char* ws; int ph_lo, ph_hi; };
typedef const __attribute__((address_space(4))) Args* ArgsP;
__device__ __forceinline__ ArgsP opaque_args() { ArgsP p = (ArgsP)__builtin_amdgcn_kernarg_segment_ptr(); asm volatile("" : "+s"(p)); return p; }
enum { I_X = 0, I_C, I_WADA, I_BADA, I_GPREMIX, I_GPOSTMIX, I_WIN, I_LRE, I_LIM, I_LSTEP, I_BRE, I_BIM, I_CRE, I_CIM, I_DSKIP, I_GLUW, I_GLUB,
       I_GOSSM, I_CONVW, I_GOCONV, I_WOUT, I_GPREFFN, I_GPOSTFFN, I_WUP, I_FCW, I_WDN };

__device__ __forceinline__ int win_row(int col) {
    const int sec = col >> 9, within = col & 511, pn = within >> 6, ch = within & 63, wc = ch >> 4, fq = (ch >> 2) & 3, e = ch & 3;
    const int bj = (sec == 0 || sec == 1) ? 1 : 0, n = (sec == 0 || sec == 3) ? 1 : 0;
    return pn * 256 + bj * 128 + wc * 32 + fq * 8 + n * 4 + e;
}
template <bool WIN = false>
__device__ __forceinline__ void transpose_item(const float* W, int K, int N, bf16_t* WT, int drow, int k0, int n0, LAS float* scr, int lane) {
#pragma unroll
    for (int i = 0; i < 32; ++i) { const int kk = 2 * i + (lane >> 5); scr[kk * 33 + (lane & 31)] = W[(size_t)(k0 + kk) * N + n0 + (lane & 31)]; }
    LDS_WAIT();
    const int c = lane & 7;
#pragma unroll
    for (int j = 0; j < 4; ++j) { const int n = (lane >> 3) + 8 * j; const LAS float* s = scr + (8 * c) * 33 + n;
        u32x4 o; o.x = pk2(s[0 * 33], s[1 * 33]); o.y = pk2(s[2 * 33], s[3 * 33]); o.z = pk2(s[4 * 33], s[5 * 33]); o.w = pk2(s[6 * 33], s[7 * 33]);
        *(u32x4*)(WT + (size_t)(WIN ? win_row(n0 + n) : drow + n) * K + k0 + 8 * c) = o; }
    LDS_WAIT();
}

__device__ __forceinline__ void build_tables(ArgsP ap, LAS unsigned char* lds, int g, int tid) {
    LAS float* lamp = (LAS float*)(lds);
    LAS float* bbar = (LAS float*)(lds + 8704);
    LAS float* cc = (LAS float*)(lds + 8704 + 8192);
    unsigned char* img = ap->ws + WS_TAB + (size_t)g * TAB_BYTES;
    __syncthreads();
    const float step = expf(ap->in[I_LSTEP][g]);
    for (int i = tid; i < 17 * 64; i += 512) { const int d = i >> 6, p = i & 63;
        const float lr = fminf(ap->in[I_LRE][g * 64 + p], -1e-4f), li = ap->in[I_LIM][g * 64 + p];
        const float er = expf(lr * step * (float)d); float sn, cs; sincosf(li * step * (float)d, &sn, &cs);
        lamp[i * 2] = er * cs; lamp[i * 2 + 1] = er * sn;
        if (d == 16) { ((float*)(img + TAB_LAMT))[p * 2] = er * cs; ((float*)(img + TAB_LAMT))[p * 2 + 1] = er * sn; } }
    for (int i = tid; i < 64 * 16; i += 512) { const int p = i >> 4;
        const float lr = fminf(ap->in[I_LRE][g * 64 + p], -1e-4f), li = ap->in[I_LIM][g * 64 + p];
        const float ar = lr * step, ai = li * step;
        float sn, cs; sincosf(ai, &sn, &cs); const float em1 = expm1f(ar), ea = em1 + 1.0f; const float sh = sinf(0.5f * ai);
        const float nr = em1 * cs - 2.0f * sh * sh, ni = ea * sn;
        const float den = 1.0f / (lr * lr + li * li);
        const float qr = (nr * lr + ni * li) * den, qi = (ni * lr - nr * li) * den;
        const float br = ap->in[I_BRE][(size_t)g * 1024 + i], bi = ap->in[I_BIM][(size_t)g * 1024 + i];
        bbar[i * 2] = qr * br - qi * bi; bbar[i * 2 + 1] = qr * bi + qi * br; }
    for (int i = tid; i < 16 * 64; i += 512) { const int h = i >> 6, p = i & 63; cc[(p * 16 + h) * 2] = ap->in[I_CRE][(size_t)g * 1024 + i]; cc[(p * 16 + h) * 2 + 1] = ap->in[I_CIM][(size_t)g * 1024 + i]; }
    for (int i = tid; i < 128; i += 512) ((unsigned*)(img + TAB_KTAB))[i] = 0u;
    __syncthreads();
    if (tid < 256) { const int d = tid >> 4, h = tid & 15; float acc[16];
#pragma unroll
        for (int e = 0; e < 16; ++e) acc[e] = 0.f;
        for (int p = 0; p < 64; ++p) { const float lr = lamp[(d * 64 + p) * 2], li = lamp[(d * 64 + p) * 2 + 1], cr = cc[(p * 16 + h) * 2], ci = cc[(p * 16 + h) * 2 + 1];
            const float tr = cr * lr - ci * li, ti = cr * li + ci * lr;
#pragma unroll
            for (int q = 0; q < 8; ++q) { const f32x4 bb = *(const LAS f32x4*)(bbar + p * 32 + 4 * q); acc[2 * q] += tr * bb[0] - ti * bb[1]; acc[2 * q + 1] += tr * bb[2] - ti * bb[3]; } }
        if (d == 0) {
#pragma unroll
            for (int e = 0; e < 16; ++e) if (e == h) acc[e] += ap->in[I_DSKIP][16 * g + h]; }
        u32x4 o0, o1; o0.x = pk2(acc[0], acc[1]); o0.y = pk2(acc[2], acc[3]); o0.z = pk2(acc[4], acc[5]); o0.w = pk2(acc[6], acc[7]);
        o1.x = pk2(acc[8], acc[9]); o1.y = pk2(acc[10], acc[11]); o1.z = pk2(acc[12], acc[13]); o1.w = pk2(acc[14], acc[15]);
        u32x4* dst = (u32x4*)(img + TAB_KTAB + 512 + tid * 32); dst[0] = o0; dst[1] = o1; }
    for (int i = tid; i < 128 * 128; i += 512) { const int n = i >> 7, k = (i & 127) * 2, p = n & 63, j = k >> 4, hp = k & 15;
        const float lr = lamp[((15 - j) * 64 + p) * 2], li = lamp[((15 - j) * 64 + p) * 2 + 1];
        const f32x4 bb = *(const LAS f32x4*)(bbar + (p * 16 + hp) * 2);
        const float v0 = n < 64 ? (lr * bb[0] - li * bb[1]) : (lr * bb[1] + li * bb[0]), v1 = n < 64 ? (lr * bb[2] - li * bb[3]) : (lr * bb[3] + li * bb[2]);
        *(unsigned*)(img + TAB_M3 + n * 528 + k * 2) = pk2(v0, v1); }
    for (int i = tid; i < 256 * 64; i += 512) { const int n = i >> 6, q = (i & 63) * 2, p = q & 63, ii = n >> 4, h = n & 15;
        float v[2];
#pragma unroll
        for (int e = 0; e < 2; ++e) { const float lr = lamp[((ii + 1) * 64 + p + e) * 2], li = lamp[((ii + 1) * 64 + p + e) * 2 + 1], cr = cc[((p + e) * 16 + h) * 2], ci = cc[((p + e) * 16 + h) * 2 + 1];
            v[e] = q < 64 ? (cr * lr - ci * li) : -(cr * li + ci * lr); }
        *(unsigned*)(img + TAB_M2 + n * 272 + q * 2) = pk2(v[0], v[1]); }
    __syncthreads();
}
__device__ __forceinline__ void p0_prologue(ArgsP ap, LAS unsigned char* lds, int wid0) {
    int tid_ = wid0 * 64 + lane_id(); asm volatile("" : "+v"(tid_));
    const int tid = tid_, lane = tid & 63, wave = tid >> 6, G = gridDim.x;
    unsigned char* ws = ap->ws;
    if ((int)blockIdx.x < 96) {
        LAS float* cact = (LAS float*)(lds + 72 * 1024);
        LAS float* red = (LAS float*)(lds + 104 * 1024);
        const float* c = ap->in[I_C];
        for (int i = tid; i < NB * D; i += 512) cact[i] = siluf_(c[i]);
        __syncthreads();
        for (int item = blockIdx.x; item < 96; item += G) {
            const int col = item * 64 + lane, k0 = wave * 128;
            const float* wp = ap->in[I_WADA] + (size_t)k0 * NMOD + col;
            float acc[NB];
#pragma unroll
            for (int b = 0; b < NB; ++b) acc[b] = 0.f;
#pragma unroll 16
            for (int k = 0; k < 128; ++k) { const float w = wp[(size_t)k * NMOD];
#pragma unroll
                for (int b = 0; b < NB; ++b) acc[b] += cact[b * D + k0 + k] * w; }
#pragma unroll
            for (int b = 0; b < NB; ++b) red[(wave * NB + b) * 64 + lane] = acc[b];
            __syncthreads();
            { const int b = wave; float s = ap->in[I_BADA][col];
#pragma unroll
              for (int w = 0; w < 8; ++w) s += red[(w * NB + b) * 64 + lane];
              ((float*)(ws + WS_MOD))[b * NMOD + col] = s; }
            asm volatile("s_waitcnt vmcnt(0)" ::: "memory");
            __syncthreads();
            if (tid == 0) { __builtin_amdgcn_fence(__ATOMIC_RELEASE, "agent"); asm volatile("s_waitcnt vmcnt(0)" ::: "memory");
                __hip_atomic_fetch_add((unsigned*)(ws + WS_BAR) + 64, 1u, __ATOMIC_RELAXED, __HIP_MEMORY_SCOPE_AGENT); }
        }
    }
    for (int w = blockIdx.x; w < 128; w += G) if (w >= 96) build_tables(ap, lds, w - 96, tid);
    LAS float* scr = (LAS float*)(lds + wave * 8704);
    const bool split = (G >= 256);
    if (split && (int)blockIdx.x < 128) return;
    const int gw = (split ? (int)blockIdx.x - 128 : (int)blockIdx.x) * 8 + wave, NGW = (split ? G - 128 : G) * 8;
    constexpr int I1 = 16 * 64, I2 = 8 * 16, I3 = 16 * 32, I4 = 16 * 176, I5 = 44 * 32, NIT = I1 + I2 + I3 + I4 + I5;
    for (int it = gw; it < NIT; it += NGW) {
        int r = it;
        if (r < I1) { const int nb = r % 64, kb = r / 64; transpose_item<true>(ap->in[I_WIN], D, DIN, (bf16_t*)(ws + WS_WIN), 0, 64 * kb, 32 * nb, scr, lane); continue; } r -= I1;
        if (r < I2) { const int nb = r % 16, kb = r / 16; transpose_item(ap->in[I_GLUW], DSSM, DSSM, (bf16_t*)(ws + WS_GLU), 32 * nb, 64 * kb, 32 * nb, scr, lane); continue; } r -= I2;
        if (r < I3) { const int nb = r % 32, kb = r / 32; transpose_item(ap->in[I_WOUT], D, D, (bf16_t*)(ws + WS_WOUT), 32 * nb, 64 * kb, 32 * nb, scr, lane); continue; } r -= I3;
        if (r < I4) { const int nb = r % 176, kb = r / 176; const int n0 = 32 * nb; const int j = n0 < DFF ? n0 : n0 - DFF;
            const int drow = (j / 128) * 256 + (n0 < DFF ? 0 : 128) + (j % 128);
            transpose_item(ap->in[I_WUP], D, NUP, (bf16_t*)(ws + WS_WUP), drow, 64 * kb, n0, scr, lane); continue; } r -= I4;
        { const int nb = r % 32, kb = r / 32; transpose_item(ap->in[I_WDN], DFF, D, (bf16_t*)(ws + WS_WDN), 32 * nb, 64 * kb, 32 * nb, scr, lane); }
    }
}

__device__ __forceinline__ void p1_rows(ArgsP ap, int wid0, bool wait_mod) {
    int tid_ = wid0 * 64 + lane_id(); asm volatile("" : "+v"(tid_));
    const int lane = tid_ & 63, wave = tid_ >> 6, G = gridDim.x;
    const float* mod = (const float*)(ap->ws + WS_MOD);
    bf16_t* H = (bf16_t*)(ap->ws + WS_H);
    if (wait_mod) {
        if (tid_ == 0) { unsigned* cnt = (unsigned*)(ap->ws + WS_BAR) + 64; unsigned sp = 0;
            while (__hip_atomic_load(cnt, __ATOMIC_RELAXED, __HIP_MEMORY_SCOPE_AGENT) < 96u) { __builtin_amdgcn_s_sleep(2); if (++sp > (1u << 22)) break; }
            __builtin_amdgcn_fence(__ATOMIC_ACQUIRE, "agent"); asm volatile("s_waitcnt vmcnt(0)" ::: "memory"); }
        __syncthreads();
    }
    const int vb = (G % 8 == 0) ? (int)(blockIdx.x % 8) * (G / 8) + (int)(blockIdx.x / 8) : (int)blockIdx.x;
    for (int base = (vb * 8 + wave) * 16; base < M; base += G * 8 * 16) {
        const int b = base / SEQ;
        f32x4 gs[4], sh[4];
#pragma unroll
        for (int j = 0; j < 4; ++j) { const int col = 4 * lane + 256 * j;
            const f32x4 g = *(const f32x4*)(ap->in[I_GPREMIX] + col), sc = *(const f32x4*)(mod + b * NMOD + D + col);
            gs[j] = g * (sc + 1.0f); sh[j] = *(const f32x4*)(mod + b * NMOD + col); }
#pragma unroll 1
        for (int rb = 0; rb < 16; rb += 4) {
            f32x4 v[4][4];
#pragma unroll
            for (int r = 0; r < 4; ++r) { const f32x4* xr = (const f32x4*)(ap->in[I_X] + (size_t)(base + rb + r) * D) + lane;
#pragma unroll
                for (int j = 0; j < 4; ++j) v[r][j] = xr[64 * j]; }
#pragma unroll
            for (int r = 0; r < 4; ++r) { const size_t row = base + rb + r; float ss = 0.f;
#pragma unroll
                for (int j = 0; j < 4; ++j) ss += (v[r][j].x * v[r][j].x + v[r][j].y * v[r][j].y) + (v[r][j].z * v[r][j].z + v[r][j].w * v[r][j].w);
                const float rs = rsqrtf(wave_sum(ss) * (1.0f / D) + EPS);
                u32x2* o = (u32x2*)(H + row * D) + lane;
#pragma unroll
                for (int j = 0; j < 4; ++j) { const f32x4 h = v[r][j] * rs * gs[j] + sh[j]; u32x2 w; w.x = pk2(h.x, h.y); w.y = pk2(h.z, h.w); o[64 * j] = w; }
            }
        }
    }
}

constexpr int L_KTAB = 0, L_XS = 8704, L_MT = 78336, L_CARRY = 147968;
constexpr int L_BBAR = L_XS, L_CC = L_XS + 8192, L_LAMP = L_XS + 16384;
__device__ __forceinline__ void ssm_unit(ArgsP ap, LAS unsigned char* lds, int unit, int wid0) {
    int tid_ = wid0 * 64 + lane_id(); asm volatile("" : "+v"(tid_));
    const int tid = tid_, lane = tid & 63, wave = __builtin_amdgcn_readfirstlane(tid >> 6), b = unit & 7, g = unit >> 3;
    const bf16_t* UB = (const bf16_t*)(ap->ws + WS_U);
    bf16_t* Z = (bf16_t*)(ap->ws + WS_Z);
    float* SS = (float*)(ap->ws + WS_SS) + (size_t)unit * NCH * 128;
    const unsigned char* img = ap->ws + WS_TAB + (size_t)g * TAB_BYTES;
    __syncthreads();
    { u32x4 t0[2], t1[9];
#pragma unroll
      for (int k = 0; k < 2; ++k) { const int i = tid + 512 * k; if (i < 8704 / 16) t0[k] = ((const u32x4*)(img + TAB_KTAB))[i]; }
#pragma unroll
      for (int k = 0; k < 9; ++k) { const int i = tid + 512 * k; if (i < 67584 / 16) t1[k] = ((const u32x4*)(img + TAB_M3))[i]; }
#pragma unroll
      for (int k = 0; k < 2; ++k) { const int i = tid + 512 * k; if (i < 8704 / 16) ((LAS u32x4*)(lds + L_KTAB))[i] = t0[k]; }
#pragma unroll
      for (int k = 0; k < 9; ++k) { const int i = tid + 512 * k; if (i < 67584 / 16) ((LAS u32x4*)(lds + L_MT))[i] = t1[k]; } }
    __syncthreads();
    u32x4 m2r[9];
#pragma unroll
    for (int k = 0; k < 9; ++k) { const int i = tid + 512 * k; if (i < 69632 / 16) m2r[k] = ((const u32x4*)(img + TAB_M2))[i]; }
    const int r32 = lane & 31, hh = lane >> 5, c0 = wave * 32;
    const bf16_t* up = UB + ((size_t)b * SEQ + (size_t)(c0 + r32) * TCH) * DSSM + 16 * g + 8 * hh;
    {
    bf16x8 ufr[16];
#pragma unroll
    for (int j = 0; j < 16; ++j) ufr[j] = *(const bf16x8*)(up + (size_t)j * DSSM);
#pragma unroll
    for (int nb = 0; nb < 4; ++nb) {
        __builtin_amdgcn_sched_barrier(0);
        f32x16 acc;
#pragma unroll
        for (int e = 0; e < 16; ++e) acc[e] = 0.f;
#pragma unroll
        for (int j = 0; j < 16; ++j) { const bf16x8 bf = *(const LAS bf16x8*)(lds + L_MT + (32 * nb + r32) * 528 + (16 * j + 8 * hh) * 2);
            acc = __builtin_amdgcn_mfma_f32_32x32x16_bf16(ufr[j], bf, acc, 0, 0, 0); }
#pragma unroll
        for (int e = 0; e < 16; ++e) { const int ch = c0 + (e & 3) + 8 * (e >> 2) + 4 * hh; SS[(size_t)ch * 128 + 32 * nb + r32] = acc[e]; }
    }
    }
    __threadfence_block();
    __syncthreads();
#pragma unroll
    for (int k = 0; k < 9; ++k) { const int i = tid + 512 * k; if (i < 69632 / 16) ((LAS u32x4*)(lds + L_MT))[i] = m2r[k]; }
    const int p = lane, sb = wave;
    const float ltr = ((const float*)(img + TAB_LAMT))[p * 2], lti = ((const float*)(img + TAB_LAMT))[p * 2 + 1];
    __syncthreads();
    float er[32], ei[32];
    { float xr = 0.f, xi = 0.f;
      const float* sp = SS + (size_t)(32 * sb) * 128 + p;
#pragma unroll
      for (int k = 0; k < 32; ++k) { er[k] = sp[(size_t)k * 128]; ei[k] = sp[(size_t)k * 128 + 64]; }
#pragma unroll
      for (int k = 0; k < 32; ++k) { const float sr = er[k], si = ei[k]; er[k] = xr; ei[k] = xi;
          const float nr = ltr * xr - lti * xi + sr, ni = ltr * xi + lti * xr + si; xr = nr; xi = ni; }
      LAS float* carry = (LAS float*)(lds + L_CARRY);
      carry[(sb * 64 + p) * 2] = xr; carry[(sb * 64 + p) * 2 + 1] = xi; }
    __syncthreads();
    { float l32r = ltr, l32i = lti;
#pragma unroll
      for (int s = 0; s < 5; ++s) { const float nr = l32r * l32r - l32i * l32i, ni = 2.0f * l32r * l32i; l32r = nr; l32i = ni; }
      const LAS float* carry = (const LAS float*)(lds + L_CARRY);
      float xr = 0.f, xi = 0.f;
      for (int s = 0; s < sb; ++s) { const float nr = l32r * xr - l32i * xi + carry[(s * 64 + p) * 2], ni = l32r * xi + l32i * xr + carry[(s * 64 + p) * 2 + 1]; xr = nr; xi = ni; }
      float pr = 1.f, pi = 0.f;
#pragma unroll
      for (int k = 0; k < 32; ++k) { const float vr = er[k] + pr * xr - pi * xi, vi = ei[k] + pr * xi + pi * xr;
          LAS bf16_t* xs = (LAS bf16_t*)(lds + L_XS + (32 * sb + k) * 272);
          const unsigned w = pk2(vr, vi); xs[p] = (bf16_t)(w & 0xffffu); xs[64 + p] = (bf16_t)(w >> 16);
          const float nr = pr * ltr - pi * lti, ni = pr * lti + pi * ltr; pr = nr; pi = ni; } }
    __syncthreads();
    __builtin_amdgcn_sched_barrier(0);
    bf16x8 ufr[16];
    { int l2 = lane_id(); asm volatile("" : "+v"(l2)); const int r2 = l2 & 31, h2 = (l2 >> 5) & 1;
      const bf16_t* up2 = UB + ((size_t)b * SEQ + (size_t)(c0 + r2) * TCH) * DSSM + 16 * g + 8 * h2;
#pragma unroll
      for (int j = 0; j < 16; ++j) ufr[j] = *(const bf16x8*)(up2 + (size_t)j * DSSM); }
#pragma unroll
    for (int half = 0; half < 2; ++half) {
        __builtin_amdgcn_sched_barrier(0);
        f32x16 acc[4];
#pragma unroll
        for (int q = 0; q < 4; ++q)
#pragma unroll
            for (int e = 0; e < 16; ++e) acc[q][e] = 0.f;
#pragma unroll
        for (int j = 0; j < 8 * half + 8; ++j)
#pragma unroll
            for (int q = 0; q < 4; ++q) { const int nb = 4 * half + q;
                if (j <= 2 * nb + 1) { int d1 = 2 * nb - j + (r32 >> 4) + 1; d1 = d1 < 0 ? 0 : d1;
                    const bf16x8 bf = *(const LAS bf16x8*)(lds + L_KTAB + d1 * 512 + (lane & 15) * 32 + 16 * hh);
                    acc[q] = __builtin_amdgcn_mfma_f32_32x32x16_bf16(ufr[j], bf, acc[q], 0, 0, 0); } }
#pragma unroll
        for (int ks = 0; ks < 8; ++ks) { const bf16x8 af = *(const LAS bf16x8*)(lds + L_XS + (c0 + r32) * 272 + (16 * ks + 8 * hh) * 2);
#pragma unroll
            for (int q = 0; q < 4; ++q) { const int nb = 4 * half + q;
                const bf16x8 bf = *(const LAS bf16x8*)(lds + L_MT + (32 * nb + r32) * 272 + (16 * ks + 8 * hh) * 2);
                acc[q] = __builtin_amdgcn_mfma_f32_32x32x16_bf16(af, bf, acc[q], 0, 0, 0); } }
#pragma unroll
        for (int q = 0; q < 4; ++q) { __builtin_amdgcn_sched_barrier(0); const int n = 32 * (4 * half + q) + r32, ii = n >> 4, ch = 16 * g + (n & 15);
#pragma unroll
            for (int e = 0; e < 16; ++e) { const int chunk = c0 + (e & 3) + 8 * (e >> 2) + 4 * hh; const size_t t = (size_t)b * SEQ + (size_t)chunk * TCH + ii;
                Z[t * DSSM + ch] = (bf16_t)(pk2(gelu_tanh(acc[q][e]), 0.f) & 0xffffu); } }
    }
    __syncthreads();
}
__device__ __forceinline__ void fix_conv_rows(ArgsP ap, int wid0) {
    const int lane = lane_id(), G = gridDim.x;
    const float* HTI = (const float*)(ap->ws + WS_HT);
    bf16_t* Y = (bf16_t*)(ap->ws + WS_Y);
    const int ch = 8 * lane;
    for (int it = blockIdx.x * 8 + wid0; it < (M / 256) * 2; it += G * 8) {
        const int pm = it >> 1, r = it & 1;
        if ((pm & 15) == 0) continue;
        const float* hp = HTI + ((size_t)(pm - 1) * 6) * 512 + ch, *hc = HTI + ((size_t)pm * 6) * 512 + ch;
        float yb[8]; float ss = 0.f;
#pragma unroll
        for (int e = 0; e < 8; ++e) {
            const float pm2 = hp[2 * 512 + e], pm1 = hp[3 * 512 + e], p0 = hc[e], p1 = hc[512 + e];
            const float w0 = ap->in[I_CONVW][ch + e], w1 = ap->in[I_CONVW][512 + ch + e], w2 = ap->in[I_CONVW][1024 + ch + e];
            const float cv = r == 0 ? (w0 * pm2 + w1 * pm1 + w2 * p0) : (w0 * pm1 + w1 * p0 + w2 * p1);
            yb[e] = hc[(4 + r) * 512 + e] * cv; ss += yb[e] * yb[e]; }
        ss += __shfl_xor(ss, 1); ss += __shfl_xor(ss, 2); ss += __shfl_xor(ss, 4);
        const float rs = rsqrtf(ss * (1.0f / 64.0f) + EPS);
        u32x4 w;
        w.x = pk2(yb[0] * rs * ap->in[I_GOCONV][ch + 0], yb[1] * rs * ap->in[I_GOCONV][ch + 1]); w.y = pk2(yb[2] * rs * ap->in[I_GOCONV][ch + 2], yb[3] * rs * ap->in[I_GOCONV][ch + 3]);
        w.z = pk2(yb[4] * rs * ap->in[I_GOCONV][ch + 4], yb[5] * rs * ap->in[I_GOCONV][ch + 5]); w.w = pk2(yb[6] * rs * ap->in[I_GOCONV][ch + 6], yb[7] * rs * ap->in[I_GOCONV][ch + 7]);
        *(u32x4*)(Y + ((size_t)pm * 256 + r) * D + 512 + ch) = w;
    }
}
__device__ __forceinline__ void fix_panel(ArgsP ap, int pm, int tid) {
    if ((pm & 15) == 0) return;
    const float* HT = (const float*)(ap->ws + WS_HT);
    const float* fcw = ap->in[I_FCW];
    bf16_t* Gm = (bf16_t*)(ap->ws + WS_G);
    const float* hp = HT + ((size_t)(pm - 1) * 4) * NUP, *hc = HT + ((size_t)pm * 4) * NUP;
    for (int j = tid; j < DFF; j += 512) {
        const int ia = (j >> 7) * 256 + (j & 127), iv = ia + 128;
        const float am2 = hp[2 * NUP + ia], am1 = hp[3 * NUP + ia], a0 = hc[ia], a1 = hc[NUP + ia];
        const float vm2 = hp[2 * NUP + iv], vm1 = hp[3 * NUP + iv], v0 = hc[iv], v1 = hc[NUP + iv];
        const float wa0 = fcw[j], wa1 = fcw[NUP + j], wa2 = fcw[2 * NUP + j], wv0 = fcw[DFF + j], wv1 = fcw[NUP + DFF + j], wv2 = fcw[2 * NUP + DFF + j];
        const float ca0 = wa0 * am2 + wa1 * am1 + wa2 * a0, ca1 = wa0 * am1 + wa1 * a0 + wa2 * a1;
        const float cv0 = wv0 * vm2 + wv1 * vm1 + wv2 * v0, cv1 = wv0 * vm1 + wv1 * v0 + wv2 * v1;
        Gm[((size_t)pm * 256) * DFF + j] = (bf16_t)(pk2(siluf_(ca0) * cv0, 0.f) & 0xffffu);
        Gm[((size_t)pm * 256 + 1) * DFF + j] = (bf16_t)(pk2(siluf_(ca1) * cv1, 0.f) & 0xffffu);
    }
}
__global__ void __launch_bounds__(512, 2) hymba_fwd(Args a_unused) {
    extern __shared__ __attribute__((aligned(16))) unsigned char shm[];
    LAS unsigned char* lds = (LAS unsigned char*)shm;
    cg::grid_group grid = cg::this_grid();
    const int wid0 = __builtin_amdgcn_readfirstlane(threadIdx.x >> 6);
    if (threadIdx.x < 4) ((LAS unsigned*)(lds + L_BARST))[threadIdx.x] = 0u;
    __syncthreads();
    XcdBarrier xbar = xcd_barrier_post((unsigned*)(opaque_args()->ws + WS_BAR), (volatile LAS unsigned*)(lds + L_BARST));
    if (opaque_args()->ph_lo < 0) grid.sync();
    const int G = gridDim.x;
#define SEAM() xcd_barrier(xbar)
    p0_prologue(opaque_args(), lds, wid0);
    p1_rows(opaque_args(), wid0, true);
    SEAM();
    {
        ArgsP ap = opaque_args(); unsigned char* ws = ap->ws;
        pg8::Gemm g{(const bf16_t*)(ws + WS_H), (const bf16_t*)(ws + WS_WIN), M, DIN, D}; pg8::StaticOrder S; S.init(M, DIN, G, blockIdx.x);
        pg8::EpiIn E{(bf16_t*)(ws + WS_Y), (bf16_t*)(ws + WS_U), (float*)(ws + WS_HT), ap->in[I_CONVW], ap->in[I_GOCONV], (LAS float*)(lds + pg8::STAGE_BYTES)};
        pg8::gemm_phase<pg8::EpiIn, true, true>(lds, g, S, E, wid0);
    }
    SEAM();
    fix_conv_rows(opaque_args(), wid0);
    for (int u = blockIdx.x; u < NB * NGRP; u += G) ssm_unit(opaque_args(), lds, u, wid0);
    SEAM();
    {
        ArgsP ap = opaque_args(); unsigned char* ws = ap->ws;
        pg8::Gemm g{(const bf16_t*)(ws + WS_Z), (const bf16_t*)(ws + WS_GLU), M, DSSM, DSSM}; pg8::StaticOrder S; S.init(M, DSSM, G, blockIdx.x);
        pg8::EpiGlu E{(const bf16_t*)(ws + WS_Z), (bf16_t*)(ws + WS_Y), ap->in[I_GLUB], ap->in[I_GOSSM]};
        pg8::gemm_phase<pg8::EpiGlu, true, true>(lds, g, S, E, wid0);
    }
    SEAM();
    {
        ArgsP ap = opaque_args(); unsigned char* ws = ap->ws;
        pg8::Gemm g{(const bf16_t*)(ws + WS_Y), (const bf16_t*)(ws + WS_WOUT), M, D, D}; pg8::StaticOrder S; S.init(M, D, G, blockIdx.x);
        pg8::EpiOutNorm E{ap->in[I_X], ap->out, (bf16_t*)(ws + WS_H), (const float*)(ws + WS_MOD), ap->in[I_GPOSTMIX], ap->in[I_GPREFFN],
                          (float*)(ws + WS_XG) + (size_t)M * 4, (unsigned*)(ws + WS_CNT) + 128 * 64, (LAS float*)(lds + pg8::STAGE_BYTES)};
        pg8::gemm_phase<pg8::EpiOutNorm, true, true>(lds, g, S, E, wid0);
    }
    SEAM();
    {
        ArgsP ap = opaque_args(); unsigned char* ws = ap->ws;
        pg8::Gemm g{(const bf16_t*)(ws + WS_H), (const bf16_t*)(ws + WS_WUP), M, NUP, D}; pg8::StaticOrder S; S.init(M, NUP, G, blockIdx.x);
        pg8::EpiUp E{(bf16_t*)(ws + WS_G), (float*)(ws + WS_HT), ap->in[I_FCW], (LAS float*)(lds + pg8::STAGE_BYTES)};
        pg8::gemm_phase<pg8::EpiUp, true, true>(lds, g, S, E, wid0);
    }
    SEAM();
    {
        ArgsP ap = opaque_args(); unsigned char* ws = ap->ws;
        pg8::Gemm g{(const bf16_t*)(ws + WS_G), (const bf16_t*)(ws + WS_WDN), M, D, DFF}; pg8::StaticOrder S; S.init(M, D, G, blockIdx.x);
        { pg8::Unit fu; const int ftid = wid0 * 64 + lane_id(); for (int i = 0; S.next(i, fu); ++i) fix_panel(ap, fu.pm, ftid);
          asm volatile("s_waitcnt vmcnt(0)" ::: "memory"); __syncthreads(); }
        pg8::EpiDownNorm E{ap->out, (const float*)(ws + WS_MOD), ap->in[I_GPOSTFFN], (float*)(ws + WS_XG), (unsigned*)(ws + WS_CNT), (LAS float*)(lds + pg8::STAGE_BYTES)};
        pg8::gemm_phase<pg8::EpiDownNorm, true, true>(lds, g, S, E, wid0);
    }
#undef SEAM
}

extern "C" void kernel_launch(void* const* d_in, const int* in_sizes, int n_in, void* d_out, int out_size, void* d_ws, size_t ws_size, hipStream_t stream) {
    static int grid = 0;
    if (grid == 0) {
        if (n_in != 26 || in_sizes[0] != M * D || out_size != M * D || ws_size < WS_END) { fprintf(stderr, "kernel_launch: unexpected shapes (n_in %d, ws %zu)\n", n_in, ws_size); grid = -1; return; }
        int dev = 0, cus = 0, per_cu = 0;
        hipGetDevice(&dev); hipDeviceGetAttribute(&cus, hipDeviceAttributeMultiprocessorCount, dev);
        if (hipFuncSetAttribute((const void*)hymba_fwd, hipFuncAttributeMaxDynamicSharedMemorySize, LDS_BYTES) != hipSuccess) { fprintf(stderr, "kernel_launch: hipFuncSetAttribute failed\n"); }
        if (hipOccupancyMaxActiveBlocksPerMultiprocessor(&per_cu, (const void*)hymba_fwd, 512, LDS_BYTES) != hipSuccess || per_cu < 1) per_cu = 1;
        (void)hipGetLastError();
        grid = cus * per_cu;
        if (grid > 256) grid = 256;
    }
    if (grid < 0) return;
    Args a{};
    for (int i = 0; i < 26; ++i) a.in[i] = (const float*)d_in[i];
    a.out = (float*)d_out; a.ws = (unsigned char*)d_ws;
    (void)hipMemsetAsync((char*)d_ws + WS_BAR, 0, CTL_ZERO, stream);
    a.ph_lo = 0; a.ph_hi = 0;
    void* args[] = {&a};
    hipError_t e = hipLaunchCooperativeKernel((const void*)hymba_fwd, dim3(grid), dim3(512), args, LDS_BYTES, stream);
    if (e != hipSuccess) fprintf(stderr, "cooperative launch failed: %s (grid %d)\n", hipGetErrorString(e), grid);

}
```

```cpp
#include <hip/hip_runtime.h>
#include <hip/hip_cooperative_groups.h>
#include <cstdio>
#include <cstdint>
namespace cg = cooperative_groups;


#define LAS __attribute__((address_space(3)))
typedef unsigned short bf16_t;
typedef short bf16x8 __attribute__((ext_vector_type(8)));
typedef float f32x4 __attribute__((ext_vector_type(4)));
typedef float f32x16 __attribute__((ext_vector_type(16)));
typedef unsigned u32x4 __attribute__((ext_vector_type(4)));
typedef unsigned u32x2 __attribute__((ext_vector_type(2)));

constexpr int NB = 8, SEQ = 4096, D = 1024, M = NB * SEQ;
constexpr int DSSM = 512, DIN = 2048, DFF = 2816, NUP = 2 * DFF, NMOD = 6 * D;
constexpr int NGRP = 32, TCH = 16, NCH = SEQ / TCH;
constexpr float EPS = 1e-6f;

constexpr size_t MiB = 1u << 20;
constexpr size_t WS_MOD = 0, WS_WIN = 1 * MiB, WS_GLU = 5 * MiB, WS_WOUT = 6 * MiB, WS_WUP = 8 * MiB, WS_WDN = 19 * MiB,
                 WS_HT = 25 * MiB, WS_SS = 36 * MiB, WS_H = 68 * MiB, WS_PROJ = 132 * MiB, WS_Z = 260 * MiB, WS_Y = 292 * MiB,
                 WS_T = 356 * MiB, WS_G = 132 * MiB, WS_TAB = 420 * MiB, WS_XG = 426 * MiB, WS_END = 428 * MiB;
constexpr int TAB_KTAB = 0, TAB_M3 = 8704, TAB_M2 = 76288, TAB_LAMT = 145920, TAB_BYTES = 146432;

constexpr size_t WS_CNT = 512 * 1024 + 16384;
constexpr size_t CTL_ZERO = 16384 + 3 * 128 * 256;
constexpr size_t WS_BAR = 512 * 1024;
constexpr size_t WS_U = WS_PROJ;
constexpr int L_BARST = 152064, LDS_BYTES = 152080;

__device__ __forceinline__ unsigned pk2(float lo, float hi) { unsigned r; asm("v_cvt_pk_bf16_f32 %0, %1, %2" : "=v"(r) : "v"(lo), "v"(hi)); return r; }
__device__ __forceinline__ float bflo(unsigned w) { return __uint_as_float(w << 16); }
__device__ __forceinline__ float bfhi(unsigned w) { return __uint_as_float(w & 0xffff0000u); }
__device__ __forceinline__ float bf1(bf16_t h) { return __uint_as_float(((unsigned)h) << 16); }
__device__ __forceinline__ float wave_sum(float v) {
#pragma unroll
    for (int o = 1; o < 64; o <<= 1) v += __shfl_xor(v, o);
    return v;
}
__device__ __forceinline__ float sigmoidf_(float x) { return __builtin_amdgcn_rcpf(1.0f + __expf(-x)); }
__device__ __forceinline__ float siluf_(float x) { return x * __builtin_amdgcn_rcpf(1.0f + __expf(-x)); }
__device__ __forceinline__ float gelu_tanh(float y) {
    const float y2 = y * y;
    const float t = y * (-2.302208198f + -0.1029432397f * y2);
    return y * __builtin_amdgcn_rcpf(1.0f + __builtin_amdgcn_exp2f(t));
}
__device__ __forceinline__ int lane_id() { return (int)__builtin_amdgcn_mbcnt_hi(~0u, __builtin_amdgcn_mbcnt_lo(~0u, 0u)); }
#define LDS_WAIT() asm volatile("s_waitcnt lgkmcnt(0)" ::: "memory")

namespace pg8 {
constexpr int BM = 256, BK = 64, HALF = 128, HTB = HALF * BK * 2, STAGE_BYTES = 8 * HTB, NXCD = 8, WGM = 8;
__host__ __device__ __forceinline__ int lds_byte(int r, int c) { const int st = (r >> 4) * 2 + (c >> 5), rr = r & 15, cc = c & 31, ob = rr * 64 + cc * 2; return st * 1024 + (ob ^ (((ob >> 9) & 1) << 5)); }
__host__ __device__ __forceinline__ void stage_rc(int b, int& R, int& C) { const int st = b / 1024, sb = b % 1024, swz = sb ^ (((sb >> 9) & 1) << 5); R = (st >> 1) * 16 + swz / 64; C = (st & 1) * 32 + (swz % 64) / 2; }
__host__ __device__ __forceinline__ int perm32(int rho) { const int n = rho >> 4, i = rho & 15; return 8 * (i >> 2) + 4 * n + (i & 3); }
struct Unit { int pm, pn; };
struct Gemm { const bf16_t* A; const bf16_t* Bt; int M, N, K; };
struct StaticOrder {
    int nM, nN, nwg, G, c;
    __device__ void init(int M_, int N_, int G_, int c_) { nM = M_ / BM; nN = N_ / BM; nwg = nM * nN; G = G_; c = c_; }
    __device__ bool next(int i, Unit& u) const {
        const long L = (long)i * G + c; if (L >= nwg) return false;
        int wgid = (int)L; { const int q = nwg / NXCD, r = nwg % NXCD, xcd = wgid % NXCD, off = wgid / NXCD; wgid = (xcd < r ? xcd * (q + 1) : r * (q + 1) + (xcd - r) * q) + off; }
        const int nig = WGM * nN, gid = wgid / nig, fm = gid * WGM, gsz = (nM - fm) < WGM ? (nM - fm) : WGM;
        u.pm = fm + ((wgid % nig) % gsz); u.pn = (wgid % nig) / gsz; return true;
    }
};

template <class Epi, bool ALIGN_EPI, bool SP2>
__device__ __forceinline__ void gemm_phase(LAS unsigned char* lds, const Gemm g, const StaticOrder& S, const Epi& E, int wid0) {
    int tid_ = wid0 * 64 + lane_id(); asm volatile("" : "+v"(tid_));
    const int tid = tid_, wid = __builtin_amdgcn_readfirstlane(tid >> 6), lane = tid & 63, wr = wid >> 2, wc = wid & 3, fr = lane & 15, fq = lane >> 4;
    const int K = g.K, nt = K / BK;
    unsigned voffA[2], voffB[2];
#pragma unroll
    for (int i = 0; i < 2; ++i) { int R, C; stage_rc(tid * 16 + i * 8192, R, C); const int Rb = Epi::PERM ? ((R & ~31) + perm32(R & 31)) : R;
        const int Ra = Epi::PERM_A ? ((R & ~63) + 4 * (R & 15) + ((R >> 4) & 3)) : R;
        voffA[i] = (unsigned)(Ra * K + C) * 2u; voffB[i] = (unsigned)(Rb * K + C) * 2u; }
    const size_t kstep = (size_t)(BK * 2);
    const size_t hstep = (size_t)HALF * K * 2;
    const size_t tstep = 2 * hstep;
    const unsigned ldsw = (unsigned)wid * 1024u;
    const int aoff = lds_byte(wr * 64 + fr, fq * 8), boff = lds_byte(wc * 32 + fr, fq * 8);
#define PG8_SA(b, h) (((b) * 2 + (h)) * HTB)
#define PG8_SB(b, h) ((4 + (b) * 2 + (h)) * HTB)
#define PG8_STAGE(bufoff, gbase, voff) do { _Pragma("unroll") for (int _i = 0; _i < 2; ++_i) \
        __builtin_amdgcn_global_load_lds((const unsigned*)((const char*)(gbase) + (voff)[_i]), (LAS unsigned*)(lds + (bufoff) + ldsw + _i * 8192), 16, 0, 0); } while (0)
#define PG8_LDA(dst, b, h) do { _Pragma("unroll") for (int m = 0; m < 4; ++m) _Pragma("unroll") for (int k = 0; k < 2; ++k) dst[m][k] = *(const LAS bf16x8*)(lds + PG8_SA(b, h) + aoff + m * 2048 + k * 1024); } while (0)
#define PG8_LDB(dst, b, h) do { _Pragma("unroll") for (int n = 0; n < 2; ++n) _Pragma("unroll") for (int k = 0; k < 2; ++k) dst[n][k] = *(const LAS bf16x8*)(lds + PG8_SB(b, h) + boff + n * 2048 + k * 1024); } while (0)
#define PG8_MMA(ai, bj, At, Bt) do { __builtin_amdgcn_s_setprio(1); _Pragma("unroll") for (int m = 0; m < 4; ++m) _Pragma("unroll") for (int n = 0; n < 2; ++n) _Pragma("unroll") for (int k = 0; k < 2; ++k) \
        acc[ai][bj][m][n] = __builtin_amdgcn_mfma_f32_16x16x32_bf16(Bt[n][k], At[m][k], acc[ai][bj][m][n], 0, 0, 0); __builtin_amdgcn_s_setprio(0); } while (0)
#define PG8_WAIT_V(n) asm volatile("s_waitcnt vmcnt(" #n ")" ::: "memory")
#define PG8_WAIT_L(n) asm volatile("s_waitcnt lgkmcnt(" #n ")" ::: "memory")
#define PG8_BAR __builtin_amdgcn_s_barrier()
#define PG8_SCHED __builtin_amdgcn_sched_barrier(0)
    Unit cur, nxt; int ui = 0;
    if (!S.next(0, cur)) return;
    f32x4 acc[2][2][4][2];
#pragma unroll
    for (int a = 0; a < 2; ++a)
#pragma unroll
        for (int b = 0; b < 2; ++b)
#pragma unroll
            for (int m = 0; m < 4; ++m)
#pragma unroll
                for (int n = 0; n < 2; ++n) acc[a][b][m][n] = (f32x4){0.f, 0.f, 0.f, 0.f};
    bf16x8 At[4][2], B0[2][2], B1[2][2];
    const char* cA = (const char*)g.A + (size_t)cur.pm * tstep; const char* cB = (const char*)g.Bt + (size_t)cur.pn * tstep;
    E.begin(cur);
    if constexpr (SP2) {
        PG8_STAGE(PG8_SB(0, 0), cB, voffB); PG8_STAGE(PG8_SB(0, 1), cB + hstep, voffB); PG8_STAGE(PG8_SA(0, 0), cA, voffA); PG8_STAGE(PG8_SA(0, 1), cA + hstep, voffA);
        if (wr == 1) PG8_BAR;
        PG8_WAIT_V(2); PG8_BAR;
        PG8_STAGE(PG8_SB(1, 0), cB + kstep, voffB); PG8_STAGE(PG8_SA(1, 0), cA + kstep, voffA); PG8_STAGE(PG8_SB(1, 1), cB + hstep + kstep, voffB);
        PG8_WAIT_V(6); PG8_BAR;
    } else {
        PG8_STAGE(PG8_SB(0, 0), cB, voffB); PG8_STAGE(PG8_SA(0, 0), cA, voffA); PG8_STAGE(PG8_SB(0, 1), cB + hstep, voffB); PG8_STAGE(PG8_SA(0, 1), cA + hstep, voffA);
        if (wr == 1) PG8_BAR;
        PG8_WAIT_V(4); PG8_BAR;
        PG8_STAGE(PG8_SB(1, 0), cB + kstep, voffB); PG8_STAGE(PG8_SA(1, 0), cA + kstep, voffA); PG8_STAGE(PG8_SB(1, 1), cB + hstep + kstep, voffB);
        PG8_WAIT_V(6); PG8_BAR;
    }
    for (;;) {
        const bool has_next = S.next(ui + 1, nxt);
        const char* nA = has_next ? (const char*)g.A + (size_t)nxt.pm * tstep : cA; const char* nB = has_next ? (const char*)g.Bt + (size_t)nxt.pn * tstep : cB;
        for (int t = 0; t < nt; t += 2) {
            const bool last = (t == nt - 2);
            const char* a1 = cA + (size_t)(t + 1) * kstep;
            const char* a2 = last ? nA : cA + (size_t)(t + 2) * kstep; const char* b2 = last ? nB : cB + (size_t)(t + 2) * kstep;
            const char* a3 = a2 + kstep; const char* b3 = b2 + kstep;
            if constexpr (SP2) {
            PG8_LDB(B0, 0, 0); PG8_LDB(B1, 0, 1); PG8_SCHED; PG8_LDA(At, 0, 0); PG8_STAGE(PG8_SA(1, 1), a1 + hstep, voffA);
            PG8_WAIT_V(8); PG8_WAIT_L(0); PG8_BAR; PG8_MMA(0, 0, At, B0); PG8_MMA(0, 1, At, B1); PG8_BAR; PG8_SCHED;
            PG8_LDA(At, 0, 1); PG8_STAGE(PG8_SB(0, 0), b2, voffB); PG8_STAGE(PG8_SB(0, 1), b2 + hstep, voffB); PG8_STAGE(PG8_SA(0, 0), a2, voffA);
            PG8_WAIT_V(8); PG8_WAIT_L(0); PG8_BAR; PG8_MMA(1, 0, At, B0); PG8_MMA(1, 1, At, B1); PG8_BAR; PG8_SCHED;
            PG8_LDB(B0, 1, 0); PG8_LDB(B1, 1, 1); PG8_SCHED; PG8_LDA(At, 1, 0); PG8_STAGE(PG8_SA(0, 1), a2 + hstep, voffA);
            PG8_WAIT_V(8); PG8_WAIT_L(0); PG8_BAR; PG8_MMA(0, 0, At, B0); PG8_MMA(0, 1, At, B1); PG8_BAR; PG8_SCHED;
            PG8_LDA(At, 1, 1); PG8_STAGE(PG8_SB(1, 0), b3, voffB); PG8_STAGE(PG8_SB(1, 1), b3 + hstep, voffB); PG8_STAGE(PG8_SA(1, 0), a3, voffA);
            PG8_WAIT_V(8); PG8_WAIT_L(0); PG8_BAR; PG8_MMA(1, 0, At, B0); PG8_MMA(1, 1, At, B1); PG8_BAR; PG8_SCHED;
            } else {
            PG8_LDB(B0, 0, 0); PG8_SCHED; PG8_LDA(At, 0, 0); PG8_STAGE(PG8_SA(1, 1), a1 + hstep, voffA);
            PG8_WAIT_L(8); PG8_BAR; PG8_WAIT_L(0); PG8_MMA(0, 0, At, B0); PG8_BAR; PG8_SCHED;
            PG8_LDB(B1, 0, 1); PG8_STAGE(PG8_SB(0, 0), b2, voffB);
            PG8_BAR; PG8_WAIT_L(0); PG8_MMA(0, 1, At, B1); PG8_BAR;
            PG8_LDA(At, 0, 1); PG8_STAGE(PG8_SA(0, 0), a2, voffA);
            PG8_BAR; PG8_WAIT_L(0); PG8_MMA(1, 0, At, B0); PG8_BAR; PG8_SCHED;
            PG8_STAGE(PG8_SB(0, 1), b2 + hstep, voffB);
            PG8_WAIT_V(6); PG8_BAR; PG8_MMA(1, 1, At, B1); PG8_BAR;
            PG8_LDB(B0, 1, 0); PG8_SCHED; PG8_LDA(At, 1, 0); PG8_STAGE(PG8_SA(0, 1), a2 + hstep, voffA);
            PG8_WAIT_L(8); PG8_BAR; PG8_WAIT_L(0); PG8_MMA(0, 0, At, B0); PG8_BAR; PG8_SCHED;
            PG8_LDB(B1, 1, 1); PG8_STAGE(PG8_SB(1, 0), b3, voffB);
            PG8_BAR; PG8_WAIT_L(0); PG8_MMA(0, 1, At, B1); PG8_BAR;
            PG8_LDA(At, 1, 1); PG8_STAGE(PG8_SA(1, 0), a3, voffA);
            PG8_BAR; PG8_WAIT_L(0); PG8_MMA(1, 0, At, B0); PG8_BAR; PG8_SCHED;
            PG8_STAGE(PG8_SB(1, 1), b3 + hstep, voffB);
            PG8_WAIT_V(6); PG8_BAR; PG8_MMA(1, 1, At, B1); PG8_BAR;
            }
        }
        if constexpr (ALIGN_EPI) { if (wr == 0) PG8_BAR; }
        E(acc, cur, wr, wc, fr, fq, has_next ? nxt.pn : -1, ui);
        if (!has_next) break;
#pragma unroll
        for (int a = 0; a < 2; ++a)
#pragma unroll
            for (int b = 0; b < 2; ++b)
#pragma unroll
                for (int m = 0; m < 4; ++m)
#pragma unroll
                    for (int n = 0; n < 2; ++n) acc[a][b][m][n] = (f32x4){0.f, 0.f, 0.f, 0.f};
        cur = nxt; cA = nA; cB = nB; ++ui;
        if constexpr (ALIGN_EPI) { if (wr == 1) PG8_BAR; }
    }
    PG8_WAIT_V(0);
    if constexpr (!ALIGN_EPI) { if (wr == 0) PG8_BAR; }
    PG8_BAR;
#undef PG8_SA
#undef PG8_SB
#undef PG8_STAGE
#undef PG8_LDA
#undef PG8_LDB
#undef PG8_MMA
#undef PG8_WAIT_V
#undef PG8_WAIT_L
#undef PG8_SCHED
}

struct EpiGlu {
    static constexpr bool PERM = true, PERM_A = false;
    const bf16_t* Z; bf16_t* Y; const float* glu_b; const float* gss;
    __device__ __forceinline__ void begin(const Unit&) const {}
    __device__ __forceinline__ void operator()(const f32x4 (&acc)[2][2][4][2], const Unit& u, int wr, int wc, int fr, int fq, int, int) const {
        const int row0 = u.pm * BM + wr * 64 + fr, col0 = u.pn * BM + wc * 32 + 8 * fq;
#pragma unroll
        for (int bj = 0; bj < 2; ++bj) {
            const int cb = col0 + bj * HALF;
            const f32x4 b0 = *(const f32x4*)(glu_b + cb), b1 = *(const f32x4*)(glu_b + cb + 4);
            const f32x4 g0 = *(const f32x4*)(gss + cb), g1 = *(const f32x4*)(gss + cb + 4);
#pragma unroll
            for (int ai = 0; ai < 2; ++ai)
#pragma unroll
                for (int m = 0; m < 4; ++m) {
                    const size_t row = (size_t)(row0 + ai * HALF + m * 16);
                    const u32x4 zr = *(const u32x4*)(Z + row * DSSM + cb);
                    float z[8] = {bflo(zr.x), bfhi(zr.x), bflo(zr.y), bfhi(zr.y), bflo(zr.z), bfhi(zr.z), bflo(zr.w), bfhi(zr.w)};
                    float y[8]; float ss = 0.f;
#pragma unroll
                    for (int e = 0; e < 4; ++e) { y[e] = z[e] * sigmoidf_(acc[ai][bj][m][0][e] + b0[e]); y[4 + e] = z[4 + e] * sigmoidf_(acc[ai][bj][m][1][e] + b1[e]); }
#pragma unroll
                    for (int e = 0; e < 8; ++e) ss += y[e] * y[e];
                    ss += __shfl_xor(ss, 16);
                    const float rs = rsqrtf(ss * (1.0f / 16.0f) + EPS);
                    u32x4 w; w.x = pk2(y[0] * rs * g0[0], y[1] * rs * g0[1]); w.y = pk2(y[2] * rs * g0[2], y[3] * rs * g0[3]);
                    w.z = pk2(y[4] * rs * g1[0], y[5] * rs * g1[1]); w.w = pk2(y[6] * rs * g1[2], y[7] * rs * g1[3]);
                    *(u32x4*)(Y + row * D + cb) = w;
                }
        }
    }
};
__device__ __forceinline__ void fmac_shr1(float& o, float src, float w) { asm volatile("s_nop 1\n\tv_fmac_f32_dpp %0, %1, %2 row_shr:1 row_mask:0xf bank_mask:0xf bound_ctrl:1" : "+v"(o) : "v"(src), "v"(w)); }
__device__ __forceinline__ void fmac_shr1b(float& o, float src, float w) { asm volatile("v_fmac_f32_dpp %0, %1, %2 row_shr:1 row_mask:0xf bank_mask:0xf bound_ctrl:1" : "+v"(o) : "v"(src), "v"(w)); }
__device__ __forceinline__ void fmac_shr2(float& o, float src, float w) { asm volatile("v_fmac_f32_dpp %0, %1, %2 row_shr:2 row_mask:0xf bank_mask:0xf bound_ctrl:1" : "+v"(o) : "v"(src), "v"(w)); }
__device__ __forceinline__ void fmac_ror1(float& o, float src, float w) { asm volatile("v_fmac_f32_dpp %0, %1, %2 row_ror:1 row_mask:0xf bank_mask:0xf" : "+v"(o) : "v"(src), "v"(w)); }
__device__ __forceinline__ void fmac_ror2(float& o, float src, float w) { asm volatile("v_fmac_f32_dpp %0, %1, %2 row_ror:2 row_mask:0xf bank_mask:0xf" : "+v"(o) : "v"(src), "v"(w)); }
struct EpiUp {
    static constexpr bool PERM = true, PERM_A = false;
    bf16_t* G; float* HT; const float* fcw; LAS float* xb;
    __device__ __forceinline__ void begin(const Unit& u) const {
        const int tq = __builtin_amdgcn_readfirstlane(threadIdx.x >> 6) * 64 + lane_id();
        const int c0w = tq & 255, oc0 = (c0w < 128 ? 0 : DFF - 128) + u.pn * HALF + c0w;
        LAS float* wt = xb + 2048;
        wt[tq] = fcw[(size_t)(tq >> 8) * NUP + oc0]; if (tq < 256) wt[512 + tq] = fcw[2 * (size_t)NUP + oc0];
    }
    __device__ __forceinline__ void operator()(f32x4 (&acc)[2][2][4][2], const Unit& u, int wr, int wc, int fr_, int fq_, int next_pn, int ui) const {
        int lq = lane_id(); asm volatile("" : "+v"(lq));
        const int fr = lq & 15, fq = (lq >> 4) & 3;
        const int ct0 = wc * 32 + 8 * fq;
        LAS float* wt = xb + 2048 + (ui & 1) * 768;
        LAS float* wtn = xb + 2048 + ((ui + 1) & 1) * 768;
        const int tq = (wr * 4 + wc) * 64 + lq;
        const int c0w = tq & 255, oc0 = (c0w < 128 ? 0 : DFF - 128) + (next_pn < 0 ? 0 : next_pn) * HALF + c0w;
        const float wq0 = fcw[(size_t)(tq >> 8) * NUP + oc0];
        const float wq1 = (tq < 256) ? fcw[2 * (size_t)NUP + oc0] : 0.f;
        if (fr >= 14) {
#pragma unroll
            for (int ai = 0; ai < 2; ++ai)
#pragma unroll
                for (int bj = 0; bj < 2; ++bj)
#pragma unroll
                    for (int n = 0; n < 2; ++n) *(LAS f32x4*)(xb + ((ai * 2 + wr) * 2 + (fr - 14)) * 256 + bj * HALF + ct0 + 4 * n) = acc[ai][bj][3][n];
        }
        if (wr == 0 && fr < 2) {
            float* hp = HT + ((size_t)u.pm * 4 + fr) * NUP + (size_t)u.pn * 256 + ct0;
#pragma unroll
            for (int bj = 0; bj < 2; ++bj)
#pragma unroll
                for (int n = 0; n < 2; ++n) *(f32x4*)(hp + bj * HALF + 4 * n) = acc[0][bj][0][n];
        }
        if (wr == 1 && fr >= 14) {
            float* hp = HT + ((size_t)u.pm * 4 + 2 + (fr - 14)) * NUP + (size_t)u.pn * 256 + ct0;
#pragma unroll
            for (int bj = 0; bj < 2; ++bj)
#pragma unroll
                for (int n = 0; n < 2; ++n) *(f32x4*)(hp + bj * HALF + 4 * n) = acc[1][bj][3][n];
        }
        LDS_WAIT(); __builtin_amdgcn_s_barrier(); asm volatile("" ::: "memory");
#pragma unroll
        for (int bj = 0; bj < 2; ++bj)
#pragma unroll
            for (int n = 0; n < 2; ++n) {
                __builtin_amdgcn_sched_barrier(0);
                const int tc = bj * HALF + ct0 + 4 * n;
                const f32x4 w0 = *(const LAS f32x4*)(wt + tc), w1 = *(const LAS f32x4*)(wt + 256 + tc), w2 = *(const LAS f32x4*)(wt + 512 + tc);
                const int b0 = wr, b1 = 2 + wr;
                const f32x4 q14 = *(const LAS f32x4*)(xb + ((b0 > 0 ? b0 - 1 : 0) * 2 + 0) * 256 + tc), q15 = *(const LAS f32x4*)(xb + ((b0 > 0 ? b0 - 1 : 0) * 2 + 1) * 256 + tc);
                const f32x4 s14 = *(const LAS f32x4*)(xb + ((b1 - 1) * 2 + 0) * 256 + tc), s15 = *(const LAS f32x4*)(xb + ((b1 - 1) * 2 + 1) * 256 + tc);
#pragma unroll
                for (int e = 0; e < 4; ++e) {
                    const float w1m = (fr == 0) ? w1[e] : 0.f, w0m = (fr < 2) ? w0[e] : 0.f;
#pragma unroll
                    for (int ai = 0; ai < 2; ++ai) {
                        const float r14 = ai ? s14[e] : q14[e], r15 = ai ? s15[e] : q15[e];
                        float h = w1m * r15 + w0m * ((fr == 0) ? r14 : r15);
                        if (ai == 0 && b0 == 0) h = 0.f;
#pragma unroll
                        for (int m = 3; m >= 0; --m) {
                            const float cur = acc[ai][bj][m][n][e];
                            float v = w2[e] * cur;
                            fmac_shr1(v, cur, w1[e]); fmac_shr2(v, cur, w0[e]);
                            if (m > 0) { const float pb = acc[ai][bj][m - 1][n][e]; fmac_ror1(v, pb, w1m); fmac_ror2(v, pb, w0m); }
                            else v += h;
                            acc[ai][bj][m][n][e] = v;
                        }
                    }
                }
            }
        const int row0 = u.pm * BM + wr * 64 + fr, col0 = u.pn * HALF + ct0;
#pragma unroll
        for (int ai = 0; ai < 2; ++ai)
#pragma unroll
            for (int m = 0; m < 4; ++m) {
                __builtin_amdgcn_sched_barrier(0);
                const f32x4 a0 = acc[ai][0][m][0], a1 = acc[ai][0][m][1], v0 = acc[ai][1][m][0], v1 = acc[ai][1][m][1];
                u32x4 w; w.x = pk2(siluf_(a0[0]) * v0[0], siluf_(a0[1]) * v0[1]); w.y = pk2(siluf_(a0[2]) * v0[2], siluf_(a0[3]) * v0[3]);
                w.z = pk2(siluf_(a1[0]) * v1[0], siluf_(a1[1]) * v1[1]); w.w = pk2(siluf_(a1[2]) * v1[2], siluf_(a1[3]) * v1[3]);
                *(u32x4*)(G + (size_t)(row0 + ai * HALF + m * 16) * DFF + col0) = w;
            }
        wtn[tq] = wq0; if (tq < 256) wtn[512 + tq] = wq1;
    }
};

__device__ __forceinline__ void panel_rms(const f32x4 (&v)[2][2][4][2], const Unit& u, int wr, int wc, int fr, int fq, int tid, float* xg, unsigned* cnt, LAS float* tab) {
#pragma unroll
    for (int ai = 0; ai < 2; ++ai)
#pragma unroll
        for (int m = 0; m < 4; ++m) { float ss = 0.f;
#pragma unroll
            for (int bj = 0; bj < 2; ++bj)
#pragma unroll
                for (int n = 0; n < 2; ++n) { const f32x4 x = v[ai][bj][m][n]; ss += (x[0] * x[0] + x[1] * x[1]) + (x[2] * x[2] + x[3] * x[3]); }
            ss += __shfl_xor(ss, 16); ss += __shfl_xor(ss, 32);
            if (fq == 0) tab[(ai * HALF + wr * 64 + m * 16 + fr) * 4 + wc] = ss; }
    LDS_WAIT(); __builtin_amdgcn_s_barrier(); asm volatile("" ::: "memory");
    if (tid < 256) { const f32x4 p = *(const LAS f32x4*)(tab + tid * 4);
        __hip_atomic_store(xg + ((size_t)u.pm * 256 + tid) * 4 + u.pn, (p[0] + p[1]) + (p[2] + p[3]), __ATOMIC_RELAXED, __HIP_MEMORY_SCOPE_AGENT);
        asm volatile("s_waitcnt vmcnt(0)" ::: "memory");
        if ((tid & 63) == 0) __hip_atomic_fetch_add(cnt + 64 * u.pm, 1u, __ATOMIC_RELAXED, __HIP_MEMORY_SCOPE_AGENT); }
    if (tid < 64) { unsigned sp = 0;
        while ((unsigned)__builtin_amdgcn_readfirstlane(__hip_atomic_load(cnt + 64 * u.pm, __ATOMIC_RELAXED, __HIP_MEMORY_SCOPE_AGENT)) < 16u) { __builtin_amdgcn_s_sleep(1); if (++sp > (1u << 20)) break; }
        __builtin_amdgcn_fence(__ATOMIC_ACQUIRE, "agent"); asm volatile("s_waitcnt vmcnt(0)" ::: "memory"); }
    asm volatile("" ::: "memory"); __builtin_amdgcn_s_barrier(); asm volatile("" ::: "memory");
    if (tid < 256) { const float* q = xg + ((size_t)u.pm * 256 + tid) * 4; float s = 0.f;
#pragma unroll
        for (int k = 0; k < 4; ++k) s += __hip_atomic_load(q + k, __ATOMIC_RELAXED, __HIP_MEMORY_SCOPE_AGENT);
        tab[1024 + tid] = rsqrtf(s * (1.0f / D) + EPS); }
    LDS_WAIT(); __builtin_amdgcn_s_barrier(); asm volatile("" ::: "memory");
}
struct EpiDownNorm {
    static constexpr bool PERM = true, PERM_A = false;
    float* out; const float* mod; const float* gpost; float* xg; unsigned* cnt; LAS float* tab;
    __device__ __forceinline__ void begin(const Unit&) const {}
    __device__ __forceinline__ void operator()(const f32x4 (&acc)[2][2][4][2], const Unit& u, int wr, int wc, int fr_, int fq_, int, int) const {
        int lq = lane_id(); asm volatile("" : "+v"(lq));
        const int fr = lq & 15, fq = (lq >> 4) & 3, tid = (wr * 4 + wc) * 64 + lq;
        panel_rms(acc, u, wr, wc, fr, fq, tid, xg, cnt, tab);
        const int row0 = u.pm * BM + wr * 64 + fr, col0 = u.pn * BM + wc * 32 + 8 * fq, b = u.pm >> 4;
#pragma unroll
        for (int bj = 0; bj < 2; ++bj) {
            __builtin_amdgcn_sched_barrier(0);
            const int cb = col0 + bj * HALF;
            const f32x4 c0 = *(const f32x4*)(mod + b * NMOD + 5 * D + cb) * *(const f32x4*)(gpost + cb), c1 = *(const f32x4*)(mod + b * NMOD + 5 * D + cb + 4) * *(const f32x4*)(gpost + cb + 4);
#pragma unroll
            for (int ai = 0; ai < 2; ++ai)
#pragma unroll
                for (int m = 0; m < 4; ++m) { const int rl = ai * HALF + wr * 64 + m * 16 + fr; const float rs = tab[1024 + rl];
                    float* op = out + (size_t)(row0 + ai * HALF + m * 16) * D + cb;
                    const f32x4 x0 = *(const f32x4*)op, x1 = *(const f32x4*)(op + 4);
                    *(f32x4*)op = x0 + c0 * (acc[ai][bj][m][0] * rs); *(f32x4*)(op + 4) = x1 + c1 * (acc[ai][bj][m][1] * rs); }
        }
    }
};

struct EpiOutNorm {
    static constexpr bool PERM = true, PERM_A = false;
    const float* x; float* out; bf16_t* H; const float* mod; const float* gpostmix; const float* gpreffn; float* xg; unsigned* cnt; LAS float* tab;
    __device__ __forceinline__ void begin(const Unit&) const {}
    __device__ __forceinline__ void operator()(f32x4 (&acc)[2][2][4][2], const Unit& u, int wr, int wc, int fr_, int fq_, int, int) const {
        int lq = lane_id(); asm volatile("" : "+v"(lq));
        const int fr = lq & 15, fq = (lq >> 4) & 3, tid = (wr * 4 + wc) * 64 + lq;
        panel_rms(acc, u, wr, wc, fr, fq, tid, xg, cnt, tab);
        const int row0 = u.pm * BM + wr * 64 + fr, col0 = u.pn * BM + wc * 32 + 8 * fq, b = u.pm >> 4;
        const float* mb = mod + b * NMOD;
#pragma unroll
        for (int bj = 0; bj < 2; ++bj) {
            __builtin_amdgcn_sched_barrier(0);
            const int cb = col0 + bj * HALF;
            const f32x4 c0 = *(const f32x4*)(mb + 2 * D + cb) * *(const f32x4*)(gpostmix + cb), c1 = *(const f32x4*)(mb + 2 * D + cb + 4) * *(const f32x4*)(gpostmix + cb + 4);
#pragma unroll
            for (int ai = 0; ai < 2; ++ai)
#pragma unroll
                for (int m = 0; m < 4; ++m) { const int rl = ai * HALF + wr * 64 + m * 16 + fr; const float rs = tab[1024 + rl];
                    const size_t off = (size_t)(row0 + ai * HALF + m * 16) * D + cb;
                    const f32x4 x0 = *(const f32x4*)(x + off), x1 = *(const f32x4*)(x + off + 4);
                    const f32x4 y0 = x0 + c0 * (acc[ai][bj][m][0] * rs), y1 = x1 + c1 * (acc[ai][bj][m][1] * rs);
                    *(f32x4*)(out + off) = y0; *(f32x4*)(out + off + 4) = y1;
                    acc[ai][bj][m][0] = y0; acc[ai][bj][m][1] = y1; }
        }
        __builtin_amdgcn_sched_barrier(0);
        panel_rms(acc, u, wr, wc, fr, fq, tid, xg + (size_t)M * 4, cnt + 128 * 64, tab);
#pragma unroll
        for (int bj = 0; bj < 2; ++bj) {
            __builtin_amdgcn_sched_barrier(0);
            const int cb = col0 + bj * HALF;
            const f32x4 g0 = *(const f32x4*)(gpreffn + cb) * (*(const f32x4*)(mb + 4 * D + cb) + 1.0f), g1 = *(const f32x4*)(gpreffn + cb + 4) * (*(const f32x4*)(mb + 4 * D + cb + 4) + 1.0f);
            const f32x4 s0 = *(const f32x4*)(mb + 3 * D + cb), s1 = *(const f32x4*)(mb + 3 * D + cb + 4);
#pragma unroll
            for (int ai = 0; ai < 2; ++ai)
#pragma unroll
                for (int m = 0; m < 4; ++m) { const int rl = ai * HALF + wr * 64 + m * 16 + fr; const float rs = tab[1024 + rl];
                    const f32x4 h0 = acc[ai][bj][m][0] * rs * g0 + s0, h1 = acc[ai][bj][m][1] * rs * g1 + s1;
                    u32x4 w; w.x = pk2(h0[0], h0[1]); w.y = pk2(h0[2], h0[3]); w.z = pk2(h1[0], h1[1]); w.w = pk2(h1[2], h1[3]);
                    *(u32x4*)(H + (size_t)(row0 + ai * HALF + m * 16) * D + cb) = w; }
        }
    }
};

struct EpiIn {
    static constexpr bool PERM = true, PERM_A = true;
    bf16_t* Y; bf16_t* U; float* HTI; const float* convw; const float* gconv; LAS float* xb;
    __device__ __forceinline__ void begin(const Unit&) const {
        const int t = __builtin_amdgcn_readfirstlane(threadIdx.x >> 6) * 64 + lane_id();
        LAS float* wl = xb + 512 + 1024;
#pragma unroll
        for (int k = 0; k < 3; ++k) wl[k * 512 + t] = convw[k * 512 + t];
        wl[3 * 512 + t] = gconv[t];
    }
    __device__ __forceinline__ void operator()(f32x4 (&acc)[2][2][4][2], const Unit& u, int wr, int wc, int fr_, int fq_, int, int) const {
        int lq = lane_id(); asm volatile("" : "+v"(lq));
        const int fr = lq & 15, fq = (lq >> 4) & 3;
        const int ch4 = 16 * wc + 4 * fq, gch = 64 * u.pn + ch4;
        LAS float* tab = xb + 512;
        const LAS float* wl = xb + 512 + 1024;
#pragma unroll
        for (int ai = 0; ai < 2; ++ai)
#pragma unroll
            for (int m = 0; m < 4; ++m) acc[ai][0][m][0] = acc[ai][0][m][0] * acc[ai][0][m][1];
        if (fr == 15) {
#pragma unroll
            for (int ai = 0; ai < 2; ++ai) { *(LAS f32x4*)(xb + ((ai * 2 + wr) * 2 + 0) * 64 + ch4) = acc[ai][0][2][0]; *(LAS f32x4*)(xb + ((ai * 2 + wr) * 2 + 1) * 64 + ch4) = acc[ai][0][3][0]; }
        }
        if (wr == 0 && fr == 0) { float* hp = HTI + ((size_t)u.pm * 6) * 512 + gch;
            *(f32x4*)(hp) = acc[0][0][0][0]; *(f32x4*)(hp + 512) = acc[0][0][1][0]; *(f32x4*)(hp + 4 * 512) = acc[0][1][0][0]; *(f32x4*)(hp + 5 * 512) = acc[0][1][1][0]; }
        if (wr == 1 && fr == 15) { float* hp = HTI + ((size_t)u.pm * 6 + 2) * 512 + gch; *(f32x4*)(hp) = acc[1][0][2][0]; *(f32x4*)(hp + 512) = acc[1][0][3][0]; }
        LDS_WAIT(); __builtin_amdgcn_s_barrier(); asm volatile("" ::: "memory");
        const f32x4 w0 = *(const LAS f32x4*)(wl + gch), w1 = *(const LAS f32x4*)(wl + 512 + gch), w2 = *(const LAS f32x4*)(wl + 1024 + gch);
#pragma unroll
        for (int ai = 0; ai < 2; ++ai) {
            __builtin_amdgcn_sched_barrier(0);
            const int blk = ai * 2 + wr, pblk = blk > 0 ? blk - 1 : 0;
            const bool halo = (fr == 0) && (blk > 0);
            const f32x4 h2 = *(const LAS f32x4*)(xb + (pblk * 2 + 0) * 64 + ch4), h3 = *(const LAS f32x4*)(xb + (pblk * 2 + 1) * 64 + ch4);
#pragma unroll
            for (int e = 0; e < 4; ++e) {
                const float w1m = halo ? w1[e] : 0.f, w0m = halo ? w0[e] : 0.f;
                const float c0 = acc[ai][0][0][0][e], c1 = acc[ai][0][1][0][e], c2 = acc[ai][0][2][0][e], c3 = acc[ai][0][3][0][e];
                float o1 = w2[e] * c1 + w1[e] * c0 + w0m * h3[e];
                float o0 = w2[e] * c0 + w1m * h3[e] + w0m * h2[e];
                fmac_shr1(o1, c3, w0[e]); fmac_shr1b(o0, c3, w1[e]); fmac_shr1b(o0, c2, w0[e]);
                acc[ai][0][3][0][e] = acc[ai][1][3][0][e] * (w2[e] * c3 + w1[e] * c2 + w0[e] * c1);
                acc[ai][0][2][0][e] = acc[ai][1][2][0][e] * (w2[e] * c2 + w1[e] * c1 + w0[e] * c0);
                acc[ai][0][1][0][e] = acc[ai][1][1][0][e] * o1; acc[ai][0][0][0][e] = acc[ai][1][0][0][e] * o0;
            }
        }
#pragma unroll
        for (int ai = 0; ai < 2; ++ai)
#pragma unroll
            for (int m = 0; m < 4; ++m) { const f32x4 y = acc[ai][0][m][0]; float ss = (y[0] * y[0] + y[1] * y[1]) + (y[2] * y[2] + y[3] * y[3]);
                ss += __shfl_xor(ss, 16); ss += __shfl_xor(ss, 32);
                if (fq == 0) tab[(ai * HALF + wr * 64 + 4 * fr + m) * 4 + wc] = ss; }
        LDS_WAIT(); __builtin_amdgcn_s_barrier(); asm volatile("" ::: "memory");
        const f32x4 gg = *(const LAS f32x4*)(wl + 1536 + gch);
        const int row0 = u.pm * BM + wr * 64 + 4 * fr;
#pragma unroll
        for (int ai = 0; ai < 2; ++ai)
#pragma unroll
            for (int m = 0; m < 4; ++m) { const int rl = ai * HALF + wr * 64 + 4 * fr + m; const f32x4 pp = *(const LAS f32x4*)(tab + rl * 4);
                const float rs = rsqrtf(((pp[0] + pp[1]) + (pp[2] + pp[3])) * (1.0f / 64.0f) + EPS);
                const f32x4 y = acc[ai][0][m][0] * rs * gg, uu = acc[ai][1][m][1];
                const size_t row = (size_t)(row0 + ai * HALF + m);
                u32x2 wy; wy.x = pk2(y[0], y[1]); wy.y = pk2(y[2], y[3]); *(u32x2*)(Y + row * D + 512 + gch) = wy;
                u32x2 wu; wu.x = pk2(uu[0], uu[1]); wu.y = pk2(uu[2], uu[3]); *(u32x2*)(U + row * DSSM + gch) = wu; }
    }
};
#undef PG8_BAR
}

#define XB_TMO      128
#define XB_XCNT(j)  (256  + 64 * (j))
#define XB_XSUB(j)  (1280 + 64 * (j))
#define XB_XGEN(j)  (2304 + 64 * (j))
#define XB_TOP      3328
#define XB_TOPGEN   3392
#define XCD_BAR_WORDS 3456
#define XB_SPIN_CAP (1u << 18)

__device__ __forceinline__ unsigned xb_ld(unsigned* p)              { return __hip_atomic_load(p, __ATOMIC_RELAXED, __HIP_MEMORY_SCOPE_AGENT); }
__device__ __forceinline__ unsigned xb_add(unsigned* p, unsigned v) { return __hip_atomic_fetch_add(p, v, __ATOMIC_RELAXED, __HIP_MEMORY_SCOPE_AGENT); }
__device__ __forceinline__ unsigned xb_xcc_id() { return (unsigned)__builtin_amdgcn_s_getreg((3 << 11) | 20) & 0xFu; }
#define XB_SPIN(cond, bar) do { unsigned _sp = 0; while (cond) { __builtin_amdgcn_s_sleep(1); \
    if ((++_sp & 255u) == 0u) { if (xb_ld(&(bar)[XB_TMO])) break; if (_sp > XB_SPIN_CAP) { atomicAdd(&(bar)[XB_TMO], 1u); break; } } } } while (0)

struct XcdBarrier {
    unsigned* bar; unsigned x;
    volatile LAS unsigned* st;
};

__device__ __forceinline__ XcdBarrier xcd_barrier_post(unsigned* bar, volatile LAS unsigned* st) {
    XcdBarrier b; b.bar = bar; b.x = xb_xcc_id(); b.st = st;
    if (threadIdx.x == 0) (void)xb_add(&bar[XB_XCNT(b.x)], 1u);
    return b;
}
__device__ __forceinline__ void xcd_barrier_complete(unsigned* bar, unsigned x, unsigned& nloc, unsigned& nx) {
    const unsigned G = gridDim.x * gridDim.y * gridDim.z;
    unsigned sum, cnt, mine, sp = 0u;
    for (;;) {
        sum = 0u; cnt = 0u; mine = 0u;
#pragma unroll
        for (unsigned j = 0; j < 16; ++j) { const unsigned c = xb_ld(&bar[XB_XCNT(j)]); sum += c; cnt += (c > 0u) ? 1u : 0u; mine = (j == x) ? c : mine; }
        if (sum == G) break;
        __builtin_amdgcn_s_sleep(1);
        if ((++sp & 255u) == 0u) { if (xb_ld(&bar[XB_TMO])) break; if (sp > XB_SPIN_CAP) { atomicAdd(&bar[XB_TMO], 1u); break; } }
    }
    nloc = mine > 0u ? mine : 1u; nx = cnt > 0u ? cnt : 1u;
}

__device__ __forceinline__ void xcd_barrier(const XcdBarrier& b) {
    asm volatile("s_waitcnt vmcnt(0)" ::: "memory");
    __syncthreads();
    if (threadIdx.x == 0) {
        unsigned* bar = b.bar;
        __builtin_amdgcn_s_waitcnt(0);
        unsigned nloc = b.st[0], nx = b.st[1];
        if (nloc == 0u) { xcd_barrier_complete(bar, b.x, nloc, nx); b.st[0] = nloc; b.st[1] = nx; }
        const unsigned old = xb_add(&bar[XB_XSUB(b.x)], 1u);
        const unsigned gen = old / nloc;
        if (old + 1u == (gen + 1u) * nloc) {
            __builtin_amdgcn_fence(__ATOMIC_RELEASE, "agent");
            asm volatile("s_waitcnt vmcnt(0)" ::: "memory");
            const unsigned og = xb_add(&bar[XB_TOP], 1u);
            const unsigned tg = og / nx;
            if (og + 1u == (tg + 1u) * nx) xb_add(&bar[XB_TOPGEN], 1u);
            else XB_SPIN(xb_ld(&bar[XB_TOPGEN]) == tg, bar);
            __builtin_amdgcn_fence(__ATOMIC_ACQUIRE, "agent");
            xb_add(&bar[XB_XGEN(b.x)], 1u);
            asm volatile("s_waitcnt vmcnt(0)" ::: "memory");
        } else {
            XB_SPIN(xb_ld(&bar[XB_XGEN(b.x)]) == gen, bar);
            __builtin_amdgcn_fence(__ATOMIC_ACQUIRE, "agent");
            asm volatile("s_waitcnt vmcnt(0)" ::: "memory");
        }
    }
    __syncthreads();
}


struct Args { const float* in[26]; float* out; unsigned char* ws; int ph_lo, ph_hi; };
typedef const __attribute__((address_space(4))) Args* ArgsP;
__device__ __forceinline__ ArgsP opaque_args() { ArgsP p = (ArgsP)__builtin_amdgcn_kernarg_segment_ptr(); asm volatile("" : "+s"(p)); return p; }
enum { I_X = 0, I_C, I_WADA, I_BADA, I_GPREMIX, I_GPOSTMIX, I_WIN, I_LRE, I_LIM, I_LSTEP, I_BRE, I_BIM, I_CRE, I_CIM, I_DSKIP, I_GLUW, I_GLUB,
       I_GOSSM, I_CONVW, I_GOCONV, I_WOUT, I_GPREFFN, I_GPOSTFFN, I_WUP, I_FCW, I_WDN };

__device__ __forceinline__ int win_row(int col) {
    const int sec = col >> 9, within = col & 511, pn = within >> 6, ch = within & 63, wc = ch >> 4, fq = (ch >> 2) & 3, e = ch & 3;
    const int bj = (sec == 0 || sec == 1) ? 1 : 0, n = (sec == 0 || sec == 3) ? 1 : 0;
    return pn * 256 + bj * 128 + wc * 32 + fq * 8 + n * 4 + e;
}
template <bool WIN = false>
__device__ __forceinline__ void transpose_item(const float* W, int K, int N, bf16_t* WT, int drow, int k0, int n0, LAS float* scr, int lane) {
#pragma unroll
    for (int i = 0; i < 32; ++i) { const int kk = 2 * i + (lane >> 5); scr[kk * 33 + (lane & 31)] = W[(size_t)(k0 + kk) * N + n0 + (lane & 31)]; }
    LDS_WAIT();
    const int c = lane & 7;
#pragma unroll
    for (int j = 0; j < 4; ++j) { const int n = (lane >> 3) + 8 * j; const LAS float* s = scr + (8 * c) * 33 + n;
        u32x4 o; o.x = pk2(s[0 * 33], s[1 * 33]); o.y = pk2(s[2 * 33], s[3 * 33]); o.z = pk2(s[4 * 33], s[5 * 33]); o.w = pk2(s[6 * 33], s[7 * 33]);
        *(u32x4*)(WT + (size_t)(WIN ? win_row(n0 + n) : drow + n) * K + k0 + 8 * c) = o; }
    LDS_WAIT();
}

__device__ __forceinline__ void build_tables(ArgsP ap, LAS unsigned char* lds, int g, int tid) {
    LAS float* lamp = (LAS float*)(lds);
    LAS float* bbar = (LAS float*)(lds + 8704);
    LAS float* cc = (LAS float*)(lds + 8704 + 8192);
    unsigned char* img = ap->ws + WS_TAB + (size_t)g * TAB_BYTES;
    __syncthreads();
    const float step = expf(ap->in[I_LSTEP][g]);
    for (int i = tid; i < 17 * 64; i += 512) { const int d = i >> 6, p = i & 63;
        const float lr = fminf(ap->in[I_LRE][g * 64 + p], -1e-4f), li = ap->in[I_LIM][g * 64 + p];
        const float er = expf(lr * step * (float)d); float sn, cs; sincosf(li * step * (float)d, &sn, &cs);
        lamp[i * 2] = er * cs; lamp[i * 2 + 1] = er * sn;
        if (d == 16) { ((float*)(img + TAB_LAMT))[p * 2] = er * cs; ((float*)(img + TAB_LAMT))[p * 2 + 1] = er * sn; } }
    for (int i = tid; i < 64 * 16; i += 512) { const int p = i >> 4;
        const float lr = fminf(ap->in[I_LRE][g * 64 + p], -1e-4f), li = ap->in[I_LIM][g * 64 + p];
        const float ar = lr * step, ai = li * step;
        float sn, cs; sincosf(ai, &sn, &cs); const float em1 = expm1f(ar), ea = em1 + 1.0f; const float sh = sinf(0.5f * ai);
        const float nr = em1 * cs - 2.0f * sh * sh, ni = ea * sn;
        const float den = 1.0f / (lr * lr + li * li);
        const float qr = (nr * lr + ni * li) * den, qi = (ni * lr - nr * li) * den;
        const float br = ap->in[I_BRE][(size_t)g * 1024 + i], bi = ap->in[I_BIM][(size_t)g * 1024 + i];
        bbar[i * 2] = qr * br - qi * bi; bbar[i * 2 + 1] = qr * bi + qi * br; }
    for (int i = tid; i < 16 * 64; i += 512) { const int h = i >> 6, p = i & 63; cc[(p * 16 + h) * 2] = ap->in[I_CRE][(size_t)g * 1024 + i]; cc[(p * 16 + h) * 2 + 1] = ap->in[I_CIM][(size_t)g * 1024 + i]; }
    for (int i = tid; i < 128; i += 512) ((unsigned*)(img + TAB_KTAB))[i] = 0u;
    __syncthreads();
    if (tid < 256) { const int d = tid >> 4, h = tid & 15; float acc[16];
#pragma unroll
        for (int e = 0; e < 16; ++e) acc[e] = 0.f;
        for (int p = 0; p < 64; ++p) { const float lr = lamp[(d * 64 + p) * 2], li = lamp[(d * 64 + p) * 2 + 1], cr = cc[(p * 16 + h) * 2], ci = cc[(p * 16 + h) * 2 + 1];
            const float tr = cr * lr - ci * li, ti = cr * li + ci * lr;
#pragma unroll
            for (int q = 0; q < 8; ++q) { const f32x4 bb = *(const LAS f32x4*)(bbar + p * 32 + 4 * q); acc[2 * q] += tr * bb[0] - ti * bb[1]; acc[2 * q + 1] += tr * bb[2] - ti * bb[3]; } }
        if (d == 0) {
#pragma unroll
            for (int e = 0; e < 16; ++e) if (e == h) acc[e] += ap->in[I_DSKIP][16 * g + h]; }
        u32x4 o0, o1; o0.x = pk2(acc[0], acc[1]); o0.y = pk2(acc[2], acc[3]); o0.z = pk2(acc[4], acc[5]); o0.w = pk2(acc[6], acc[7]);
        o1.x = pk2(acc[8], acc[9]); o1.y = pk2(acc[10], acc[11]); o1.z = pk2(acc[12], acc[13]); o1.w = pk2(acc[14], acc[15]);
        u32x4* dst = (u32x4*)(img + TAB_KTAB + 512 + tid * 32); dst[0] = o0; dst[1] = o1; }
    for (int i = tid; i < 128 * 128; i += 512) { const int n = i >> 7, k = (i & 127) * 2, p = n & 63, j = k >> 4, hp = k & 15;
        const float lr = lamp[((15 - j) * 64 + p) * 2], li = lamp[((15 - j) * 64 + p) * 2 + 1];
        const f32x4 bb = *(const LAS f32x4*)(bbar + (p * 16 + hp) * 2);
        const float v0 = n < 64 ? (lr * bb[0] - li * bb[1]) : (lr * bb[1] + li * bb[0]), v1 = n < 64 ? (lr * bb[2] - li * bb[3]) : (lr * bb[3] + li * bb[2]);
        *(unsigned*)(img + TAB_M3 + n * 528 + k * 2) = pk2(v0, v1); }
    for (int i = tid; i < 256 * 64; i += 512) { const int n = i >> 6, q = (i & 63) * 2, p = q & 63, ii = n >> 4, h = n & 15;
        float v[2];
#pragma unroll
        for (int e = 0; e < 2; ++e) { const float lr = lamp[((ii + 1) * 64 + p + e) * 2], li = lamp[((ii + 1) * 64 + p + e) * 2 + 1], cr = cc[((p + e) * 16 + h) * 2], ci = cc[((p + e) * 16 + h) * 2 + 1];
            v[e] = q < 64 ? (cr * lr - ci * li) : -(cr * li + ci * lr); }
        *(unsigned*)(img + TAB_M2 + n * 272 + q * 2) = pk2(v[0], v[1]); }
    __syncthreads();
}
__device__ __forceinline__ void p0_prologue(ArgsP ap, LAS unsigned char* lds, int wid0) {
    int tid_ = wid0 * 64 + lane_id(); asm volatile("" : "+v"(tid_));
    const int tid = tid_, lane = tid & 63, wave = tid >> 6, G = gridDim.x;
    unsigned char* ws = ap->ws;
    if ((int)blockIdx.x < 96) {
        LAS float* cact = (LAS float*)(lds + 72 * 1024);
        LAS float* red = (LAS float*)(lds + 104 * 1024);
        const float* c = ap->in[I_C];
        for (int i = tid; i < NB * D; i += 512) cact[i] = siluf_(c[i]);
        __syncthreads();
        for (int item = blockIdx.x; item < 96; item += G) {
            const int col = item * 64 + lane, k0 = wave * 128;
            const float* wp = ap->in[I_WADA] + (size_t)k0 * NMOD + col;
            float acc[NB];
#pragma unroll
            for (int b = 0; b < NB; ++b) acc[b] = 0.f;
#pragma unroll 16
            for (int k = 0; k < 128; ++k) { const float w = wp[(size_t)k * NMOD];
#pragma unroll
                for (int b = 0; b < NB; ++b) acc[b] += cact[b * D + k0 + k] * w; }
#pragma unroll
            for (int b = 0; b < NB; ++b) red[(wave * NB + b) * 64 + lane] = acc[b];
            __syncthreads();
            { const int b = wave; float s = ap->in[I_BADA][col];
#pragma unroll
              for (int w = 0; w < 8; ++w) s += red[(w * NB + b) * 64 + lane];
              ((float*)(ws + WS_MOD))[b * NMOD + col] = s; }
            asm volatile("s_waitcnt vmcnt(0)" ::: "memory");
            __syncthreads();
            if (tid == 0) { __builtin_amdgcn_fence(__ATOMIC_RELEASE, "agent"); asm volatile("s_waitcnt vmcnt(0)" ::: "memory");
                __hip_atomic_fetch_add((unsigned*)(ws + WS_BAR) + 64, 1u, __ATOMIC_RELAXED, __HIP_MEMORY_SCOPE_AGENT); }
        }
    }
    for (int w = blockIdx.x; w < 128; w += G) if (w >= 96) build_tables(ap, lds, w - 96, tid);
    LAS float* scr = (LAS float*)(lds + wave * 8704);
    const bool split = (G >= 256);
    if (split && (int)blockIdx.x < 128) return;
    const int gw = (split ? (int)blockIdx.x - 128 : (int)blockIdx.x) * 8 + wave, NGW = (split ? G - 128 : G) * 8;
    constexpr int I1 = 16 * 64, I2 = 8 * 16, I3 = 16 * 32, I4 = 16 * 176, I5 = 44 * 32, NIT = I1 + I2 + I3 + I4 + I5;
    for (int it = gw; it < NIT; it += NGW) {
        int r = it;
        if (r < I1) { const int nb = r % 64, kb = r / 64; transpose_item<true>(ap->in[I_WIN], D, DIN, (bf16_t*)(ws + WS_WIN), 0, 64 * kb, 32 * nb, scr, lane); continue; } r -= I1;
        if (r < I2) { const int nb = r % 16, kb = r / 16; transpose_item(ap->in[I_GLUW], DSSM, DSSM, (bf16_t*)(ws + WS_GLU), 32 * nb, 64 * kb, 32 * nb, scr, lane); continue; } r -= I2;
        if (r < I3) { const int nb = r % 32, kb = r / 32; transpose_item(ap->in[I_WOUT], D, D, (bf16_t*)(ws + WS_WOUT), 32 * nb, 64 * kb, 32 * nb, scr, lane); continue; } r -= I3;
        if (r < I4) { const int nb = r % 176, kb = r / 176; const int n0 = 32 * nb; const int j = n0 < DFF ? n0 : n0 - DFF;
            const int drow = (j / 128) * 256 + (n0 < DFF ? 0 : 128) + (j % 128);
            transpose_item(ap->in[I_WUP], D, NUP, (bf16_t*)(ws + WS_WUP), drow, 64 * kb, n0, scr, lane); continue; } r -= I4;
        { const int nb = r % 32, kb = r / 32; transpose_item(ap->in[I_WDN], DFF, D, (bf16_t*)(ws + WS_WDN), 32 * nb, 64 * kb, 32 * nb, scr, lane); }
    }
}

__device__ __forceinline__ void p1_rows(ArgsP ap, int wid0, bool wait_mod) {
    int tid_ = wid0 * 64 + lane_id(); asm volatile("" : "+v"(tid_));
    const int lane = tid_ & 63, wave = tid_ >> 6, G = gridDim.x;
    const float* mod = (const float*)(ap->ws + WS_MOD);
    bf16_t* H = (bf16_t*)(ap->ws + WS_H);
    if (wait_mod) {
        if (tid_ == 0) { unsigned* cnt = (unsigned*)(ap->ws + WS_BAR) + 64; unsigned sp = 0;
            while (__hip_atomic_load(cnt, __ATOMIC_RELAXED, __HIP_MEMORY_SCOPE_AGENT) < 96u) { __builtin_amdgcn_s_sleep(2); if (++sp > (1u << 22)) break; }
            __builtin_amdgcn_fence(__ATOMIC_ACQUIRE, "agent"); asm volatile("s_waitcnt vmcnt(0)" ::: "memory"); }
        __syncthreads();
    }
    const int vb = (G % 8 == 0) ? (int)(blockIdx.x % 8) * (G / 8) + (int)(blockIdx.x / 8) : (int)blockIdx.x;
    for (int base = (vb * 8 + wave) * 16; base < M; base += G * 8 * 16) {
        const int b = base / SEQ;
        f32x4 gs[4], sh[4];
#pragma unroll
        for (int j = 0; j < 4; ++j) { const int col = 4 * lane + 256 * j;
            const f32x4 g = *(const f32x4*)(ap->in[I_GPREMIX] + col), sc = *(const f32x4*)(mod + b * NMOD + D + col);
            gs[j] = g * (sc + 1.0f); sh[j] = *(const f32x4*)(mod + b * NMOD + col); }
#pragma unroll 1
        for (int rb = 0; rb < 16; rb += 4) {
            f32x4 v[4][4];
#pragma unroll
            for (int r = 0; r < 4; ++r) { const f32x4* xr = (const f32x4*)(ap->in[I_X] + (size_t)(base + rb + r) * D) + lane;
#pragma unroll
                for (int j = 0; j < 4; ++j) v[r][j] = xr[64 * j]; }
#pragma unroll
            for (int r = 0; r < 4; ++r) { const size_t row = base + rb + r; float ss = 0.f;
#pragma unroll
                for (int j = 0; j < 4; ++j) ss += (v[r][j].x * v[r][j].x + v[r][j].y * v[r][j].y) + (v[r][j].z * v[r][j].z + v[r][j].w * v[r][j].w);
                const float rs = rsqrtf(wave_sum(ss) * (1.0f / D) + EPS);
                u32x2* o = (u32x2*)(H + row * D) + lane;
#pragma unroll
                for (int j = 0; j < 4; ++j) { const f32x4 h = v[r][j] * rs * gs[j] + sh[j]; u32x2 w; w.x = pk2(h.x, h.y); w.y = pk2(h.z, h.w); o[64 * j] = w; }
            }
        }
    }
}

constexpr int L_KTAB = 0, L_XS = 8704, L_MT = 78336, L_CARRY = 147968;
constexpr int L_BBAR = L_XS, L_CC = L_XS + 8192, L_LAMP = L_XS + 16384;
__device__ __forceinline__ void ssm_unit(ArgsP ap, LAS unsigned char* lds, int unit, int wid0) {
    int tid_ = wid0 * 64 + lane_id(); asm volatile("" : "+v"(tid_));
    const int tid = tid_, lane = tid & 63, wave = __builtin_amdgcn_readfirstlane(tid >> 6), b = unit & 7, g = unit >> 3;
    const bf16_t* UB = (const bf16_t*)(ap->ws + WS_U);
    bf16_t* Z = (bf16_t*)(ap->ws + WS_Z);
    float* SS = (float*)(ap->ws + WS_SS) + (size_t)unit * NCH * 128;
    const unsigned char* img = ap->ws + WS_TAB + (size_t)g * TAB_BYTES;
    __syncthreads();
    u32x4 t0[2], t1[9], m2r[9];
#pragma unroll
    for (int k = 0; k < 2; ++k) { const int i = tid + 512 * k; if (i < 8704 / 16) t0[k] = ((const u32x4*)(img + TAB_KTAB))[i]; }
#pragma unroll
    for (int k = 0; k < 9; ++k) { const int i = tid + 512 * k; if (i < 67584 / 16) t1[k] = ((const u32x4*)(img + TAB_M3))[i]; }
    const int r32 = lane & 31, hh = lane >> 5, c0 = wave * 32;
    const bf16_t* up = UB + ((size_t)b * SEQ + (size_t)(c0 + r32) * TCH) * DSSM + 16 * g + 8 * hh;
    f32x16 accS[4];
    {
    bf16x8 ufr[16];
#pragma unroll
    for (int j = 0; j < 16; ++j) ufr[j] = *(const bf16x8*)(up + (size_t)j * DSSM);
#pragma unroll
    for (int k = 0; k < 9; ++k) { const int i = tid + 512 * k; if (i < 69632 / 16) m2r[k] = ((const u32x4*)(img + TAB_M2))[i]; }
#pragma unroll
    for (int k = 0; k < 2; ++k) { const int i = tid + 512 * k; if (i < 8704 / 16) ((LAS u32x4*)(lds + L_KTAB))[i] = t0[k]; }
#pragma unroll
    for (int k = 0; k < 9; ++k) { const int i = tid + 512 * k; if (i < 67584 / 16) ((LAS u32x4*)(lds + L_MT))[i] = t1[k]; }
    __syncthreads();
#pragma unroll
    for (int nb = 0; nb < 4; ++nb) {
        __builtin_amdgcn_sched_barrier(0);
#pragma unroll
        for (int e = 0; e < 16; ++e) accS[nb][e] = 0.f;
#pragma unroll
        for (int j = 0; j < 16; ++j) { const bf16x8 bf = *(const LAS bf16x8*)(lds + L_MT + (32 * nb + r32) * 528 + (16 * j + 8 * hh) * 2);
            accS[nb] = __builtin_amdgcn_mfma_f32_32x32x16_bf16(ufr[j], bf, accS[nb], 0, 0, 0); }
    }
    }
    const int p = lane, sb = wave;
    const float ltr = ((const float*)(img + TAB_LAMT))[p * 2], lti = ((const float*)(img + TAB_LAMT))[p * 2 + 1];
    __syncthreads();
    { LAS float* sl = (LAS float*)(lds + L_XS);
#pragma unroll
      for (int nb = 0; nb < 4; ++nb)
#pragma unroll
          for (int e = 0; e < 16; ++e) sl[(c0 + (e & 3) + 8 * (e >> 2) + 4 * hh) * 128 + 32 * nb + r32] = accS[nb][e]; }
    __syncthreads();
    float er[32], ei[32];
    { const LAS float* sp = (const LAS float*)(lds + L_XS) + (32 * sb) * 128 + p;
#pragma unroll
      for (int k = 0; k < 32; ++k) { er[k] = sp[k * 128]; ei[k] = sp[k * 128 + 64]; } }
    __syncthreads();
#pragma unroll
    for (int k = 0; k < 9; ++k) { const int i = tid + 512 * k; if (i < 69632 / 16) ((LAS u32x4*)(lds + L_MT))[i] = m2r[k]; }
    { float xr = 0.f, xi = 0.f;
#pragma unroll
      for (int k = 0; k < 32; ++k) { const float sr = er[k], si = ei[k]; er[k] = xr; ei[k] = xi;
          const float nr = ltr * xr - lti * xi + sr, ni = ltr * xi + lti * xr + si; xr = nr; xi = ni; }
      LAS float* carry = (LAS float*)(lds + L_CARRY);
      carry[(sb * 64 + p) * 2] = xr; carry[(sb * 64 + p) * 2 + 1] = xi; }
    __syncthreads();
    { float l32r = ltr, l32i = lti;
#pragma unroll
      for (int s = 0; s < 5; ++s) { const float nr = l32r * l32r - l32i * l32i, ni = 2.0f * l32r * l32i; l32r = nr; l32i = ni; }
      const LAS float* carry = (const LAS float*)(lds + L_CARRY);
      float xr = 0.f, xi = 0.f;
      for (int s = 0; s < sb; ++s) { const float nr = l32r * xr - l32i * xi + carry[(s * 64 + p) * 2], ni = l32r * xi + l32i * xr + carry[(s * 64 + p) * 2 + 1]; xr = nr; xi = ni; }
      float pr = 1.f, pi = 0.f;
#pragma unroll
      for (int k = 0; k < 32; ++k) { const float vr = er[k] + pr * xr - pi * xi, vi = ei[k] + pr * xi + pi * xr;
          LAS bf16_t* xs = (LAS bf16_t*)(lds + L_XS + (32 * sb + k) * 272);
          const unsigned w = pk2(vr, vi); xs[p] = (bf16_t)(w & 0xffffu); xs[64 + p] = (bf16_t)(w >> 16);
          const float nr = pr * ltr - pi * lti, ni = pr * lti + pi * ltr; pr = nr; pi = ni; } }
    __syncthreads();
    __builtin_amdgcn_sched_barrier(0);
    bf16x8 ufr[16];
    { int l2 = lane_id(); asm volatile("" : "+v"(l2)); const int r2 = l2 & 31, h2 = (l2 >> 5) & 1;
      const bf16_t* up2 = UB + ((size_t)b * SEQ + (size_t)(c0 + r2) * TCH) * DSSM + 16 * g + 8 * h2;
#pragma unroll
      for (int j = 0; j < 16; ++j) ufr[j] = *(const bf16x8*)(up2 + (size_t)j * DSSM); }
#pragma unroll
    for (int half = 0; half < 2; ++half) {
        __builtin_amdgcn_sched_barrier(0);
        f32x16 acc[4];
#pragma unroll
        for (int q = 0; q < 4; ++q)
#pragma unroll
            for (int e = 0; e < 16; ++e) acc[q][e] = 0.f;
#pragma unroll
        for (int j = 0; j < 8 * half + 8; ++j)
#pragma unroll
            for (int q = 0; q < 4; ++q) { const int nb = 4 * half + q;
                if (j <= 2 * nb + 1) { int d1 = 2 * nb - j + (r32 >> 4) + 1; d1 = d1 < 0 ? 0 : d1;
                    const bf16x8 bf = *(const LAS bf16x8*)(lds + L_KTAB + d1 * 512 + (lane & 15) * 32 + 16 * hh);
                    acc[q] = __builtin_amdgcn_mfma_f32_32x32x16_bf16(ufr[j], bf, acc[q], 0, 0, 0); } }
#pragma unroll
        for (int ks = 0; ks < 8; ++ks) { const bf16x8 af = *(const LAS bf16x8*)(lds + L_XS + (c0 + r32) * 272 + (16 * ks + 8 * hh) * 2);
#pragma unroll
            for (int q = 0; q < 4; ++q) { const int nb = 4 * half + q;
                const bf16x8 bf = *(const LAS bf16x8*)(lds + L_MT + (32 * nb + r32) * 272 + (16 * ks + 8 * hh) * 2);
                acc[q] = __builtin_amdgcn_mfma_f32_32x32x16_bf16(af, bf, acc[q], 0, 0, 0); } }
#pragma unroll
        for (int q = 0; q < 4; ++q) { __builtin_amdgcn_sched_barrier(0); const int n = 32 * (4 * half + q) + r32, ii = n >> 4, ch = 16 * g + (n & 15);
#pragma unroll
            for (int e = 0; e < 16; ++e) { const int chunk = c0 + (e & 3) + 8 * (e >> 2) + 4 * hh; const size_t t = (size_t)b * SEQ + (size_t)chunk * TCH + ii;
                Z[t * DSSM + ch] = (bf16_t)(pk2(gelu_tanh(acc[q][e]), 0.f) & 0xffffu); } }
    }
    __syncthreads();
}
__device__ __forceinline__ void fix_conv_rows(ArgsP ap, int wid0) {
    const int lane = lane_id(), G = gridDim.x;
    const float* HTI = (const float*)(ap->ws + WS_HT);
    bf16_t* Y = (bf16_t*)(ap->ws + WS_Y);
    const int ch = 8 * lane;
    for (int it = blockIdx.x * 8 + wid0; it < (M / 256) * 2; it += G * 8) {
        const int pm = it >> 1, r = it & 1;
        if ((pm & 15) == 0) continue;
        const float* hp = HTI + ((size_t)(pm - 1) * 6) * 512 + ch, *hc = HTI + ((size_t)pm * 6) * 512 + ch;
        float yb[8]; float ss = 0.f;
#pragma unroll
        for (int e = 0; e < 8; ++e) {
            const float pm2 = hp[2 * 512 + e], pm1 = hp[3 * 512 + e], p0 = hc[e], p1 = hc[512 + e];
            const float w0 = ap->in[I_CONVW][ch + e], w1 = ap->in[I_CONVW][512 + ch + e], w2 = ap->in[I_CONVW][1024 + ch + e];
            const float cv = r == 0 ? (w0 * pm2 + w1 * pm1 + w2 * p0) : (w0 * pm1 + w1 * p0 + w2 * p1);
            yb[e] = hc[(4 + r) * 512 + e] * cv; ss += yb[e] * yb[e]; }
        ss += __shfl_xor(ss, 1); ss += __shfl_xor(ss, 2); ss += __shfl_xor(ss, 4);
        const float rs = rsqrtf(ss * (1.0f / 64.0f) + EPS);
        u32x4 w;
        w.x = pk2(yb[0] * rs * ap->in[I_GOCONV][ch + 0], yb[1] * rs * ap->in[I_GOCONV][ch + 1]); w.y = pk2(yb[2] * rs * ap->in[I_GOCONV][ch + 2], yb[3] * rs * ap->in[I_GOCONV][ch + 3]);
        w.z = pk2(yb[4] * rs * ap->in[I_GOCONV][ch + 4], yb[5] * rs * ap->in[I_GOCONV][ch + 5]); w.w = pk2(yb[6] * rs * ap->in[I_GOCONV][ch + 6], yb[7] * rs * ap->in[I_GOCONV][ch + 7]);
        *(u32x4*)(Y + ((size_t)pm * 256 + r) * D + 512 + ch) = w;
    }
}
__device__ __forceinline__ void fix_panel(ArgsP ap, int pm, int tid) {
    if ((pm & 15) == 0) return;
    const float* HT = (const float*)(ap->ws + WS_HT);
    const float* fcw = ap->in[I_FCW];
    bf16_t* Gm = (bf16_t*)(ap->ws + WS_G);
    const float* hp = HT + ((size_t)(pm - 1) * 4) * NUP, *hc = HT + ((size_t)pm * 4) * NUP;
    for (int j = tid; j < DFF; j += 512) {
        const int ia = (j >> 7) * 256 + (j & 127), iv = ia + 128;
        const float am2 = hp[2 * NUP + ia], am1 = hp[3 * NUP + ia], a0 = hc[ia], a1 = hc[NUP + ia];
        const float vm2 = hp[2 * NUP + iv], vm1 = hp[3 * NUP + iv], v0 = hc[iv], v1 = hc[NUP + iv];
        const float wa0 = fcw[j], wa1 = fcw[NUP + j], wa2 = fcw[2 * NUP + j], wv0 = fcw[DFF + j], wv1 = fcw[NUP + DFF + j], wv2 = fcw[2 * NUP + DFF + j];
        const float ca0 = wa0 * am2 + wa1 * am1 + wa2 * a0, ca1 = wa0 * am1 + wa1 * a0 + wa2 * a1;
        const float cv0 = wv0 * vm2 + wv1 * vm1 + wv2 * v0, cv1 = wv0 * vm1 + wv1 * v0 + wv2 * v1;
        Gm[((size_t)pm * 256) * DFF + j] = (bf16_t)(pk2(siluf_(ca0) * cv0, 0.f) & 0xffffu);
        Gm[((size_t)pm * 256 + 1) * DFF + j] = (bf16_t)(pk2(siluf_(ca1) * cv1, 0.f) & 0xffffu);
    }
}
__global__ void __launch_bounds__(512, 2) hymba_fwd(Args a_unused) {
    extern __shared__ __attribute__((aligned(16))) unsigned char shm[];
    LAS unsigned char* lds = (LAS unsigned char*)shm;
    cg::grid_group grid = cg::this_grid();
    const int wid0 = __builtin_amdgcn_readfirstlane(threadIdx.x >> 6);
    if (threadIdx.x < 4) ((LAS unsigned*)(lds + L_BARST))[threadIdx.x] = 0u;
    __syncthreads();
    XcdBarrier xbar = xcd_barrier_post((unsigned*)(opaque_args()->ws + WS_BAR), (volatile LAS unsigned*)(lds + L_BARST));
    if (opaque_args()->ph_lo < 0) grid.sync();
    const int G = gridDim.x;
#define SEAM() xcd_barrier(xbar)
    p0_prologue(opaque_args(), lds, wid0);
    p1_rows(opaque_args(), wid0, true);
    SEAM();
    {
        ArgsP ap = opaque_args(); unsigned char* ws = ap->ws;
        pg8::Gemm g{(const bf16_t*)(ws + WS_H), (const bf16_t*)(ws + WS_WIN), M, DIN, D}; pg8::StaticOrder S; S.init(M, DIN, G, blockIdx.x);
        pg8::EpiIn E{(bf16_t*)(ws + WS_Y), (bf16_t*)(ws + WS_U), (float*)(ws + WS_HT), ap->in[I_CONVW], ap->in[I_GOCONV], (LAS float*)(lds + pg8::STAGE_BYTES)};
        pg8::gemm_phase<pg8::EpiIn, true, true>(lds, g, S, E, wid0);
    }
    SEAM();
    fix_conv_rows(opaque_args(), wid0);
    for (int u = blockIdx.x; u < NB * NGRP; u += G) ssm_unit(opaque_args(), lds, u, wid0);
    SEAM();
    {
        ArgsP ap = opaque_args(); unsigned char* ws = ap->ws;
        pg8::Gemm g{(const bf16_t*)(ws + WS_Z), (const bf16_t*)(ws + WS_GLU), M, DSSM, DSSM}; pg8::StaticOrder S; S.init(M, DSSM, G, blockIdx.x);
        pg8::EpiGlu E{(const bf16_t*)(ws + WS_Z), (bf16_t*)(ws + WS_Y), ap->in[I_GLUB], ap->in[I_GOSSM]};
        pg8::gemm_phase<pg8::EpiGlu, true, true>(lds, g, S, E, wid0);
    }
    SEAM();
    {
        ArgsP ap = opaque_args(); unsigned char* ws = ap->ws;
        pg8::Gemm g{(const bf16_t*)(ws + WS_Y), (const bf16_t*)(ws + WS_WOUT), M, D, D}; pg8::StaticOrder S; S.init(M, D, G, blockIdx.x);
        pg8::EpiOutNorm E{ap->in[I_X], ap->out, (bf16_t*)(ws + WS_H), (const float*)(ws + WS_MOD), ap->in[I_GPOSTMIX], ap->in[I_GPREFFN],
                          (float*)(ws + WS_XG) + (size_t)M * 4, (unsigned*)(ws + WS_CNT) + 128 * 64, (LAS float*)(lds + pg8::STAGE_BYTES)};
        pg8::gemm_phase<pg8::EpiOutNorm, true, true>(lds, g, S, E, wid0);
    }
    SEAM();
    {
        ArgsP ap = opaque_args(); unsigned char* ws = ap->ws;
        pg8::Gemm g{(const bf16_t*)(ws + WS_H), (const bf16_t*)(ws + WS_WUP), M, NUP, D}; pg8::StaticOrder S; S.init(M, NUP, G, blockIdx.x);
        pg8::EpiUp E{(bf16_t*)(ws + WS_G), (float*)(ws + WS_HT), ap->in[I_FCW], (LAS float*)(lds + pg8::STAGE_BYTES)};
        pg8::gemm_phase<pg8::EpiUp, true, true>(lds, g, S, E, wid0);
    }
    SEAM();
    {
        ArgsP ap = opaque_args(); unsigned char* ws = ap->ws;
        pg8::Gemm g{(const bf16_t*)(ws + WS_G), (const bf16_t*)(ws + WS_WDN), M, D, DFF}; pg8::StaticOrder S; S.init(M, D, G, blockIdx.x);
        { pg8::Unit fu; const int ftid = wid0 * 64 + lane_id(); for (int i = 0; S.next(i, fu); ++i) fix_panel(ap, fu.pm, ftid);
          asm volatile("s_waitcnt vmcnt(0)" ::: "memory"); __syncthreads(); }
        pg8::EpiDownNorm E{ap->out, (const float*)(ws + WS_MOD), ap->in[I_GPOSTFFN], (float*)(ws + WS_XG), (unsigned*)(ws + WS_CNT), (LAS float*)(lds + pg8::STAGE_BYTES)};
        pg8::gemm_phase<pg8::EpiDownNorm, true, true>(lds, g, S, E, wid0);
    }
#undef SEAM
}

extern "C" void kernel_launch(void* const* d_in, const int* in_sizes, int n_in, void* d_out, int out_size, void* d_ws, size_t ws_size, hipStream_t stream) {
    static int grid = 0;
    if (grid == 0) {
        if (n_in != 26 || in_sizes[0] != M * D || out_size != M * D || ws_size < WS_END) { fprintf(stderr, "kernel_launch: unexpected shapes (n_in %d, ws %zu)\n", n_in, ws_size); grid = -1; return; }
        int dev = 0, cus = 0, per_cu = 0;
        hipGetDevice(&dev); hipDeviceGetAttribute(&cus, hipDeviceAttributeMultiprocessorCount, dev);
        if (hipFuncSetAttribute((const void*)hymba_fwd, hipFuncAttributeMaxDynamicSharedMemorySize, LDS_BYTES) != hipSuccess) { fprintf(stderr, "kernel_launch: hipFuncSetAttribute failed\n"); }
        if (hipOccupancyMaxActiveBlocksPerMultiprocessor(&per_cu, (const void*)hymba_fwd, 512, LDS_BYTES) != hipSuccess || per_cu < 1) per_cu = 1;
        (void)hipGetLastError();
        grid = cus * per_cu;
        if (grid > 256) grid = 256;
    }
    if (grid < 0) return;
    Args a{};
    for (int i = 0; i < 26; ++i) a.in[i] = (const float*)d_in[i];
    a.out = (float*)d_out; a.ws = (unsigned char*)d_ws;
    (void)hipMemsetAsync((char*)d_ws + WS_BAR, 0, CTL_ZERO, stream);
    a.ph_lo = 0; a.ph_hi = 0;
    void* args[] = {&a};
    hipError_t e = hipLaunchCooperativeKernel((const void*)hymba_fwd, dim3(grid), dim3(512), args, LDS_BYTES, stream);
    if (e != hipSuccess) fprintf(stderr, "cooperative launch failed: %s (grid %d)\n", hipGetErrorString(e), grid);

}
```

```cpp
#include <hip/hip_runtime.h>
#include <hip/hip_cooperative_groups.h>
#include <cstdio>
#include <cstdint>
namespace cg = cooperative_groups;


#define LAS __attribute__((address_space(3)))
typedef unsigned short bf16_t;
typedef short bf16x8 __attribute__((ext_vector_type(8)));
typedef float f32x4 __attribute__((ext_vector_type(4)));
typedef float f32x16 __attribute__((ext_vector_type(16)));
typedef unsigned u32x4 __attribute__((ext_vector_type(4)));
typedef unsigned u32x2 __attribute__((ext_vector_type(2)));

constexpr int NB = 8, SEQ = 4096, D = 1024, M = NB * SEQ;
constexpr int DSSM = 512, DIN = 2048, DFF = 2816, NUP = 2 * DFF, NMOD = 6 * D;
constexpr int NGRP = 32, TCH = 16, NCH = SEQ / TCH;
constexpr float EPS = 1e-6f;

constexpr size_t MiB = 1u << 20;
constexpr size_t WS_MOD = 0, WS_WIN = 1 * MiB, WS_GLU = 5 * MiB, WS_WOUT = 6 * MiB, WS_WUP = 8 * MiB, WS_WDN = 19 * MiB,
                 WS_HT = 25 * MiB, WS_SS = 36 * MiB, WS_H = 68 * MiB, WS_PROJ = 132 * MiB, WS_Z = 260 * MiB, WS_Y = 292 * MiB,
                 WS_T = 356 * MiB, WS_G = 132 * MiB, WS_TAB = 420 * MiB, WS_XG = 426 * MiB, WS_END = 428 * MiB;
constexpr int TAB_KTAB = 0, TAB_M3 = 8704, TAB_M2 = 76288, TAB_LAMT = 145920, TAB_BYTES = 146432;

constexpr size_t WS_CNT = 512 * 1024 + 16384;
constexpr size_t CTL_ZERO = 16384 + 3 * 128 * 256;
constexpr size_t WS_BAR = 512 * 1024;
constexpr size_t WS_U = WS_PROJ;
constexpr int L_BARST = 152064, LDS_BYTES = 152080;

__device__ __forceinline__ unsigned pk2(float lo, float hi) { unsigned r; asm("v_cvt_pk_bf16_f32 %0, %1, %2" : "=v"(r) : "v"(lo), "v"(hi)); return r; }
__device__ __forceinline__ float bflo(unsigned w) { return __uint_as_float(w << 16); }
__device__ __forceinline__ float bfhi(unsigned w) { return __uint_as_float(w & 0xffff0000u); }
__device__ __forceinline__ float bf1(bf16_t h) { return __uint_as_float(((unsigned)h) << 16); }
__device__ __forceinline__ float wave_sum(float v) {
#pragma unroll
    for (int o = 1; o < 64; o <<= 1) v += __shfl_xor(v, o);
    return v;
}
__device__ __forceinline__ float sigmoidf_(float x) { return __builtin_amdgcn_rcpf(1.0f + __expf(-x)); }
__device__ __forceinline__ float siluf_(float x) { return x * __builtin_amdgcn_rcpf(1.0f + __expf(-x)); }
__device__ __forceinline__ float gelu_tanh(float y) {
    const float y2 = y * y;
    const float t = y * (-2.302208198f + -0.1029432397f * y2);
    return y * __builtin_amdgcn_rcpf(1.0f + __builtin_amdgcn_exp2f(t));
}
__device__ __forceinline__ int lane_id() { return (int)__builtin_amdgcn_mbcnt_hi(~0u, __builtin_amdgcn_mbcnt_lo(~0u, 0u)); }
#define LDS_WAIT() asm volatile("s_waitcnt lgkmcnt(0)" ::: "memory")

namespace pg8 {
constexpr int BM = 256, BK = 64, HALF = 128, HTB = HALF * BK * 2, STAGE_BYTES = 8 * HTB, NXCD = 8, WGM = 8;
__host__ __device__ __forceinline__ int lds_byte(int r, int c) { const int st = (r >> 4) * 2 + (c >> 5), rr = r & 15, cc = c & 31, ob = rr * 64 + cc * 2; return st * 1024 + (ob ^ (((ob >> 9) & 1) << 5)); }
__host__ __device__ __forceinline__ void stage_rc(int b, int& R, int& C) { const int st = b / 1024, sb = b % 1024, swz = sb ^ (((sb >> 9) & 1) << 5); R = (st >> 1) * 16 + swz / 64; C = (st & 1) * 32 + (swz % 64) / 2; }
__host__ __device__ __forceinline__ int perm32(int rho) { const int n = rho >> 4, i = rho & 15; return 8 * (i >> 2) + 4 * n + (i & 3); }
struct Unit { int pm, pn; };
struct Gemm { const bf16_t* A; const bf16_t* Bt; int M, N, K; };
struct StaticOrder {
    int nM, nN, nwg, G, c;
    __device__ void init(int M_, int N_, int G_, int c_) { nM = M_ / BM; nN = N_ / BM; nwg = nM * nN; G = G_; c = c_; }
    __device__ bool next(int i, Unit& u) const {
        const long L = (long)i * G + c; if (L >= nwg) return false;
        int wgid = (int)L; { const int q = nwg / NXCD, r = nwg % NXCD, xcd = wgid % NXCD, off = wgid / NXCD; wgid = (xcd < r ? xcd * (q + 1) : r * (q + 1) + (xcd - r) * q) + off; }
        const int nig = WGM * nN, gid = wgid / nig, fm = gid * WGM, gsz = (nM - fm) < WGM ? (nM - fm) : WGM;
        u.pm = fm + ((wgid % nig) % gsz); u.pn = (wgid % nig) / gsz; return true;
    }
};

template <class Epi, bool ALIGN_EPI, bool SP2>
__device__ __forceinline__ void gemm_phase(LAS unsigned char* lds, const Gemm g, const StaticOrder& S, const Epi& E, int wid0) {
    int tid_ = wid0 * 64 + lane_id(); asm volatile("" : "+v"(tid_));
    const int tid = tid_, wid = __builtin_amdgcn_readfirstlane(tid >> 6), lane = tid & 63, wr = wid >> 2, wc = wid & 3, fr = lane & 15, fq = lane >> 4;
    const int K = g.K, nt = K / BK;
    unsigned voffA[2], voffB[2];
#pragma unroll
    for (int i = 0; i < 2; ++i) { int R, C; stage_rc(tid * 16 + i * 8192, R, C); const int Rb = Epi::PERM ? ((R & ~31) + perm32(R & 31)) : R;
        const int Ra = Epi::PERM_A ? ((R & ~63) + 4 * (R & 15) + ((R >> 4) & 3)) : R;
        voffA[i] = (unsigned)(Ra * K + C) * 2u; voffB[i] = (unsigned)(Rb * K + C) * 2u; }
    const size_t kstep = (size_t)(BK * 2);
    const size_t hstep = (size_t)HALF * K * 2;
    const size_t tstep = 2 * hstep;
    const unsigned ldsw = (unsigned)wid * 1024u;
    const int aoff = lds_byte(wr * 64 + fr, fq * 8), boff = lds_byte(wc * 32 + fr, fq * 8);
#define PG8_SA(b, h) (((b) * 2 + (h)) * HTB)
#define PG8_SB(b, h) ((4 + (b) * 2 + (h)) * HTB)
#define PG8_STAGE(bufoff, gbase, voff) do { _Pragma("unroll") for (int _i = 0; _i < 2; ++_i) \
        __builtin_amdgcn_global_load_lds((const unsigned*)((const char*)(gbase) + (voff)[_i]), (LAS unsigned*)(lds + (bufoff) + ldsw + _i * 8192), 16, 0, 0); } while (0)
#define PG8_LDA(dst, b, h) do { _Pragma("unroll") for (int m = 0; m < 4; ++m) _Pragma("unroll") for (int k = 0; k < 2; ++k) dst[m][k] = *(const LAS bf16x8*)(lds + PG8_SA(b, h) + aoff + m * 2048 + k * 1024); } while (0)
#define PG8_LDB(dst, b, h) do { _Pragma("unroll") for (int n = 0; n < 2; ++n) _Pragma("unroll") for (int k = 0; k < 2; ++k) dst[n][k] = *(const LAS bf16x8*)(lds + PG8_SB(b, h) + boff + n * 2048 + k * 1024); } while (0)
#define PG8_MMA(ai, bj, At, Bt) do { __builtin_amdgcn_s_setprio(1); _Pragma("unroll") for (int m = 0; m < 4; ++m) _Pragma("unroll") for (int n = 0; n < 2; ++n) _Pragma("unroll") for (int k = 0; k < 2; ++k) \
        acc[ai][bj][m][n] = __builtin_amdgcn_mfma_f32_16x16x32_bf16(Bt[n][k], At[m][k], acc[ai][bj][m][n], 0, 0, 0); __builtin_amdgcn_s_setprio(0); } while (0)
#define PG8_WAIT_V(n) asm volatile("s_waitcnt vmcnt(" #n ")" ::: "memory")
#define PG8_WAIT_L(n) asm volatile("s_waitcnt lgkmcnt(" #n ")" ::: "memory")
#define PG8_BAR __builtin_amdgcn_s_barrier()
#define PG8_SCHED __builtin_amdgcn_sched_barrier(0)
    Unit cur, nxt; int ui = 0;
    if (!S.next(0, cur)) return;
    f32x4 acc[2][2][4][2];
#pragma unroll
    for (int a = 0; a < 2; ++a)
#pragma unroll
        for (int b = 0; b < 2; ++b)
#pragma unroll
            for (int m = 0; m < 4; ++m)
#pragma unroll
                for (int n = 0; n < 2; ++n) acc[a][b][m][n] = (f32x4){0.f, 0.f, 0.f, 0.f};
    bf16x8 At[4][2], B0[2][2], B1[2][2];
    const char* cA = (const char*)g.A + (size_t)cur.pm * tstep; const char* cB = (const char*)g.Bt + (size_t)cur.pn * tstep;
    E.begin(cur);
    if constexpr (SP2) {
        PG8_STAGE(PG8_SB(0, 0), cB, voffB); PG8_STAGE(PG8_SB(0, 1), cB + hstep, voffB); PG8_STAGE(PG8_SA(0, 0), cA, voffA); PG8_STAGE(PG8_SA(0, 1), cA + hstep, voffA);
        if (wr == 1) PG8_BAR;
        PG8_WAIT_V(2); PG8_BAR;
        PG8_STAGE(PG8_SB(1, 0), cB + kstep, voffB); PG8_STAGE(PG8_SA(1, 0), cA + kstep, voffA); PG8_STAGE(PG8_SB(1, 1), cB + hstep + kstep, voffB);
        PG8_WAIT_V(6); PG8_BAR;
    } else {
        PG8_STAGE(PG8_SB(0, 0), cB, voffB); PG8_STAGE(PG8_SA(0, 0), cA, voffA); PG8_STAGE(PG8_SB(0, 1), cB + hstep, voffB); PG8_STAGE(PG8_SA(0, 1), cA + hstep, voffA);
        if (wr == 1) PG8_BAR;
        PG8_WAIT_V(4); PG8_BAR;
        PG8_STAGE(PG8_SB(1, 0), cB + kstep, voffB); PG8_STAGE(PG8_SA(1, 0), cA + kstep, voffA); PG8_STAGE(PG8_SB(1, 1), cB + hstep + kstep, voffB);
        PG8_WAIT_V(6); PG8_BAR;
    }
    for (;;) {
        const bool has_next = S.next(ui + 1, nxt);
        const char* nA = has_next ? (const char*)g.A + (size_t)nxt.pm * tstep : cA; const char* nB = has_next ? (const char*)g.Bt + (size_t)nxt.pn * tstep : cB;
        for (int t = 0; t < nt; t += 2) {
            const bool last = (t == nt - 2);
            const char* a1 = cA + (size_t)(t + 1) * kstep;
            const char* a2 = last ? nA : cA + (size_t)(t + 2) * kstep; const char* b2 = last ? nB : cB + (size_t)(t + 2) * kstep;
            const char* a3 = a2 + kstep; const char* b3 = b2 + kstep;
            if constexpr (SP2) {
            PG8_LDB(B0, 0, 0); PG8_LDB(B1, 0, 1); PG8_SCHED; PG8_LDA(At, 0, 0); PG8_STAGE(PG8_SA(1, 1), a1 + hstep, voffA);
            PG8_WAIT_V(8); PG8_WAIT_L(0); PG8_BAR; PG8_MMA(0, 0, At, B0); PG8_MMA(0, 1, At, B1); PG8_BAR; PG8_SCHED;
            PG8_LDA(At, 0, 1); PG8_STAGE(PG8_SB(0, 0), b2, voffB); PG8_STAGE(PG8_SB(0, 1), b2 + hstep, voffB); PG8_STAGE(PG8_SA(0, 0), a2, voffA);
            PG8_WAIT_V(8); PG8_WAIT_L(0); PG8_BAR; PG8_MMA(1, 0, At, B0); PG8_MMA(1, 1, At, B1); PG8_BAR; PG8_SCHED;
            PG8_LDB(B0, 1, 0); PG8_LDB(B1, 1, 1); PG8_SCHED; PG8_LDA(At, 1, 0); PG8_STAGE(PG8_SA(0, 1), a2 + hstep, voffA);
            PG8_WAIT_V(8); PG8_WAIT_L(0); PG8_BAR; PG8_MMA(0, 0, At, B0); PG8_MMA(0, 1, At, B1); PG8_BAR; PG8_SCHED;
            PG8_LDA(At, 1, 1); PG8_STAGE(PG8_SB(1, 0), b3, voffB); PG8_STAGE(PG8_SB(1, 1), b3 + hstep, voffB); PG8_STAGE(PG8_SA(1, 0), a3, voffA);
            PG8_WAIT_V(8); PG8_WAIT_L(0); PG8_BAR; PG8_MMA(1, 0, At, B0); PG8_MMA(1, 1, At, B1); PG8_BAR; PG8_SCHED;
            } else {
            PG8_LDB(B0, 0, 0); PG8_SCHED; PG8_LDA(At, 0, 0); PG8_STAGE(PG8_SA(1, 1), a1 + hstep, voffA);
            PG8_WAIT_L(8); PG8_BAR; PG8_WAIT_L(0); PG8_MMA(0, 0, At, B0); PG8_BAR; PG8_SCHED;
            PG8_LDB(B1, 0, 1); PG8_STAGE(PG8_SB(0, 0), b2, voffB);
            PG8_BAR; PG8_WAIT_L(0); PG8_MMA(0, 1, At, B1); PG8_BAR;
            PG8_LDA(At, 0, 1); PG8_STAGE(PG8_SA(0, 0), a2, voffA);
            PG8_BAR; PG8_WAIT_L(0); PG8_MMA(1, 0, At, B0); PG8_BAR; PG8_SCHED;
            PG8_STAGE(PG8_SB(0, 1), b2 + hstep, voffB);
            PG8_WAIT_V(6); PG8_BAR; PG8_MMA(1, 1, At, B1); PG8_BAR;
            PG8_LDB(B0, 1, 0); PG8_SCHED; PG8_LDA(At, 1, 0); PG8_STAGE(PG8_SA(0, 1), a2 + hstep, voffA);
            PG8_WAIT_L(8); PG8_BAR; PG8_WAIT_L(0); PG8_MMA(0, 0, At, B0); PG8_BAR; PG8_SCHED;
            PG8_LDB(B1, 1, 1); PG8_STAGE(PG8_SB(1, 0), b3, voffB);
            PG8_BAR; PG8_WAIT_L(0); PG8_MMA(0, 1, At, B1); PG8_BAR;
            PG8_LDA(At, 1, 1); PG8_STAGE(PG8_SA(1, 0), a3, voffA);
            PG8_BAR; PG8_WAIT_L(0); PG8_MMA(1, 0, At, B0); PG8_BAR; PG8_SCHED;
            PG8_STAGE(PG8_SB(1, 1), b3 + hstep, voffB);
            PG8_WAIT_V(6); PG8_BAR; PG8_MMA(1, 1, At, B1); PG8_BAR;
            }
        }
        if constexpr (ALIGN_EPI) { if (wr == 0) PG8_BAR; }
        E(acc, cur, wr, wc, fr, fq, has_next ? nxt.pn : -1, ui);
        if (!has_next) break;
#pragma unroll
        for (int a = 0; a < 2; ++a)
#pragma unroll
            for (int b = 0; b < 2; ++b)
#pragma unroll
                for (int m = 0; m < 4; ++m)
#pragma unroll
                    for (int n = 0; n < 2; ++n) acc[a][b][m][n] = (f32x4){0.f, 0.f, 0.f, 0.f};
        cur = nxt; cA = nA; cB = nB; ++ui;
        if constexpr (ALIGN_EPI) { if (wr == 1) PG8_BAR; }
    }
    PG8_WAIT_V(0);
    if constexpr (!ALIGN_EPI) { if (wr == 0) PG8_BAR; }
    PG8_BAR;
#undef PG8_SA
#undef PG8_SB
#undef PG8_STAGE
#undef PG8_LDA
#undef PG8_LDB
#undef PG8_MMA
#undef PG8_WAIT_V
#undef PG8_WAIT_L
#undef PG8_SCHED
}

struct EpiGlu {
    static constexpr bool PERM = true, PERM_A = false;
    const bf16_t* Z; bf16_t* Y; const float* glu_b; const float* gss;
    __device__ __forceinline__ void begin(const Unit&) const {}
    __device__ __forceinline__ void operator()(const f32x4 (&acc)[2][2][4][2], const Unit& u, int wr, int wc, int fr, int fq, int, int) const {
        const int row0 = u.pm * BM + wr * 64 + fr, col0 = u.pn * BM + wc * 32 + 8 * fq;
#pragma unroll
        for (int bj = 0; bj < 2; ++bj) {
            const int cb = col0 + bj * HALF;
            const f32x4 b0 = *(const f32x4*)(glu_b + cb), b1 = *(const f32x4*)(glu_b + cb + 4);
            const f32x4 g0 = *(const f32x4*)(gss + cb), g1 = *(const f32x4*)(gss + cb + 4);
#pragma unroll
            for (int ai = 0; ai < 2; ++ai)
#pragma unroll
                for (int m = 0; m < 4; ++m) {
                    const size_t row = (size_t)(row0 + ai * HALF + m * 16);
                    const u32x4 zr = *(const u32x4*)(Z + row * DSSM + cb);
                    float z[8] = {bflo(zr.x), bfhi(zr.x), bflo(zr.y), bfhi(zr.y), bflo(zr.z), bfhi(zr.z), bflo(zr.w), bfhi(zr.w)};
                    float y[8]; float ss = 0.f;
#pragma unroll
                    for (int e = 0; e < 4; ++e) { y[e] = z[e] * sigmoidf_(acc[ai][bj][m][0][e] + b0[e]); y[4 + e] = z[4 + e] * sigmoidf_(acc[ai][bj][m][1][e] + b1[e]); }
#pragma unroll
                    for (int e = 0; e < 8; ++e) ss += y[e] * y[e];
                    ss += __shfl_xor(ss, 16);
                    const float rs = rsqrtf(ss * (1.0f / 16.0f) + EPS);
                    u32x4 w; w.x = pk2(y[0] * rs * g0[0], y[1] * rs * g0[1]); w.y = pk2(y[2] * rs * g0[2], y[3] * rs * g0[3]);
                    w.z = pk2(y[4] * rs * g1[0], y[5] * rs * g1[1]); w.w = pk2(y[6] * rs * g1[2], y[7] * rs * g1[3]);
                    *(u32x4*)(Y + row * D + cb) = w;
                }
        }
    }
};
__device__ __forceinline__ void fmac_shr1(float& o, float src, float w) { asm volatile("s_nop 1\n\tv_fmac_f32_dpp %0, %1, %2 row_shr:1 row_mask:0xf bank_mask:0xf bound_ctrl:1" : "+v"(o) : "v"(src), "v"(w)); }
__device__ __forceinline__ void fmac_shr1b(float& o, float src, float w) { asm volatile("v_fmac_f32_dpp %0, %1, %2 row_shr:1 row_mask:0xf bank_mask:0xf bound_ctrl:1" : "+v"(o) : "v"(src), "v"(w)); }
__device__ __forceinline__ void fmac_shr2(float& o, float src, float w) { asm volatile("v_fmac_f32_dpp %0, %1, %2 row_shr:2 row_mask:0xf bank_mask:0xf bound_ctrl:1" : "+v"(o) : "v"(src), "v"(w)); }
__device__ __forceinline__ void fmac_ror1(float& o, float src, float w) { asm volatile("v_fmac_f32_dpp %0, %1, %2 row_ror:1 row_mask:0xf bank_mask:0xf" : "+v"(o) : "v"(src), "v"(w)); }
__device__ __forceinline__ void fmac_ror2(float& o, float src, float w) { asm volatile("v_fmac_f32_dpp %0, %1, %2 row_ror:2 row_mask:0xf bank_mask:0xf" : "+v"(o) : "v"(src), "v"(w)); }
struct EpiUp {
    static constexpr bool PERM = true, PERM_A = false;
    bf16_t* G; float* HT; const float* fcw; LAS float* xb;
    __device__ __forceinline__ void begin(const Unit& u) const {
        const int tq = __builtin_amdgcn_readfirstlane(threadIdx.x >> 6) * 64 + lane_id();
        const int c0w = tq & 255, oc0 = (c0w < 128 ? 0 : DFF - 128) + u.pn * HALF + c0w;
        LAS float* wt = xb + 2048;
        wt[tq] = fcw[(size_t)(tq >> 8) * NUP + oc0]; if (tq < 256) wt[512 + tq] = fcw[2 * (size_t)NUP + oc0];
    }
    __device__ __forceinline__ void operator()(f32x4 (&acc)[2][2][4][2], const Unit& u, int wr, int wc, int fr_, int fq_, int next_pn, int ui) const {
        int lq = lane_id(); asm volatile("" : "+v"(lq));
        const int fr = lq & 15, fq = (lq >> 4) & 3;
        const int ct0 = wc * 32 + 8 * fq;
        LAS float* wt = xb + 2048 + (ui & 1) * 768;
        LAS float* wtn = xb + 2048 + ((ui + 1) & 1) * 768;
        const int tq = (wr * 4 + wc) * 64 + lq;
        const int c0w = tq & 255, oc0 = (c0w < 128 ? 0 : DFF - 128) + (next_pn < 0 ? 0 : next_pn) * HALF + c0w;
        const float wq0 = fcw[(size_t)(tq >> 8) * NUP + oc0];
        const float wq1 = (tq < 256) ? fcw[2 * (size_t)NUP + oc0] : 0.f;
        if (fr >= 14) {
#pragma unroll
            for (int ai = 0; ai < 2; ++ai)
#pragma unroll
                for (int bj = 0; bj < 2; ++bj)
#pragma unroll
                    for (int n = 0; n < 2; ++n) *(LAS f32x4*)(xb + ((ai * 2 + wr) * 2 + (fr - 14)) * 256 + bj * HALF + ct0 + 4 * n) = acc[ai][bj][3][n];
        }
        if (wr == 0 && fr < 2) {
            float* hp = HT + ((size_t)u.pm * 4 + fr) * NUP + (size_t)u.pn * 256 + ct0;
#pragma unroll
            for (int bj = 0; bj < 2; ++bj)
#pragma unroll
                for (int n = 0; n < 2; ++n) *(f32x4*)(hp + bj * HALF + 4 * n) = acc[0][bj][0][n];
        }
        if (wr == 1 && fr >= 14) {
            float* hp = HT + ((size_t)u.pm * 4 + 2 + (fr - 14)) * NUP + (size_t)u.pn * 256 + ct0;
#pragma unroll
            for (int bj = 0; bj < 2; ++bj)
#pragma unroll
                for (int n = 0; n < 2; ++n) *(f32x4*)(hp + bj * HALF + 4 * n) = acc[1][bj][3][n];
        }
        LDS_WAIT(); __builtin_amdgcn_s_barrier(); asm volatile("" ::: "memory");
#pragma unroll
        for (int bj = 0; bj < 2; ++bj)
#pragma unroll
            for (int n = 0; n < 2; ++n) {
                __builtin_amdgcn_sched_barrier(0);
                const int tc = bj * HALF + ct0 + 4 * n;
                const f32x4 w0 = *(const LAS f32x4*)(wt + tc), w1 = *(const LAS f32x4*)(wt + 256 + tc), w2 = *(const LAS f32x4*)(wt + 512 + tc);
                const int b0 = wr, b1 = 2 + wr;
                const f32x4 q14 = *(const LAS f32x4*)(xb + ((b0 > 0 ? b0 - 1 : 0) * 2 + 0) * 256 + tc), q15 = *(const LAS f32x4*)(xb + ((b0 > 0 ? b0 - 1 : 0) * 2 + 1) * 256 + tc);
                const f32x4 s14 = *(const LAS f32x4*)(xb + ((b1 - 1) * 2 + 0) * 256 + tc), s15 = *(const LAS f32x4*)(xb + ((b1 - 1) * 2 + 1) * 256 + tc);
#pragma unroll
                for (int e = 0; e < 4; ++e) {
                    const float w1m = (fr == 0) ? w1[e] : 0.f, w0m = (fr < 2) ? w0[e] : 0.f;
#pragma unroll
                    for (int ai = 0; ai < 2; ++ai) {
                        const float r14 = ai ? s14[e] : q14[e], r15 = ai ? s15[e] : q15[e];
                        float h = w1m * r15 + w0m * ((fr == 0) ? r14 : r15);
                        if (ai == 0 && b0 == 0) h = 0.f;
#pragma unroll
                        for (int m = 3; m >= 0; --m) {
                            const float cur = acc[ai][bj][m][n][e];
                            float v = w2[e] * cur;
                            fmac_shr1(v, cur, w1[e]); fmac_shr2(v, cur, w0[e]);
                            if (m > 0) { const float pb = acc[ai][bj][m - 1][n][e]; fmac_ror1(v, pb, w1m); fmac_ror2(v, pb, w0m); }
                            else v += h;
                            acc[ai][bj][m][n][e] = v;
                        }
                    }
                }
            }
        const int row0 = u.pm * BM + wr * 64 + fr, col0 = u.pn * HALF + ct0;
#pragma unroll
        for (int ai = 0; ai < 2; ++ai)
#pragma unroll
            for (int m = 0; m < 4; ++m) {
                __builtin_amdgcn_sched_barrier(0);
                const f32x4 a0 = acc[ai][0][m][0], a1 = acc[ai][0][m][1], v0 = acc[ai][1][m][0], v1 = acc[ai][1][m][1];
                u32x4 w; w.x = pk2(siluf_(a0[0]) * v0[0], siluf_(a0[1]) * v0[1]); w.y = pk2(siluf_(a0[2]) * v0[2], siluf_(a0[3]) * v0[3]);
                w.z = pk2(siluf_(a1[0]) * v1[0], siluf_(a1[1]) * v1[1]); w.w = pk2(siluf_(a1[2]) * v1[2], siluf_(a1[3]) * v1[3]);
                *(u32x4*)(G + (size_t)(row0 + ai * HALF + m * 16) * DFF + col0) = w;
            }
        wtn[tq] = wq0; if (tq < 256) wtn[512 + tq] = wq1;
    }
};

__device__ __forceinline__ void panel_rms(const f32x4 (&v)[2][2][4][2], const Unit& u, int wr, int wc, int fr, int fq, int tid, float* xg, unsigned* cnt, LAS float* tab) {
#pragma unroll
    for (int ai = 0; ai < 2; ++ai)
#pragma unroll
        for (int m = 0; m < 4; ++m) { float ss = 0.f;
#pragma unroll
            for (int bj = 0; bj < 2; ++bj)
#pragma unroll
                for (int n = 0; n < 2; ++n) { const f32x4 x = v[ai][bj][m][n]; ss += (x[0] * x[0] + x[1] * x[1]) + (x[2] * x[2] + x[3] * x[3]); }
            ss += __shfl_xor(ss, 16); ss += __shfl_xor(ss, 32);
            if (fq == 0) tab[(ai * HALF + wr * 64 + m * 16 + fr) * 4 + wc] = ss; }
    LDS_WAIT(); __builtin_amdgcn_s_barrier(); asm volatile("" ::: "memory");
    if (tid < 256) { const f32x4 p = *(const LAS f32x4*)(tab + tid * 4);
        __hip_atomic_store(xg + ((size_t)u.pm * 256 + tid) * 4 + u.pn, (p[0] + p[1]) + (p[2] + p[3]), __ATOMIC_RELAXED, __HIP_MEMORY_SCOPE_AGENT);
        asm volatile("s_waitcnt vmcnt(0)" ::: "memory");
        if ((tid & 63) == 0) __hip_atomic_fetch_add(cnt + 64 * u.pm, 1u, __ATOMIC_RELAXED, __HIP_MEMORY_SCOPE_AGENT); }
    if (tid < 64) { unsigned sp = 0;
        while ((unsigned)__builtin_amdgcn_readfirstlane(__hip_atomic_load(cnt + 64 * u.pm, __ATOMIC_RELAXED, __HIP_MEMORY_SCOPE_AGENT)) < 16u) { __builtin_amdgcn_s_sleep(1); if (++sp > (1u << 20)) break; }
        asm volatile("" ::: "memory"); }
    asm volatile("" ::: "memory"); __builtin_amdgcn_s_barrier(); asm volatile("" ::: "memory");
    if (tid < 256) { const float* q = xg + ((size_t)u.pm * 256 + tid) * 4; float s = 0.f;
#pragma unroll
        for (int k = 0; k < 4; ++k) s += __hip_atomic_load(q + k, __ATOMIC_RELAXED, __HIP_MEMORY_SCOPE_AGENT);
        tab[1024 + tid] = rsqrtf(s * (1.0f / D) + EPS); }
    LDS_WAIT(); __builtin_amdgcn_s_barrier(); asm volatile("" ::: "memory");
}
struct EpiDownNorm {
    static constexpr bool PERM = true, PERM_A = false;
    float* out; const float* mod; const float* gpost; float* xg; unsigned* cnt; LAS float* tab;
    __device__ __forceinline__ void begin(const Unit&) const {}
    __device__ __forceinline__ void operator()(const f32x4 (&acc)[2][2][4][2], const Unit& u, int wr, int wc, int fr_, int fq_, int, int) const {
        int lq = lane_id(); asm volatile("" : "+v"(lq));
        const int fr = lq & 15, fq = (lq >> 4) & 3, tid = (wr * 4 + wc) * 64 + lq;
        panel_rms(acc, u, wr, wc, fr, fq, tid, xg, cnt, tab);
        const int row0 = u.pm * BM + wr * 64 + fr, col0 = u.pn * BM + wc * 32 + 8 * fq, b = u.pm >> 4;
#pragma unroll
        for (int bj = 0; bj < 2; ++bj) {
            __builtin_amdgcn_sched_barrier(0);
            const int cb = col0 + bj * HALF;
            const f32x4 c0 = *(const f32x4*)(mod + b * NMOD + 5 * D + cb) * *(const f32x4*)(gpost + cb), c1 = *(const f32x4*)(mod + b * NMOD + 5 * D + cb + 4) * *(const f32x4*)(gpost + cb + 4);
#pragma unroll
            for (int ai = 0; ai < 2; ++ai)
#pragma unroll
                for (int m = 0; m < 4; ++m) { const int rl = ai * HALF + wr * 64 + m * 16 + fr; const float rs = tab[1024 + rl];
                    float* op = out + (size_t)(row0 + ai * HALF + m * 16) * D + cb;
                    const f32x4 x0 = *(const f32x4*)op, x1 = *(const f32x4*)(op + 4);
                    *(f32x4*)op = x0 + c0 * (acc[ai][bj][m][0] * rs); *(f32x4*)(op + 4) = x1 + c1 * (acc[ai][bj][m][1] * rs); }
        }
    }
};

struct EpiOutNorm {
    static constexpr bool PERM = true, PERM_A = false;
    const float* x; float* out; bf16_t* H; const float* mod; const float* gpostmix; const float* gpreffn; float* xg; unsigned* cnt; LAS float* tab;
    __device__ __forceinline__ void begin(const Unit&) const {}
    __device__ __forceinline__ void operator()(f32x4 (&acc)[2][2][4][2], const Unit& u, int wr, int wc, int fr_, int fq_, int, int) const {
        int lq = lane_id(); asm volatile("" : "+v"(lq));
        const int fr = lq & 15, fq = (lq >> 4) & 3, tid = (wr * 4 + wc) * 64 + lq;
        panel_rms(acc, u, wr, wc, fr, fq, tid, xg, cnt, tab);
        const int row0 = u.pm * BM + wr * 64 + fr, col0 = u.pn * BM + wc * 32 + 8 * fq, b = u.pm >> 4;
        const float* mb = mod + b * NMOD;
#pragma unroll
        for (int bj = 0; bj < 2; ++bj) {
            __builtin_amdgcn_sched_barrier(0);
            const int cb = col0 + bj * HALF;
            const f32x4 c0 = *(const f32x4*)(mb + 2 * D + cb) * *(const f32x4*)(gpostmix + cb), c1 = *(const f32x4*)(mb + 2 * D + cb + 4) * *(const f32x4*)(gpostmix + cb + 4);
#pragma unroll
            for (int ai = 0; ai < 2; ++ai)
#pragma unroll
                for (int m = 0; m < 4; ++m) { const int rl = ai * HALF + wr * 64 + m * 16 + fr; const float rs = tab[1024 + rl];
                    const size_t off = (size_t)(row0 + ai * HALF + m * 16) * D + cb;
                    const f32x4 x0 = *(const f32x4*)(x + off), x1 = *(const f32x4*)(x + off + 4);
                    const f32x4 y0 = x0 + c0 * (acc[ai][bj][m][0] * rs), y1 = x1 + c1 * (acc[ai][bj][m][1] * rs);
                    *(f32x4*)(out + off) = y0; *(f32x4*)(out + off + 4) = y1;
                    acc[ai][bj][m][0] = y0; acc[ai][bj][m][1] = y1; }
        }
        __builtin_amdgcn_sched_barrier(0);
        panel_rms(acc, u, wr, wc, fr, fq, tid, xg + (size_t)M * 4, cnt + 128 * 64, tab);
#pragma unroll
        for (int bj = 0; bj < 2; ++bj) {
            __builtin_amdgcn_sched_barrier(0);
            const int cb = col0 + bj * HALF;
            const f32x4 g0 = *(const f32x4*)(gpreffn + cb) * (*(const f32x4*)(mb + 4 * D + cb) + 1.0f), g1 = *(const f32x4*)(gpreffn + cb + 4) * (*(const f32x4*)(mb + 4 * D + cb + 4) + 1.0f);
            const f32x4 s0 = *(const f32x4*)(mb + 3 * D + cb), s1 = *(const f32x4*)(mb + 3 * D + cb + 4);
#pragma unroll
            for (int ai = 0; ai < 2; ++ai)
#pragma unroll
                for (int m = 0; m < 4; ++m) { const int rl = ai * HALF + wr * 64 + m * 16 + fr; const float rs = tab[1024 + rl];
                    const f32x4 h0 = acc[ai][bj][m][0] * rs * g0 + s0, h1 = acc[ai][bj][m][1] * rs * g1 + s1;
                    u32x4 w; w.x = pk2(h0[0], h0[1]); w.y = pk2(h0[2], h0[3]); w.z = pk2(h1[0], h1[1]); w.w = pk2(h1[2], h1[3]);
                    *(u32x4*)(H + (size_t)(row0 + ai * HALF + m * 16) * D + cb) = w; }
        }
    }
};

struct EpiIn {
    static constexpr bool PERM = true, PERM_A = true;
    bf16_t* Y; bf16_t* U; float* HTI; const float* convw; const float* gconv; LAS float* xb;
    __device__ __forceinline__ void begin(const Unit&) const {
        const int t = __builtin_amdgcn_readfirstlane(threadIdx.x >> 6) * 64 + lane_id();
        LAS float* wl = xb + 512 + 1024;
#pragma unroll
        for (int k = 0; k < 3; ++k) wl[k * 512 + t] = convw[k * 512 + t];
        wl[3 * 512 + t] = gconv[t];
    }
    __device__ __forceinline__ void operator()(f32x4 (&acc)[2][2][4][2], const Unit& u, int wr, int wc, int fr_, int fq_, int, int) const {
        int lq = lane_id(); asm volatile("" : "+v"(lq));
        const int fr = lq & 15, fq = (lq >> 4) & 3;
        const int ch4 = 16 * wc + 4 * fq, gch = 64 * u.pn + ch4;
        LAS float* tab = xb + 512;
        const LAS float* wl = xb + 512 + 1024;
#pragma unroll
        for (int ai = 0; ai < 2; ++ai)
#pragma unroll
            for (int m = 0; m < 4; ++m) acc[ai][0][m][0] = acc[ai][0][m][0] * acc[ai][0][m][1];
        if (fr == 15) {
#pragma unroll
            for (int ai = 0; ai < 2; ++ai) { *(LAS f32x4*)(xb + ((ai * 2 + wr) * 2 + 0) * 64 + ch4) = acc[ai][0][2][0]; *(LAS f32x4*)(xb + ((ai * 2 + wr) * 2 + 1) * 64 + ch4) = acc[ai][0][3][0]; }
        }
        if (wr == 0 && fr == 0) { float* hp = HTI + ((size_t)u.pm * 6) * 512 + gch;
            *(f32x4*)(hp) = acc[0][0][0][0]; *(f32x4*)(hp + 512) = acc[0][0][1][0]; *(f32x4*)(hp + 4 * 512) = acc[0][1][0][0]; *(f32x4*)(hp + 5 * 512) = acc[0][1][1][0]; }
        if (wr == 1 && fr == 15) { float* hp = HTI + ((size_t)u.pm * 6 + 2) * 512 + gch; *(f32x4*)(hp) = acc[1][0][2][0]; *(f32x4*)(hp + 512) = acc[1][0][3][0]; }
        LDS_WAIT(); __builtin_amdgcn_s_barrier(); asm volatile("" ::: "memory");
        const f32x4 w0 = *(const LAS f32x4*)(wl + gch), w1 = *(const LAS f32x4*)(wl + 512 + gch), w2 = *(const LAS f32x4*)(wl + 1024 + gch);
#pragma unroll
        for (int ai = 0; ai < 2; ++ai) {
            __builtin_amdgcn_sched_barrier(0);
            const int blk = ai * 2 + wr, pblk = blk > 0 ? blk - 1 : 0;
            const bool halo = (fr == 0) && (blk > 0);
            const f32x4 h2 = *(const LAS f32x4*)(xb + (pblk * 2 + 0) * 64 + ch4), h3 = *(const LAS f32x4*)(xb + (pblk * 2 + 1) * 64 + ch4);
#pragma unroll
            for (int e = 0; e < 4; ++e) {
                const float w1m = halo ? w1[e] : 0.f, w0m = halo ? w0[e] : 0.f;
                const float c0 = acc[ai][0][0][0][e], c1 = acc[ai][0][1][0][e], c2 = acc[ai][0][2][0][e], c3 = acc[ai][0][3][0][e];
                float o1 = w2[e] * c1 + w1[e] * c0 + w0m * h3[e];
                float o0 = w2[e] * c0 + w1m * h3[e] + w0m * h2[e];
                fmac_shr1(o1, c3, w0[e]); fmac_shr1b(o0, c3, w1[e]); fmac_shr1b(o0, c2, w0[e]);
                acc[ai][0][3][0][e] = acc[ai][1][3][0][e] * (w2[e] * c3 + w1[e] * c2 + w0[e] * c1);
                acc[ai][0][2][0][e] = acc[ai][1][2][0][e] * (w2[e] * c2 + w1[e] * c1 + w0[e] * c0);
                acc[ai][0][1][0][e] = acc[ai][1][1][0][e] * o1; acc[ai][0][0][0][e] = acc[ai][1][0][0][e] * o0;
            }
        }
#pragma unroll
        for (int ai = 0; ai < 2; ++ai)
#pragma unroll
            for (int m = 0; m < 4; ++m) { const f32x4 y = acc[ai][0][m][0]; float ss = (y[0] * y[0] + y[1] * y[1]) + (y[2] * y[2] + y[3] * y[3]);
                ss += __shfl_xor(ss, 16); ss += __shfl_xor(ss, 32);
                if (fq == 0) tab[(ai * HALF + wr * 64 + 4 * fr + m) * 4 + wc] = ss; }
        LDS_WAIT(); __builtin_amdgcn_s_barrier(); asm volatile("" ::: "memory");
        const f32x4 gg = *(const LAS f32x4*)(wl + 1536 + gch);
        const int row0 = u.pm * BM + wr * 64 + 4 * fr;
#pragma unroll
        for (int ai = 0; ai < 2; ++ai)
#pragma unroll
            for (int m = 0; m < 4; ++m) { const int rl = ai * HALF + wr * 64 + 4 * fr + m; const f32x4 pp = *(const LAS f32x4*)(tab + rl * 4);
                const float rs = rsqrtf(((pp[0] + pp[1]) + (pp[2] + pp[3])) * (1.0f / 64.0f) + EPS);
                const f32x4 y = acc[ai][0][m][0] * rs * gg, uu = acc[ai][1][m][1];
                const size_t row = (size_t)(row0 + ai * HALF + m);
                u32x2 wy; wy.x = pk2(y[0], y[1]); wy.y = pk2(y[2], y[3]); *(u32x2*)(Y + row * D + 512 + gch) = wy;
                u32x2 wu; wu.x = pk2(uu[0], uu[1]); wu.y = pk2(uu[2], uu[3]); *(u32x2*)(U + row * DSSM + gch) = wu; }
    }
};
#undef PG8_BAR
}

#define XB_TMO      128
#define XB_XCNT(j)  (256  + 64 * (j))
#define XB_XSUB(j)  (1280 + 64 * (j))
#define XB_XGEN(j)  (2304 + 64 * (j))
#define XB_TOP      3328
#define XB_TOPGEN   3392
#define XCD_BAR_WORDS 3456
#define XB_SPIN_CAP (1u << 18)

__device__ __forceinline__ unsigned xb_ld(unsigned* p)              { return __hip_atomic_load(p, __ATOMIC_RELAXED, __HIP_MEMORY_SCOPE_AGENT); }
__device__ __forceinline__ unsigned xb_add(unsigned* p, unsigned v) { return __hip_atomic_fetch_add(p, v, __ATOMIC_RELAXED, __HIP_MEMORY_SCOPE_AGENT); }
__device__ __forceinline__ unsigned xb_xcc_id() { return (unsigned)__builtin_amdgcn_s_getreg((3 << 11) | 20) & 0xFu; }
#define XB_SPIN(cond, bar) do { unsigned _sp = 0; while (cond) { __builtin_amdgcn_s_sleep(1); \
    if ((++_sp & 255u) == 0u) { if (xb_ld(&(bar)[XB_TMO])) break; if (_sp > XB_SPIN_CAP) { atomicAdd(&(bar)[XB_TMO], 1u); break; } } } } while (0)

struct XcdBarrier {
    unsigned* bar; unsigned x;
    volatile LAS unsigned* st;
};

__device__ __forceinline__ XcdBarrier xcd_barrier_post(unsigned* bar, volatile LAS unsigned* st) {
    XcdBarrier b; b.bar = bar; b.x = xb_xcc_id(); b.st = st;
    if (threadIdx.x == 0) (void)xb_add(&bar[XB_XCNT(b.x)], 1u);
    return b;
}
__device__ __forceinline__ void xcd_barrier_complete(unsigned* bar, unsigned x, unsigned& nloc, unsigned& nx) {
    const unsigned G = gridDim.x * gridDim.y * gridDim.z;
    unsigned sum, cnt, mine, sp = 0u;
    for (;;) {
        sum = 0u; cnt = 0u; mine = 0u;
#pragma unroll
        for (unsigned j = 0; j < 16; ++j) { const unsigned c = xb_ld(&bar[XB_XCNT(j)]); sum += c; cnt += (c > 0u) ? 1u : 0u; mine = (j == x) ? c : mine; }
        if (sum == G) break;
        __builtin_amdgcn_s_sleep(1);
        if ((++sp & 255u) == 0u) { if (xb_ld(&bar[XB_TMO])) break; if (sp > XB_SPIN_CAP) { atomicAdd(&bar[XB_TMO], 1u); break; } }
    }
    nloc = mine > 0u ? mine : 1u; nx = cnt > 0u ? cnt : 1u;
}

__device__ __forceinline__ void xcd_barrier(const XcdBarrier& b) {
    asm volatile("s_waitcnt vmcnt(0)" ::: "memory");
    __syncthreads();
    if (threadIdx.x == 0) {
        unsigned* bar = b.bar;
        __builtin_amdgcn_s_waitcnt(0);
        unsigned nloc = b.st[0], nx = b.st[1];
        if (nloc == 0u) { xcd_barrier_complete(bar, b.x, nloc, nx); b.st[0] = nloc; b.st[1] = nx; }
        const unsigned old = xb_add(&bar[XB_XSUB(b.x)], 1u);
        const unsigned gen = old / nloc;
        if (old + 1u == (gen + 1u) * nloc) {
            __builtin_amdgcn_fence(__ATOMIC_RELEASE, "agent");
            asm volatile("s_waitcnt vmcnt(0)" ::: "memory");
            const unsigned og = xb_add(&bar[XB_TOP], 1u);
            const unsigned tg = og / nx;
            if (og + 1u == (tg + 1u) * nx) xb_add(&bar[XB_TOPGEN], 1u);
            else XB_SPIN(xb_ld(&bar[XB_TOPGEN]) == tg, bar);
            __builtin_amdgcn_fence(__ATOMIC_ACQUIRE, "agent");
            xb_add(&bar[XB_XGEN(b.x)], 1u);
            asm volatile("s_waitcnt vmcnt(0)" ::: "memory");
        } else {
            XB_SPIN(xb_ld(&bar[XB_XGEN(b.x)]) == gen, bar);
            __builtin_amdgcn_fence(__ATOMIC_ACQUIRE, "agent");
            asm volatile("s_waitcnt vmcnt(0)" ::: "memory");
        }
    }
    __syncthreads();
}


struct Args { const float* in[26]; float* out; unsigned char* ws; int ph_lo, ph_hi; };
typedef const __attribute__((address_space(4))) Args* ArgsP;
__device__ __forceinline__ ArgsP opaque_args() { ArgsP p = (ArgsP)__builtin_amdgcn_kernarg_segment_ptr(); asm volatile("" : "+s"(p)); return p; }
enum { I_X = 0, I_C, I_WADA, I_BADA, I_GPREMIX, I_GPOSTMIX, I_WIN, I_LRE, I_LIM, I_LSTEP, I_BRE, I_BIM, I_CRE, I_CIM, I_DSKIP, I_GLUW, I_GLUB,
       I_GOSSM, I_CONVW, I_GOCONV, I_WOUT, I_GPREFFN, I_GPOSTFFN, I_WUP, I_FCW, I_WDN };

__device__ __forceinline__ int win_row(int col) {
    const int sec = col >> 9, within = col & 511, pn = within >> 6, ch = within & 63, wc = ch >> 4, fq = (ch >> 2) & 3, e = ch & 3;
    const int bj = (sec == 0 || sec == 1) ? 1 : 0, n = (sec == 0 || sec == 3) ? 1 : 0;
    return pn * 256 + bj * 128 + wc * 32 + fq * 8 + n * 4 + e;
}
template <bool WIN = false>
__device__ __forceinline__ void transpose_item(const float* W, int K, int N, bf16_t* WT, int drow, int k0, int n0, LAS float* scr, int lane) {
#pragma unroll
    for (int i = 0; i < 32; ++i) { const int kk = 2 * i + (lane >> 5); scr[kk * 33 + (lane & 31)] = W[(size_t)(k0 + kk) * N + n0 + (lane & 31)]; }
    LDS_WAIT();
    const int c = lane & 7;
#pragma unroll
    for (int j = 0; j < 4; ++j) { const int n = (lane >> 3) + 8 * j; const LAS float* s = scr + (8 * c) * 33 + n;
        u32x4 o; o.x = pk2(s[0 * 33], s[1 * 33]); o.y = pk2(s[2 * 33], s[3 * 33]); o.z = pk2(s[4 * 33], s[5 * 33]); o.w = pk2(s[6 * 33], s[7 * 33]);
        *(u32x4*)(WT + (size_t)(WIN ? win_row(n0 + n) : drow + n) * K + k0 + 8 * c) = o; }
    LDS_WAIT();
}

__device__ __forceinline__ void build_tables(ArgsP ap, LAS unsigned char* lds, int g, int tid) {
    LAS float* lamp = (LAS float*)(lds);
    LAS float* bbar = (LAS float*)(lds + 8704);
    LAS float* cc = (LAS float*)(lds + 8704 + 8192);
    unsigned char* img = ap->ws + WS_TAB + (size_t)g * TAB_BYTES;
    __syncthreads();
    const float step = expf(ap->in[I_LSTEP][g]);
    for (int i = tid; i < 17 * 64; i += 512) { const int d = i >> 6, p = i & 63;
        const float lr = fminf(ap->in[I_LRE][g * 64 + p], -1e-4f), li = ap->in[I_LIM][g * 64 + p];
        const float er = expf(lr * step * (float)d); float sn, cs; sincosf(li * step * (float)d, &sn, &cs);
        lamp[i * 2] = er * cs; lamp[i * 2 + 1] = er * sn;
        if (d == 16) { ((float*)(img + TAB_LAMT))[p * 2] = er * cs; ((float*)(img + TAB_LAMT))[p * 2 + 1] = er * sn; } }
    for (int i = tid; i < 64 * 16; i += 512) { const int p = i >> 4;
        const float lr = fminf(ap->in[I_LRE][g * 64 + p], -1e-4f), li = ap->in[I_LIM][g * 64 + p];
        const float ar = lr * step, ai = li * step;
        float sn, cs; sincosf(ai, &sn, &cs); const float em1 = expm1f(ar), ea = em1 + 1.0f; const float sh = sinf(0.5f * ai);
        const float nr = em1 * cs - 2.0f * sh * sh, ni = ea * sn;
        const float den = 1.0f / (lr * lr + li * li);
        const float qr = (nr * lr + ni * li) * den, qi = (ni * lr - nr * li) * den;
        const float br = ap->in[I_BRE][(size_t)g * 1024 + i], bi = ap->in[I_BIM][(size_t)g * 1024 + i];
        bbar[i * 2] = qr * br - qi * bi; bbar[i * 2 + 1] = qr * bi + qi * br; }
    for (int i = tid; i < 16 * 64; i += 512) { const int h = i >> 6, p = i & 63; cc[(p * 16 + h) * 2] = ap->in[I_CRE][(size_t)g * 1024 + i]; cc[(p * 16 + h) * 2 + 1] = ap->in[I_CIM][(size_t)g * 1024 + i]; }
    for (int i = tid; i < 128; i += 512) ((unsigned*)(img + TAB_KTAB))[i] = 0u;
    __syncthreads();
    if (tid < 256) { const int d = tid >> 4, h = tid & 15; float acc[16];
#pragma unroll
        for (int e = 0; e < 16; ++e) acc[e] = 0.f;
        for (int p = 0; p < 64; ++p) { const float lr = lamp[(d * 64 + p) * 2], li = lamp[(d * 64 + p) * 2 + 1], cr = cc[(p * 16 + h) * 2], ci = cc[(p * 16 + h) * 2 + 1];
            const float tr = cr * lr - ci * li, ti = cr * li + ci * lr;
#pragma unroll
            for (int q = 0; q < 8; ++q) { const f32x4 bb = *(const LAS f32x4*)(bbar + p * 32 + 4 * q); acc[2 * q] += tr * bb[0] - ti * bb[1]; acc[2 * q + 1] += tr * bb[2] - ti * bb[3]; } }
        if (d == 0) {
#pragma unroll
            for (int e = 0; e < 16; ++e) if (e == h) acc[e] += ap->in[I_DSKIP][16 * g + h]; }
        u32x4 o0, o1; o0.x = pk2(acc[0], acc[1]); o0.y = pk2(acc[2], acc[3]); o0.z = pk2(acc[4], acc[5]); o0.w = pk2(acc[6], acc[7]);
        o1.x = pk2(acc[8], acc[9]); o1.y = pk2(acc[10], acc[11]); o1.z = pk2(acc[12], acc[13]); o1.w = pk2(acc[14], acc[15]);
        u32x4* dst = (u32x4*)(img + TAB_KTAB + 512 + tid * 32); dst[0] = o0; dst[1] = o1; }
    for (int i = tid; i < 128 * 128; i += 512) { const int n = i >> 7, k = (i & 127) * 2, p = n & 63, j = k >> 4, hp = k & 15;
        const float lr = lamp[((15 - j) * 64 + p) * 2], li = lamp[((15 - j) * 64 + p) * 2 + 1];
        const f32x4 bb = *(const LAS f32x4*)(bbar + (p * 16 + hp) * 2);
        const float v0 = n < 64 ? (lr * bb[0] - li * bb[1]) : (lr * bb[1] + li * bb[0]), v1 = n < 64 ? (lr * bb[2] - li * bb[3]) : (lr * bb[3] + li * bb[2]);
        *(unsigned*)(img + TAB_M3 + n * 528 + k * 2) = pk2(v0, v1); }
    for (int i = tid; i < 256 * 64; i += 512) { const int n = i >> 6, q = (i & 63) * 2, p = q & 63, ii = n >> 4, h = n & 15;
        float v[2];
#pragma unroll
        for (int e = 0; e < 2; ++e) { const float lr = lamp[((ii + 1) * 64 + p + e) * 2], li = lamp[((ii + 1) * 64 + p + e) * 2 + 1], cr = cc[((p + e) * 16 + h) * 2], ci = cc[((p + e) * 16 + h) * 2 + 1];
            v[e] = q < 64 ? (cr * lr - ci * li) : -(cr * li + ci * lr); }
        *(unsigned*)(img + TAB_M2 + n * 272 + q * 2) = pk2(v[0], v[1]); }
    __syncthreads();
}
__device__ __forceinline__ void p0_prologue(ArgsP ap, LAS unsigned char* lds, int wid0) {
    int tid_ = wid0 * 64 + lane_id(); asm volatile("" : "+v"(tid_));
    const int tid = tid_, lane = tid & 63, wave = tid >> 6, G = gridDim.x;
    unsigned char* ws = ap->ws;
    if ((int)blockIdx.x < 96) {
        LAS float* cact = (LAS float*)(lds + 72 * 1024);
        LAS float* red = (LAS float*)(lds + 104 * 1024);
        const float* c = ap->in[I_C];
        for (int i = tid; i < NB * D; i += 512) cact[i] = siluf_(c[i]);
        __syncthreads();
        for (int item = blockIdx.x; item < 96; item += G) {
            const int col = item * 64 + lane, k0 = wave * 128;
            const float* wp = ap->in[I_WADA] + (size_t)k0 * NMOD + col;
            float acc[NB];
#pragma unroll
            for (int b = 0; b < NB; ++b) acc[b] = 0.f;
#pragma unroll 16
            for (int k = 0; k < 128; ++k) { const float w = wp[(size_t)k * NMOD];
#pragma unroll
                for (int b = 0; b < NB; ++b) acc[b] += cact[b * D + k0 + k] * w; }
#pragma unroll
            for (int b = 0; b < NB; ++b) red[(wave * NB + b) * 64 + lane] = acc[b];
            __syncthreads();
            { const int b = wave; float s = ap->in[I_BADA][col];
#pragma unroll
              for (int w = 0; w < 8; ++w) s += red[(w * NB + b) * 64 + lane];
              ((float*)(ws + WS_MOD))[b * NMOD + col] = s; }
            asm volatile("s_waitcnt vmcnt(0)" ::: "memory");
            __syncthreads();
            if (tid == 0) { __builtin_amdgcn_fence(__ATOMIC_RELEASE, "agent"); asm volatile("s_waitcnt vmcnt(0)" ::: "memory");
                __hip_atomic_fetch_add((unsigned*)(ws + WS_BAR) + 64, 1u, __ATOMIC_RELAXED, __HIP_MEMORY_SCOPE_AGENT); }
        }
    }
    for (int w = blockIdx.x; w < 128; w += G) if (w >= 96) build_tables(ap, lds, w - 96, tid);
    LAS float* scr = (LAS float*)(lds + wave * 8704);
    const bool split = (G >= 256);
    if (split && (int)blockIdx.x < 128) return;
    const int gw = (split ? (int)blockIdx.x - 128 : (int)blockIdx.x) * 8 + wave, NGW = (split ? G - 128 : G) * 8;
    constexpr int I1 = 16 * 64, I2 = 8 * 16, I3 = 16 * 32, I4 = 16 * 176, I5 = 44 * 32, NIT = I1 + I2 + I3 + I4 + I5;
    for (int it = gw; it < NIT; it += NGW) {
        int r = it;
        if (r < I1) { const int nb = r % 64, kb = r / 64; transpose_item<true>(ap->in[I_WIN], D, DIN, (bf16_t*)(ws + WS_WIN), 0, 64 * kb, 32 * nb, scr, lane); continue; } r -= I1;
        if (r < I2) { const int nb = r % 16, kb = r / 16; transpose_item(ap->in[I_GLUW], DSSM, DSSM, (bf16_t*)(ws + WS_GLU), 32 * nb, 64 * kb, 32 * nb, scr, lane); continue; } r -= I2;
        if (r < I3) { const int nb = r % 32, kb = r / 32; transpose_item(ap->in[I_WOUT], D, D, (bf16_t*)(ws + WS_WOUT), 32 * nb, 64 * kb, 32 * nb, scr, lane); continue; } r -= I3;
        if (r < I4) { const int nb = r % 176, kb = r / 176; const int n0 = 32 * nb; const int j = n0 < DFF ? n0 : n0 - DFF;
            const int drow = (j / 128) * 256 + (n0 < DFF ? 0 : 128) + (j % 128);
            transpose_item(ap->in[I_WUP], D, NUP, (bf16_t*)(ws + WS_WUP), drow, 64 * kb, n0, scr, lane); continue; } r -= I4;
        { const int nb = r % 32, kb = r / 32; transpose_item(ap->in[I_WDN], DFF, D, (bf16_t*)(ws + WS_WDN), 32 * nb, 64 * kb, 32 * nb, scr, lane); }
    }
}

__device__ __forceinline__ void p1_rows(ArgsP ap, int wid0, bool wait_mod) {
    int tid_ = wid0 * 64 + lane_id(); asm volatile("" : "+v"(tid_));
    const int lane = tid_ & 63, wave = tid_ >> 6, G = gridDim.x;
    const float* mod = (const float*)(ap->ws + WS_MOD);
    bf16_t* H = (bf16_t*)(ap->ws + WS_H);
    if (wait_mod) {
        if (tid_ == 0) { unsigned* cnt = (unsigned*)(ap->ws + WS_BAR) + 64; unsigned sp = 0;
            while (__hip_atomic_load(cnt, __ATOMIC_RELAXED, __HIP_MEMORY_SCOPE_AGENT) < 96u) { __builtin_amdgcn_s_sleep(2); if (++sp > (1u << 22)) break; }
            __builtin_amdgcn_fence(__ATOMIC_ACQUIRE, "agent"); asm volatile("s_waitcnt vmcnt(0)" ::: "memory"); }
        __syncthreads();
    }
    const int vb = (G % 8 == 0) ? (int)(blockIdx.x % 8) * (G / 8) + (int)(blockIdx.x / 8) : (int)blockIdx.x;
    for (int base = (vb * 8 + wave) * 16; base < M; base += G * 8 * 16) {
        const int b = base / SEQ;
        f32x4 gs[4], sh[4];
#pragma unroll
        for (int j = 0; j < 4; ++j) { const int col = 4 * lane + 256 * j;
            const f32x4 g = *(const f32x4*)(ap->in[I_GPREMIX] + col), sc = *(const f32x4*)(mod + b * NMOD + D + col);
            gs[j] = g * (sc + 1.0f); sh[j] = *(const f32x4*)(mod + b * NMOD + col); }
#pragma unroll 1
        for (int rb = 0; rb < 16; rb += 4) {
            f32x4 v[4][4];
#pragma unroll
            for (int r = 0; r < 4; ++r) { const f32x4* xr = (const f32x4*)(ap->in[I_X] + (size_t)(base + rb + r) * D) + lane;
#pragma unroll
                for (int j = 0; j < 4; ++j) v[r][j] = xr[64 * j]; }
#pragma unroll
            for (int r = 0; r < 4; ++r) { const size_t row = base + rb + r; float ss = 0.f;
#pragma unroll
                for (int j = 0; j < 4; ++j) ss += (v[r][j].x * v[r][j].x + v[r][j].y * v[r][j].y) + (v[r][j].z * v[r][j].z + v[r][j].w * v[r][j].w);
                const float rs = rsqrtf(wave_sum(ss) * (1.0f / D) + EPS);
                u32x2* o = (u32x2*)(H + row * D) + lane;
#pragma unroll
                for (int j = 0; j < 4; ++j) { const f32x4 h = v[r][j] * rs * gs[j] + sh[j]; u32x2 w; w.x = pk2(h.x, h.y); w.y = pk2(h.z, h.w); o[64 * j] = w; }
            }
        }
    }
}

constexpr int L_KTAB = 0, L_XS = 8704, L_MT = 78336, L_CARRY = 147968;
constexpr int L_BBAR = L_XS, L_CC = L_XS + 8192, L_LAMP = L_XS + 16384;
__device__ __forceinline__ void ssm_unit(ArgsP ap, LAS unsigned char* lds, int unit, int wid0) {
    int tid_ = wid0 * 64 + lane_id(); asm volatile("" : "+v"(tid_));
    const int tid = tid_, lane = tid & 63, wave = __builtin_amdgcn_readfirstlane(tid >> 6), b = unit & 7, g = unit >> 3;
    const bf16_t* UB = (const bf16_t*)(ap->ws + WS_U);
    bf16_t* Z = (bf16_t*)(ap->ws + WS_Z);
    float* SS = (float*)(ap->ws + WS_SS) + (size_t)unit * NCH * 128;
    const unsigned char* img = ap->ws + WS_TAB + (size_t)g * TAB_BYTES;
    __syncthreads();
    u32x4 t0[2], t1[9], m2r[9];
#pragma unroll
    for (int k = 0; k < 2; ++k) { const int i = tid + 512 * k; if (i < 8704 / 16) t0[k] = ((const u32x4*)(img + TAB_KTAB))[i]; }
#pragma unroll
    for (int k = 0; k < 9; ++k) { const int i = tid + 512 * k; if (i < 67584 / 16) t1[k] = ((const u32x4*)(img + TAB_M3))[i]; }
    const int r32 = lane & 31, hh = lane >> 5, c0 = wave * 32;
    const bf16_t* up = UB + ((size_t)b * SEQ + (size_t)(c0 + r32) * TCH) * DSSM + 16 * g + 8 * hh;
    f32x16 accS[4];
    {
    bf16x8 ufr[16];
#pragma unroll
    for (int j = 0; j < 16; ++j) ufr[j] = *(const bf16x8*)(up + (size_t)j * DSSM);
#pragma unroll
    for (int k = 0; k < 9; ++k) { const int i = tid + 512 * k; if (i < 69632 / 16) m2r[k] = ((const u32x4*)(img + TAB_M2))[i]; }
#pragma unroll
    for (int k = 0; k < 2; ++k) { const int i = tid + 512 * k; if (i < 8704 / 16) ((LAS u32x4*)(lds + L_KTAB))[i] = t0[k]; }
#pragma unroll
    for (int k = 0; k < 9; ++k) { const int i = tid + 512 * k; if (i < 67584 / 16) ((LAS u32x4*)(lds + L_MT))[i] = t1[k]; }
    __syncthreads();
#pragma unroll
    for (int nb = 0; nb < 4; ++nb) {
        __builtin_amdgcn_sched_barrier(0);
#pragma unroll
        for (int e = 0; e < 16; ++e) accS[nb][e] = 0.f;
#pragma unroll
        for (int j = 0; j < 16; ++j) { const bf16x8 bf = *(const LAS bf16x8*)(lds + L_MT + (32 * nb + r32) * 528 + (16 * j + 8 * hh) * 2);
            accS[nb] = __builtin_amdgcn_mfma_f32_32x32x16_bf16(ufr[j], bf, accS[nb], 0, 0, 0); }
    }
    }
    const int p = lane, sb = wave;
    const float ltr = ((const float*)(img + TAB_LAMT))[p * 2], lti = ((const float*)(img + TAB_LAMT))[p * 2 + 1];
    __syncthreads();
    { LAS float* sl = (LAS float*)(lds + L_XS);
#pragma unroll
      for (int nb = 0; nb < 4; ++nb)
#pragma unroll
          for (int e = 0; e < 16; ++e) sl[(c0 + (e & 3) + 8 * (e >> 2) + 4 * hh) * 128 + 32 * nb + r32] = accS[nb][e]; }
    __syncthreads();
    float er[32], ei[32];
    { const LAS float* sp = (const LAS float*)(lds + L_XS) + (32 * sb) * 128 + p;
#pragma unroll
      for (int k = 0; k < 32; ++k) { er[k] = sp[k * 128]; ei[k] = sp[k * 128 + 64]; } }
    __syncthreads();
#pragma unroll
    for (int k = 0; k < 9; ++k) { const int i = tid + 512 * k; if (i < 69632 / 16) ((LAS u32x4*)(lds + L_MT))[i] = m2r[k]; }
    { float xr = 0.f, xi = 0.f;
#pragma unroll
      for (int k = 0; k < 32; ++k) { const float sr = er[k], si = ei[k]; er[k] = xr; ei[k] = xi;
          const float nr = ltr * xr - lti * xi + sr, ni = ltr * xi + lti * xr + si; xr = nr; xi = ni; }
      LAS float* carry = (LAS float*)(lds + L_CARRY);
      carry[(sb * 64 + p) * 2] = xr; carry[(sb * 64 + p) * 2 + 1] = xi; }
    __syncthreads();
    { float l32r = ltr, l32i = lti;
#pragma unroll
      for (int s = 0; s < 5; ++s) { const float nr = l32r * l32r - l32i * l32i, ni = 2.0f * l32r * l32i; l32r = nr; l32i = ni; }
      const LAS float* carry = (const LAS float*)(lds + L_CARRY);
      float xr = 0.f, xi = 0.f;
      for (int s = 0; s < sb; ++s) { const float nr = l32r * xr - l32i * xi + carry[(s * 64 + p) * 2], ni = l32r * xi + l32i * xr + carry[(s * 64 + p) * 2 + 1]; xr = nr; xi = ni; }
      float pr = 1.f, pi = 0.f;
#pragma unroll
      for (int k = 0; k < 32; ++k) { const float vr = er[k] + pr * xr - pi * xi, vi = ei[k] + pr * xi + pi * xr;
          LAS bf16_t* xs = (LAS bf16_t*)(lds + L_XS + (32 * sb + k) * 272);
          const unsigned w = pk2(vr, vi); xs[p] = (bf16_t)(w & 0xffffu); xs[64 + p] = (bf16_t)(w >> 16);
          const float nr = pr * ltr - pi * lti, ni = pr * lti + pi * ltr; pr = nr; pi = ni; } }
    __syncthreads();
    __builtin_amdgcn_sched_barrier(0);
    bf16x8 ufr[16];
    { int l2 = lane_id(); asm volatile("" : "+v"(l2)); const int r2 = l2 & 31, h2 = (l2 >> 5) & 1;
      const bf16_t* up2 = UB + ((size_t)b * SEQ + (size_t)(c0 + r2) * TCH) * DSSM + 16 * g + 8 * h2;
#pragma unroll
      for (int j = 0; j < 16; ++j) ufr[j] = *(const bf16x8*)(up2 + (size_t)j * DSSM); }
#pragma unroll
    for (int half = 0; half < 2; ++half) {
        __builtin_amdgcn_sched_barrier(0);
        f32x16 acc[4];
#pragma unroll
        for (int q = 0; q < 4; ++q)
#pragma unroll
            for (int e = 0; e < 16; ++e) acc[q][e] = 0.f;
#pragma unroll
        for (int j = 0; j < 8 * half + 8; ++j)
#pragma unroll
            for (int q = 0; q < 4; ++q) { const int nb = 4 * half + q;
                if (j <= 2 * nb + 1) { int d1 = 2 * nb - j + (r32 >> 4) + 1; d1 = d1 < 0 ? 0 : d1;
                    const bf16x8 bf = *(const LAS bf16x8*)(lds + L_KTAB + d1 * 512 + (lane & 15) * 32 + 16 * hh);
                    acc[q] = __builtin_amdgcn_mfma_f32_32x32x16_bf16(ufr[j], bf, acc[q], 0, 0, 0); } }
#pragma unroll
        for (int ks = 0; ks < 8; ++ks) { const bf16x8 af = *(const LAS bf16x8*)(lds + L_XS + (c0 + r32) * 272 + (16 * ks + 8 * hh) * 2);
#pragma unroll
            for (int q = 0; q < 4; ++q) { const int nb = 4 * half + q;
                const bf16x8 bf = *(const LAS bf16x8*)(lds + L_MT + (32 * nb + r32) * 272 + (16 * ks + 8 * hh) * 2);
                acc[q] = __builtin_amdgcn_mfma_f32_32x32x16_bf16(af, bf, acc[q], 0, 0, 0); } }
#pragma unroll
        for (int q = 0; q < 4; ++q) { __builtin_amdgcn_sched_barrier(0); const int n = 32 * (4 * half + q) + r32, ii = n >> 4, ch = 16 * g + (n & 15);
#pragma unroll
            for (int e = 0; e < 16; ++e) { const int chunk = c0 + (e & 3) + 8 * (e >> 2) + 4 * hh; const size_t t = (size_t)b * SEQ + (size_t)chunk * TCH + ii;
                Z[t * DSSM + ch] = (bf16_t)(pk2(gelu_tanh(acc[q][e]), 0.f) & 0xffffu); } }
    }
    __syncthreads();
}
__device__ __forceinline__ void fix_conv_rows(ArgsP ap, int wid0) {
    const int lane = lane_id(), G = gridDim.x;
    const float* HTI = (const float*)(ap->ws + WS_HT);
    bf16_t* Y = (bf16_t*)(ap->ws + WS_Y);
    const int ch = 8 * lane;
    for (int it = blockIdx.x * 8 + wid0; it < (M / 256) * 2; it += G * 8) {
        const int pm = it >> 1, r = it & 1;
        if ((pm & 15) == 0) continue;
        const float* hp = HTI + ((size_t)(pm - 1) * 6) * 512 + ch, *hc = HTI + ((size_t)pm * 6) * 512 + ch;
        float yb[8]; float ss = 0.f;
#pragma unroll
        for (int e = 0; e < 8; ++e) {
            const float pm2 = hp[2 * 512 + e], pm1 = hp[3 * 512 + e], p0 = hc[e], p1 = hc[512 + e];
            const float w0 = ap->in[I_CONVW][ch + e], w1 = ap->in[I_CONVW][512 + ch + e], w2 = ap->in[I_CONVW][1024 + ch + e];
            const float cv = r == 0 ? (w0 * pm2 + w1 * pm1 + w2 * p0) : (w0 * pm1 + w1 * p0 + w2 * p1);
            yb[e] = hc[(4 + r) * 512 + e] * cv; ss += yb[e] * yb[e]; }
        ss += __shfl_xor(ss, 1); ss += __shfl_xor(ss, 2); ss += __shfl_xor(ss, 4);
        const float rs = rsqrtf(ss * (1.0f / 64.0f) + EPS);
        u32x4 w;
        w.x = pk2(yb[0] * rs * ap->in[I_GOCONV][ch + 0], yb[1] * rs * ap->in[I_GOCONV][ch + 1]); w.y = pk2(yb[2] * rs * ap->in[I_GOCONV][ch + 2], yb[3] * rs * ap->in[I_GOCONV][ch + 3]);
        w.z = pk2(yb[4] * rs * ap->in[I_GOCONV][ch + 4], yb[5] * rs * ap->in[I_GOCONV][ch + 5]); w.w = pk2(yb[6] * rs * ap->in[I_GOCONV][ch + 6], yb[7] * rs * ap->in[I_GOCONV][ch + 7]);
        *(u32x4*)(Y + ((size_t)pm * 256 + r) * D + 512 + ch) = w;
    }
}
__device__ __forceinline__ void fix_panel(ArgsP ap, int pm, int tid) {
    if ((pm & 15) == 0) return;
    const float* HT = (const float*)(ap->ws + WS_HT);
    const float* fcw = ap->in[I_FCW];
    bf16_t* Gm = (bf16_t*)(ap->ws + WS_G);
    const float* hp = HT + ((size_t)(pm - 1) * 4) * NUP, *hc = HT + ((size_t)pm * 4) * NUP;
    for (int j = tid; j < DFF; j += 512) {
        const int ia = (j >> 7) * 256 + (j & 127), iv = ia + 128;
        const float am2 = hp[2 * NUP + ia], am1 = hp[3 * NUP + ia], a0 = hc[ia], a1 = hc[NUP + ia];
        const float vm2 = hp[2 * NUP + iv], vm1 = hp[3 * NUP + iv], v0 = hc[iv], v1 = hc[NUP + iv];
        const float wa0 = fcw[j], wa1 = fcw[NUP + j], wa2 = fcw[2 * NUP + j], wv0 = fcw[DFF + j], wv1 = fcw[NUP + DFF + j], wv2 = fcw[2 * NUP + DFF + j];
        const float ca0 = wa0 * am2 + wa1 * am1 + wa2 * a0, ca1 = wa0 * am1 + wa1 * a0 + wa2 * a1;
        const float cv0 = wv0 * vm2 + wv1 * vm1 + wv2 * v0, cv1 = wv0 * vm1 + wv1 * v0 + wv2 * v1;
        Gm[((size_t)pm * 256) * DFF + j] = (bf16_t)(pk2(siluf_(ca0) * cv0, 0.f) & 0xffffu);
        Gm[((size_t)pm * 256 + 1) * DFF + j] = (bf16_t)(pk2(siluf_(ca1) * cv1, 0.f) & 0xffffu);
    }
}
__global__ void __launch_bounds__(512, 2) hymba_fwd(Args a_unused) {
    extern __shared__ __attribute__((aligned(16))) unsigned char shm[];
    LAS unsigned char* lds = (LAS unsigned char*)shm;
    cg::grid_group grid = cg::this_grid();
    const int wid0 = __builtin_amdgcn_readfirstlane(threadIdx.x >> 6);
    if (threadIdx.x < 4) ((LAS unsigned*)(lds + L_BARST))[threadIdx.x] = 0u;
    __syncthreads();
    XcdBarrier xbar = xcd_barrier_post((unsigned*)(opaque_args()->ws + WS_BAR), (volatile LAS unsigned*)(lds + L_BARST));
    if (opaque_args()->ph_lo < 0) grid.sync();
    const int G = gridDim.x;
#define SEAM() xcd_barrier(xbar)
    p0_prologue(opaque_args(), lds, wid0);
    p1_rows(opaque_args(), wid0, true);
    SEAM();
    {
        ArgsP ap = opaque_args(); unsigned char* ws = ap->ws;
        pg8::Gemm g{(const bf16_t*)(ws + WS_H), (const bf16_t*)(ws + WS_WIN), M, DIN, D}; pg8::StaticOrder S; S.init(M, DIN, G, blockIdx.x);
        pg8::EpiIn E{(bf16_t*)(ws + WS_Y), (bf16_t*)(ws + WS_U), (float*)(ws + WS_HT), ap->in[I_CONVW], ap->in[I_GOCONV], (LAS float*)(lds + pg8::STAGE_BYTES)};
        pg8::gemm_phase<pg8::EpiIn, true, true>(lds, g, S, E, wid0);
    }
    SEAM();
    fix_conv_rows(opaque_args(), wid0);
    for (int u = blockIdx.x; u < NB * NGRP; u += G) ssm_unit(opaque_args(), lds, u, wid0);
    SEAM();
    {
        ArgsP ap = opaque_args(); unsigned char* ws = ap->ws;
        pg8::Gemm g{(const bf16_t*)(ws + WS_Z), (const bf16_t*)(ws + WS_GLU), M, DSSM, DSSM}; pg8::StaticOrder S; S.init(M, DSSM, G, blockIdx.x);
        pg8::EpiGlu E{(const bf16_t*)(ws + WS_Z), (bf16_t*)(ws + WS_Y), ap->in[I_GLUB], ap->in[I_GOSSM]};
        pg8::gemm_phase<pg8::EpiGlu, true, true>(lds, g, S, E, wid0);
    }
    SEAM();
    {
        ArgsP ap = opaque_args(); unsigned char* ws = ap->ws;
        pg8::Gemm g{(const bf16_t*)(ws + WS_Y), (const bf16_t*)(ws + WS_WOUT), M, D, D}; pg8::StaticOrder S; S.init(M, D, G, blockIdx.x);
        pg8::EpiOutNorm E{ap->in[I_X], ap->out, (bf16_t*)(ws + WS_H), (const float*)(ws + WS_MOD), ap->in[I_GPOSTMIX], ap->in[I_GPREFFN],
                          (float*)(ws + WS_XG) + (size_t)M * 4, (unsigned*)(ws + WS_CNT) + 128 * 64, (LAS float*)(lds + pg8::STAGE_BYTES)};
        pg8::gemm_phase<pg8::EpiOutNorm, true, true>(lds, g, S, E, wid0);
    }
    SEAM();
    {
        ArgsP ap = opaque_args(); unsigned char* ws = ap->ws;
        pg8::Gemm g{(const bf16_t*)(ws + WS_H), (const bf16_t*)(ws + WS_WUP), M, NUP, D}; pg8::StaticOrder S; S.init(M, NUP, G, blockIdx.x);
        pg8::EpiUp E{(bf16_t*)(ws + WS_G), (float*)(ws + WS_HT), ap->in[I_FCW], (LAS float*)(lds + pg8::STAGE_BYTES)};
        pg8::gemm_phase<pg8::EpiUp, true, true>(lds, g, S, E, wid0);
    }
    SEAM();
    {
        ArgsP ap = opaque_args(); unsigned char* ws = ap->ws;
        pg8::Gemm g{(const bf16_t*)(ws + WS_G), (const bf16_t*)(ws + WS_WDN), M, D, DFF}; pg8::StaticOrder S; S.init(M, D, G, blockIdx.x);
        { pg8::Unit fu; const int ftid = wid0 * 64 + lane_id(); for (int i = 0; S.next(i, fu); ++i) fix_panel(ap, fu.pm, ftid);
          asm volatile("s_waitcnt vmcnt(0)" ::: "memory"); __syncthreads(); }
        pg8::EpiDownNorm E{ap->out, (const float*)(ws + WS_MOD), ap->in[I_GPOSTFFN], (float*)(ws + WS_XG), (unsigned*)(ws + WS_CNT), (LAS float*)(lds + pg8::STAGE_BYTES)};
        pg8::gemm_phase<pg8::EpiDownNorm, true, true>(lds, g, S, E, wid0);
    }
#undef SEAM
}

extern "C" void kernel_launch(void* const* d_in, const int* in_sizes, int n_in, void* d_out, int out_size, void* d_ws, size_t ws_size, hipStream_t stream) {
    static int grid = 0;
    if (grid == 0) {
        if (n_in != 26 || in_sizes[0] != M * D || out_size != M * D || ws_size < WS_END) { fprintf(stderr, "kernel_launch: unexpected shapes (n_in %d, ws %zu)\n", n_in, ws_size); grid = -1; return; }
        int dev = 0, cus = 0, per_cu = 0;
        hipGetDevice(&dev); hipDeviceGetAttribute(&cus, hipDeviceAttributeMultiprocessorCount, dev);
        if (hipFuncSetAttribute((const void*)hymba_fwd, hipFuncAttributeMaxDynamicSharedMemorySize, LDS_BYTES) != hipSuccess) { fprintf(stderr, "kernel_launch: hipFuncSetAttribute failed\n"); }
        if (hipOccupancyMaxActiveBlocksPerMultiprocessor(&per_cu, (const void*)hymba_fwd, 512, LDS_BYTES) != hipSuccess || per_cu < 1) per_cu = 1;
        (void)hipGetLastError();
        grid = cus * per_cu;
        if (grid > 256) grid = 256;
    }
    if (grid < 0) return;
    Args a{};
    for (int i = 0; i < 26; ++i) a.in[i] = (const float*)d_in[i];
    a.out = (float*)d_out; a.ws = (unsigned char*)d_ws;
    (void)hipMemsetAsync((char*)d_ws + WS_BAR, 0, CTL_ZERO, stream);
    a.ph_lo = 0; a.ph_hi = 0;
    void* args[] = {&a};
    hipError_t e = hipLaunchCooperativeKernel((const void*)hymba_fwd, dim3(grid), dim3(512), args, LDS_BYTES, stream);
    if (e != hipSuccess) fprintf(stderr, "cooperative launch failed: %s (grid %d)\n", hipGetErrorString(e), grid);

}
```

```cpp
#include <hip/hip_runtime.h>
#include <hip/hip_cooperative_groups.h>
#include <cstdio>
#include <cstdint>
namespace cg = cooperative_groups;


#define LAS __attribute__((address_space(3)))
typedef unsigned short bf16_t;
typedef short bf16x8 __attribute__((ext_vector_type(8)));
typedef float f32x4 __attribute__((ext_vector_type(4)));
typedef float f32x16 __attribute__((ext_vector_type(16)));
typedef unsigned u32x4 __attribute__((ext_vector_type(4)));
typedef unsigned u32x2 __attribute__((ext_vector_type(2)));

constexpr int NB = 8, SEQ = 4096, D = 1024, M = NB * SEQ;
constexpr int DSSM = 512, DIN = 2048, DFF = 2816, NUP = 2 * DFF, NMOD = 6 * D;
constexpr int NGRP = 32, TCH = 16, NCH = SEQ / TCH;
constexpr float EPS = 1e-6f;

constexpr size_t MiB = 1u << 20;
constexpr size_t WS_MOD = 0, WS_WIN = 1 * MiB, WS_GLU = 5 * MiB, WS_WOUT = 6 * MiB, WS_WUP = 8 * MiB, WS_WDN = 19 * MiB,
                 WS_HT = 25 * MiB, WS_SS = 36 * MiB, WS_H = 68 * MiB, WS_PROJ = 132 * MiB, WS_Z = 260 * MiB, WS_Y = 292 * MiB,
                 WS_T = 356 * MiB, WS_G = 132 * MiB, WS_TAB = 420 * MiB, WS_XG = 426 * MiB, WS_END = 428 * MiB;
constexpr int TAB_KTAB = 0, TAB_M3 = 8704, TAB_M2 = 76288, TAB_LAMT = 145920, TAB_BYTES = 146432;

constexpr size_t WS_CNT = 512 * 1024 + 16384;
constexpr size_t CTL_ZERO = 16384 + 3 * 128 * 256;
constexpr size_t WS_BAR = 512 * 1024;
constexpr size_t WS_U = WS_PROJ;
constexpr int L_BARST = 152064, LDS_BYTES = 152080;

__device__ __forceinline__ unsigned pk2(float lo, float hi) { unsigned r; asm("v_cvt_pk_bf16_f32 %0, %1, %2" : "=v"(r) : "v"(lo), "v"(hi)); return r; }
__device__ __forceinline__ float bflo(unsigned w) { return __uint_as_float(w << 16); }
__device__ __forceinline__ float bfhi(unsigned w) { return __uint_as_float(w & 0xffff0000u); }
__device__ __forceinline__ float bf1(bf16_t h) { return __uint_as_float(((unsigned)h) << 16); }
__device__ __forceinline__ float wave_sum(float v) {
#pragma unroll
    for (int o = 1; o < 64; o <<= 1) v += __shfl_xor(v, o);
    return v;
}
__device__ __forceinline__ float sigmoidf_(float x) { return __builtin_amdgcn_rcpf(1.0f + __expf(-x)); }
__device__ __forceinline__ float siluf_(float x) { return x * __builtin_amdgcn_rcpf(1.0f + __expf(-x)); }
__device__ __forceinline__ float gelu_tanh(float y) {
    const float y2 = y * y;
    const float t = y * (-2.302208198f + -0.1029432397f * y2);
    return y * __builtin_amdgcn_rcpf(1.0f + __builtin_amdgcn_exp2f(t));
}
__device__ __forceinline__ int lane_id() { return (int)__builtin_amdgcn_mbcnt_hi(~0u, __builtin_amdgcn_mbcnt_lo(~0u, 0u)); }
#define LDS_WAIT() asm volatile("s_waitcnt lgkmcnt(0)" ::: "memory")

namespace pg8 {
constexpr int BM = 256, BK = 64, HALF = 128, HTB = HALF * BK * 2, STAGE_BYTES = 8 * HTB, NXCD = 8, WGM = 8;
__host__ __device__ __forceinline__ int lds_byte(int r, int c) { const int st = (r >> 4) * 2 + (c >> 5), rr = r & 15, cc = c & 31, ob = rr * 64 + cc * 2; return st * 1024 + (ob ^ (((ob >> 9) & 1) << 5)); }
__host__ __device__ __forceinline__ void stage_rc(int b, int& R, int& C) { const int st = b / 1024, sb = b % 1024, swz = sb ^ (((sb >> 9) & 1) << 5); R = (st >> 1) * 16 + swz / 64; C = (st & 1) * 32 + (swz % 64) / 2; }
__host__ __device__ __forceinline__ int perm32(int rho) { const int n = rho >> 4, i = rho & 15; return 8 * (i >> 2) + 4 * n + (i & 3); }
struct Unit { int pm, pn; };
struct Gemm { const bf16_t* A; const bf16_t* Bt; int M, N, K; };
struct StaticOrder {
    int nM, nN, nwg, G, c;
    __device__ void init(int M_, int N_, int G_, int c_) { nM = M_ / BM; nN = N_ / BM; nwg = nM * nN; G = G_; c = c_; }
    __device__ bool next(int i, Unit& u) const {
        const long L = (long)i * G + c; if (L >= nwg) return false;
        int wgid = (int)L; { const int q = nwg / NXCD, r = nwg % NXCD, xcd = wgid % NXCD, off = wgid / NXCD; wgid = (xcd < r ? xcd * (q + 1) : r * (q + 1) + (xcd - r) * q) + off; }
        const int nig = WGM * nN, gid = wgid / nig, fm = gid * WGM, gsz = (nM - fm) < WGM ? (nM - fm) : WGM;
        u.pm = fm + ((wgid % nig) % gsz); u.pn = (wgid % nig) / gsz; return true;
    }
};

template <class Epi, bool ALIGN_EPI, bool SP2>
__device__ __forceinline__ void gemm_phase(LAS unsigned char* lds, const Gemm g, const StaticOrder& S, const Epi& E, int wid0) {
    int tid_ = wid0 * 64 + lane_id(); asm volatile("" : "+v"(tid_));
    const int tid = tid_, wid = __builtin_amdgcn_readfirstlane(tid >> 6), lane = tid & 63, wr = wid >> 2, wc = wid & 3, fr = lane & 15, fq = lane >> 4;
    const int K = g.K, nt = K / BK;
    unsigned voffA[2], voffB[2];
#pragma unroll
    for (int i = 0; i < 2; ++i) { int R, C; stage_rc(tid * 16 + i * 8192, R, C); const int Rb = Epi::PERM ? ((R & ~31) + perm32(R & 31)) : R;
        const int Ra = Epi::PERM_A ? ((R & ~63) + 4 * (R & 15) + ((R >> 4) & 3)) : R;
        voffA[i] = (unsigned)(Ra * K + C) * 2u; voffB[i] = (unsigned)(Rb * K + C) * 2u; }
    const size_t kstep = (size_t)(BK * 2);
    const size_t hstep = (size_t)HALF * K * 2;
    const size_t tstep = 2 * hstep;
    const unsigned ldsw = (unsigned)wid * 1024u;
    const int aoff = lds_byte(wr * 64 + fr, fq * 8), boff = lds_byte(wc * 32 + fr, fq * 8);
#define PG8_SA(b, h) (((b) * 2 + (h)) * HTB)
#define PG8_SB(b, h) ((4 + (b) * 2 + (h)) * HTB)
#define PG8_STAGE(bufoff, gbase, voff) do { _Pragma("unroll") for (int _i = 0; _i < 2; ++_i) \
        __builtin_amdgcn_global_load_lds((const unsigned*)((const char*)(gbase) + (voff)[_i]), (LAS unsigned*)(lds + (bufoff) + ldsw + _i * 8192), 16, 0, 0); } while (0)
#define PG8_LDA(dst, b, h) do { _Pragma("unroll") for (int m = 0; m < 4; ++m) _Pragma("unroll") for (int k = 0; k < 2; ++k) dst[m][k] = *(const LAS bf16x8*)(lds + PG8_SA(b, h) + aoff + m * 2048 + k * 1024); } while (0)
#define PG8_LDB(dst, b, h) do { _Pragma("unroll") for (int n = 0; n < 2; ++n) _Pragma("unroll") for (int k = 0; k < 2; ++k) dst[n][k] = *(const LAS bf16x8*)(lds + PG8_SB(b, h) + boff + n * 2048 + k * 1024); } while (0)
#define PG8_MMA(ai, bj, At, Bt) do { __builtin_amdgcn_s_setprio(1); _Pragma("unroll") for (int m = 0; m < 4; ++m) _Pragma("unroll") for (int n = 0; n < 2; ++n) _Pragma("unroll") for (int k = 0; k < 2; ++k) \
        acc[ai][bj][m][n] = __builtin_amdgcn_mfma_f32_16x16x32_bf16(Bt[n][k], At[m][k], acc[ai][bj][m][n], 0, 0, 0); __builtin_amdgcn_s_setprio(0); } while (0)
#define PG8_WAIT_V(n) asm volatile("s_waitcnt vmcnt(" #n ")" ::: "memory")
#define PG8_WAIT_L(n) asm volatile("s_waitcnt lgkmcnt(" #n ")" ::: "memory")
#define PG8_BAR __builtin_amdgcn_s_barrier()
#define PG8_SCHED __builtin_amdgcn_sched_barrier(0)
    Unit cur, nxt; int ui = 0;
    if (!S.next(0, cur)) return;
    f32x4 acc[2][2][4][2];
#pragma unroll
    for (int a = 0; a < 2; ++a)
#pragma unroll
        for (int b = 0; b < 2; ++b)
#pragma unroll
            for (int m = 0; m < 4; ++m)
#pragma unroll
                for (int n = 0; n < 2; ++n) acc[a][b][m][n] = (f32x4){0.f, 0.f, 0.f, 0.f};
    bf16x8 At[4][2], B0[2][2], B1[2][2];
    const char* cA = (const char*)g.A + (size_t)cur.pm * tstep; const char* cB = (const char*)g.Bt + (size_t)cur.pn * tstep;
    E.begin(cur);
    if constexpr (SP2) {
        PG8_STAGE(PG8_SB(0, 0), cB, voffB); PG8_STAGE(PG8_SB(0, 1), cB + hstep, voffB); PG8_STAGE(PG8_SA(0, 0), cA, voffA); PG8_STAGE(PG8_SA(0, 1), cA + hstep, voffA);
        if (wr == 1) PG8_BAR;
        PG8_WAIT_V(2); PG8_BAR;
        PG8_STAGE(PG8_SB(1, 0), cB + kstep, voffB); PG8_STAGE(PG8_SA(1, 0), cA + kstep, voffA); PG8_STAGE(PG8_SB(1, 1), cB + hstep + kstep, voffB);
        PG8_WAIT_V(6); PG8_BAR;
    } else {
        PG8_STAGE(PG8_SB(0, 0), cB, voffB); PG8_STAGE(PG8_SA(0, 0), cA, voffA); PG8_STAGE(PG8_SB(0, 1), cB + hstep, voffB); PG8_STAGE(PG8_SA(0, 1), cA + hstep, voffA);
        if (wr == 1) PG8_BAR;
        PG8_WAIT_V(4); PG8_BAR;
        PG8_STAGE(PG8_SB(1, 0), cB + kstep, voffB); PG8_STAGE(PG8_SA(1, 0), cA + kstep, voffA); PG8_STAGE(PG8_SB(1, 1), cB + hstep + kstep, voffB);
        PG8_WAIT_V(6); PG8_BAR;
    }
    for (;;) {
        const bool has_next = S.next(ui + 1, nxt);
        const char* nA = has_next ? (const char*)g.A + (size_t)nxt.pm * tstep : cA; const char* nB = has_next ? (const char*)g.Bt + (size_t)nxt.pn * tstep : cB;
        for (int t = 0; t < nt; t += 2) {
            const bool last = (t == nt - 2);
            const char* a1 = cA + (size_t)(t + 1) * kstep;
            const char* a2 = last ? nA : cA + (size_t)(t + 2) * kstep; const char* b2 = last ? nB : cB + (size_t)(t + 2) * kstep;
            const char* a3 = a2 + kstep; const char* b3 = b2 + kstep;
            if constexpr (SP2) {
            PG8_LDB(B0, 0, 0); PG8_LDB(B1, 0, 1); PG8_SCHED; PG8_LDA(At, 0, 0); PG8_STAGE(PG8_SA(1, 1), a1 + hstep, voffA);
            PG8_WAIT_V(8); PG8_WAIT_L(0); PG8_BAR; PG8_MMA(0, 0, At, B0); PG8_MMA(0, 1, At, B1); PG8_BAR; PG8_SCHED;
            PG8_LDA(At, 0, 1); PG8_STAGE(PG8_SB(0, 0), b2, voffB); PG8_STAGE(PG8_SB(0, 1), b2 + hstep, voffB); PG8_STAGE(PG8_SA(0, 0), a2, voffA);
            PG8_WAIT_V(8); PG8_WAIT_L(0); PG8_BAR; PG8_MMA(1, 0, At, B0); PG8_MMA(1, 1, At, B1); PG8_BAR; PG8_SCHED;
            PG8_LDB(B0, 1, 0); PG8_LDB(B1, 1, 1); PG8_SCHED; PG8_LDA(At, 1, 0); PG8_STAGE(PG8_SA(0, 1), a2 + hstep, voffA);
            PG8_WAIT_V(8); PG8_WAIT_L(0); PG8_BAR; PG8_MMA(0, 0, At, B0); PG8_MMA(0, 1, At, B1); PG8_BAR; PG8_SCHED;
            PG8_LDA(At, 1, 1); PG8_STAGE(PG8_SB(1, 0), b3, voffB); PG8_STAGE(PG8_SB(1, 1), b3 + hstep, voffB); PG8_STAGE(PG8_SA(1, 0), a3, voffA);
            PG8_WAIT_V(8); PG8_WAIT_L(0); PG8_BAR; PG8_MMA(1, 0, At, B0); PG8_MMA(1, 1, At, B1); PG8_BAR; PG8_SCHED;
            } else {
            PG8_LDB(B0, 0, 0); PG8_SCHED; PG8_LDA(At, 0, 0); PG8_STAGE(PG8_SA(1, 1), a1 + hstep, voffA);
            PG8_WAIT_L(8); PG8_BAR; PG8_WAIT_L(0); PG8_MMA(0, 0, At, B0); PG8_BAR; PG8_SCHED;
            PG8_LDB(B1, 0, 1); PG8_STAGE(PG8_SB(0, 0), b2, voffB);
            PG8_BAR; PG8_WAIT_L(0); PG8_MMA(0, 1, At, B1); PG8_BAR;
            PG8_LDA(At, 0, 1); PG8_STAGE(PG8_SA(0, 0), a2, voffA);
            PG8_BAR; PG8_WAIT_L(0); PG8_MMA(1, 0, At, B0); PG8_BAR; PG8_SCHED;
            PG8_STAGE(PG8_SB(0, 1), b2 + hstep, voffB);
            PG8_WAIT_V(6); PG8_BAR; PG8_MMA(1, 1, At, B1); PG8_BAR;
            PG8_LDB(B0, 1, 0); PG8_SCHED; PG8_LDA(At, 1, 0); PG8_STAGE(PG8_SA(0, 1), a2 + hstep, voffA);
            PG8_WAIT_L(8); PG8_BAR; PG8_WAIT_L(0); PG8_MMA(0, 0, At, B0); PG8_BAR; PG8_SCHED;
            PG8_LDB(B1, 1, 1); PG8_STAGE(PG8_SB(1, 0), b3, voffB);
            PG8_BAR; PG8_WAIT_L(0); PG8_MMA(0, 1, At, B1); PG8_BAR;
            PG8_LDA(At, 1, 1); PG8_STAGE(PG8_SA(1, 0), a3, voffA);
            PG8_BAR; PG8_WAIT_L(0); PG8_MMA(1, 0, At, B0); PG8_BAR; PG8_SCHED;
            PG8_STAGE(PG8_SB(1, 1), b3 + hstep, voffB);
            PG8_WAIT_V(6); PG8_BAR; PG8_MMA(1, 1, At, B1); PG8_BAR;
            }
        }
        if constexpr (ALIGN_EPI) { if (wr == 0) PG8_BAR; }
        E(acc, cur, wr, wc, fr, fq, has_next ? nxt.pn : -1, ui);
        if (!has_next) break;
#pragma unroll
        for (int a = 0; a < 2; ++a)
#pragma unroll
            for (int b = 0; b < 2; ++b)
#pragma unroll
                for (int m = 0; m < 4; ++m)
#pragma unroll
                    for (int n = 0; n < 2; ++n) acc[a][b][m][n] = (f32x4){0.f, 0.f, 0.f, 0.f};
        cur = nxt; cA = nA; cB = nB; ++ui;
        if constexpr (ALIGN_EPI) { if (wr == 1) PG8_BAR; }
    }
    PG8_WAIT_V(0);
    if constexpr (!ALIGN_EPI) { if (wr == 0) PG8_BAR; }
    PG8_BAR;
#undef PG8_SA
#undef PG8_SB
#undef PG8_STAGE
#undef PG8_LDA
#undef PG8_LDB
#undef PG8_MMA
#undef PG8_WAIT_V
#undef PG8_WAIT_L
#undef PG8_SCHED
}

struct EpiGlu {
    static constexpr bool PERM = true, PERM_A = false;
    const bf16_t* Z; bf16_t* Y; const float* glu_b; const float* gss;
    __device__ __forceinline__ void begin(const Unit&) const {}
    __device__ __forceinline__ void operator()(const f32x4 (&acc)[2][2][4][2], const Unit& u, int wr, int wc, int fr, int fq, int, int) const {
        const int row0 = u.pm * BM + wr * 64 + fr, col0 = u.pn * BM + wc * 32 + 8 * fq;
#pragma unroll
        for (int bj = 0; bj < 2; ++bj) {
            const int cb = col0 + bj * HALF;
            const f32x4 b0 = *(const f32x4*)(glu_b + cb), b1 = *(const f32x4*)(glu_b + cb + 4);
            const f32x4 g0 = *(const f32x4*)(gss + cb), g1 = *(const f32x4*)(gss + cb + 4);
#pragma unroll
            for (int ai = 0; ai < 2; ++ai)
#pragma unroll
                for (int m = 0; m < 4; ++m) {
                    const size_t row = (size_t)(row0 + ai * HALF + m * 16);
                    const u32x4 zr = *(const u32x4*)(Z + row * DSSM + cb);
                    float z[8] = {bflo(zr.x), bfhi(zr.x), bflo(zr.y), bfhi(zr.y), bflo(zr.z), bfhi(zr.z), bflo(zr.w), bfhi(zr.w)};
                    float y[8]; float ss = 0.f;
#pragma unroll
                    for (int e = 0; e < 4; ++e) { y[e] = z[e] * sigmoidf_(acc[ai][bj][m][0][e] + b0[e]); y[4 + e] = z[4 + e] * sigmoidf_(acc[ai][bj][m][1][e] + b1[e]); }
#pragma unroll
                    for (int e = 0; e < 8; ++e) ss += y[e] * y[e];
                    ss += __shfl_xor(ss, 16);
                    const float rs = rsqrtf(ss * (1.0f / 16.0f) + EPS);
                    u32x4 w; w.x = pk2(y[0] * rs * g0[0], y[1] * rs * g0[1]); w.y = pk2(y[2] * rs * g0[2], y[3] * rs * g0[3]);
                    w.z = pk2(y[4] * rs * g1[0], y[5] * rs * g1[1]); w.w = pk2(y[6] * rs * g1[2], y[7] * rs * g1[3]);
                    *(u32x4*)(Y + row * D + cb) = w;
                }
        }
    }
};
__device__ __forceinline__ void fmac_shr1(float& o, float src, float w) { asm volatile("s_nop 1\n\tv_fmac_f32_dpp %0, %1, %2 row_shr:1 row_mask:0xf bank_mask:0xf bound_ctrl:1" : "+v"(o) : "v"(src), "v"(w)); }
__device__ __forceinline__ void fmac_shr1b(float& o, float src, float w) { asm volatile("v_fmac_f32_dpp %0, %1, %2 row_shr:1 row_mask:0xf bank_mask:0xf bound_ctrl:1" : "+v"(o) : "v"(src), "v"(w)); }
__device__ __forceinline__ void fmac_shr2(float& o, float src, float w) { asm volatile("v_fmac_f32_dpp %0, %1, %2 row_shr:2 row_mask:0xf bank_mask:0xf bound_ctrl:1" : "+v"(o) : "v"(src), "v"(w)); }
__device__ __forceinline__ void fmac_ror1(float& o, float src, float w) { asm volatile("v_fmac_f32_dpp %0, %1, %2 row_ror:1 row_mask:0xf bank_mask:0xf" : "+v"(o) : "v"(src), "v"(w)); }
__device__ __forceinline__ void fmac_ror2(float& o, float src, float w) { asm volatile("v_fmac_f32_dpp %0, %1, %2 row_ror:2 row_mask:0xf bank_mask:0xf" : "+v"(o) : "v"(src), "v"(w)); }
struct EpiUp {
    static constexpr bool PERM = true, PERM_A = false;
    bf16_t* G; float* HT; const float* fcw; LAS float* xb;
    __device__ __forceinline__ void begin(const Unit& u) const {
        const int tq = __builtin_amdgcn_readfirstlane(threadIdx.x >> 6) * 64 + lane_id();
        const int c0w = tq & 255, oc0 = (c0w < 128 ? 0 : DFF - 128) + u.pn * HALF + c0w;
        LAS float* wt = xb + 2048;
        wt[tq] = fcw[(size_t)(tq >> 8) * NUP + oc0]; if (tq < 256) wt[512 + tq] = fcw[2 * (size_t)NUP + oc0];
    }
    __device__ __forceinline__ void operator()(f32x4 (&acc)[2][2][4][2], const Unit& u, int wr, int wc, int fr_, int fq_, int next_pn, int ui) const {
        int lq = lane_id(); asm volatile("" : "+v"(lq));
        const int fr = lq & 15, fq = (lq >> 4) & 3;
        const int ct0 = wc * 32 + 8 * fq;
        LAS float* wt = xb + 2048 + (ui & 1) * 768;
        LAS float* wtn = xb + 2048 + ((ui + 1) & 1) * 768;
        const int tq = (wr * 4 + wc) * 64 + lq;
        const int c0w = tq & 255, oc0 = (c0w < 128 ? 0 : DFF - 128) + (next_pn < 0 ? 0 : next_pn) * HALF + c0w;
        const float wq0 = fcw[(size_t)(tq >> 8) * NUP + oc0];
        const float wq1 = (tq < 256) ? fcw[2 * (size_t)NUP + oc0] : 0.f;
        if (fr >= 14) {
#pragma unroll
            for (int ai = 0; ai < 2; ++ai)
#pragma unroll
                for (int bj = 0; bj < 2; ++bj)
#pragma unroll
                    for (int n = 0; n < 2; ++n) *(LAS f32x4*)(xb + ((ai * 2 + wr) * 2 + (fr - 14)) * 256 + bj * HALF + ct0 + 4 * n) = acc[ai][bj][3][n];
        }
        if (wr == 0 && fr < 2) {
            float* hp = HT + ((size_t)u.pm * 4 + fr) * NUP + (size_t)u.pn * 256 + ct0;
#pragma unroll
            for (int bj = 0; bj < 2; ++bj)
#pragma unroll
                for (int n = 0; n < 2; ++n) *(f32x4*)(hp + bj * HALF + 4 * n) = acc[0][bj][0][n];
        }
        if (wr == 1 && fr >= 14) {
            float* hp = HT + ((size_t)u.pm * 4 + 2 + (fr - 14)) * NUP + (size_t)u.pn * 256 + ct0;
#pragma unroll
            for (int bj = 0; bj < 2; ++bj)
#pragma unroll
                for (int n = 0; n < 2; ++n) *(f32x4*)(hp + bj * HALF + 4 * n) = acc[1][bj][3][n];
        }
        LDS_WAIT(); __builtin_amdgcn_s_barrier(); asm volatile("" ::: "memory");
#pragma unroll
        for (int bj = 0; bj < 2; ++bj)
#pragma unroll
            for (int n = 0; n < 2; ++n) {
                __builtin_amdgcn_sched_barrier(0);
                const int tc = bj * HALF + ct0 + 4 * n;
                const f32x4 w0 = *(const LAS f32x4*)(wt + tc), w1 = *(const LAS f32x4*)(wt + 256 + tc), w2 = *(const LAS f32x4*)(wt + 512 + tc);
                const int b0 = wr, b1 = 2 + wr;
                const f32x4 q14 = *(const LAS f32x4*)(xb + ((b0 > 0 ? b0 - 1 : 0) * 2 + 0) * 256 + tc), q15 = *(const LAS f32x4*)(xb + ((b0 > 0 ? b0 - 1 : 0) * 2 + 1) * 256 + tc);
                const f32x4 s14 = *(const LAS f32x4*)(xb + ((b1 - 1) * 2 + 0) * 256 + tc), s15 = *(const LAS f32x4*)(xb + ((b1 - 1) * 2 + 1) * 256 + tc);
#pragma unroll
                for (int e = 0; e < 4; ++e) {
                    const float w1m = (fr == 0) ? w1[e] : 0.f, w0m = (fr < 2) ? w0[e] : 0.f;
#pragma unroll
                    for (int ai = 0; ai < 2; ++ai) {
                        const float r14 = ai ? s14[e] : q14[e], r15 = ai ? s15[e] : q15[e];
                        float h = w1m * r15 + w0m * ((fr == 0) ? r14 : r15);
                        if (ai == 0 && b0 == 0) h = 0.f;
#pragma unroll
                        for (int m = 3; m >= 0; --m) {
                            const float cur = acc[ai][bj][m][n][e];
                            float v = w2[e] * cur;
                            fmac_shr1(v, cur, w1[e]); fmac_shr2(v, cur, w0[e]);
                            if (m > 0) { const float pb = acc[ai][bj][m - 1][n][e]; fmac_ror1(v, pb, w1m); fmac_ror2(v, pb, w0m); }
                            else v += h;
                            acc[ai][bj][m][n][e] = v;
                        }
                    }
                }
            }
        const int row0 = u.pm * BM + wr * 64 + fr, col0 = u.pn * HALF + ct0;
#pragma unroll
        for (int ai = 0; ai < 2; ++ai)
#pragma unroll
            for (int m = 0; m < 4; ++m) {
                __builtin_amdgcn_sched_barrier(0);
                const f32x4 a0 = acc[ai][0][m][0], a1 = acc[ai][0][m][1], v0 = acc[ai][1][m][0], v1 = acc[ai][1][m][1];
                u32x4 w; w.x = pk2(siluf_(a0[0]) * v0[0], siluf_(a0[1]) * v0[1]); w.y = pk2(siluf_(a0[2]) * v0[2], siluf_(a0[3]) * v0[3]);
                w.z = pk2(siluf_(a1[0]) * v1[0], siluf_(a1[1]) * v1[1]); w.w = pk2(siluf_(a1[2]) * v1[2], siluf_(a1[3]) * v1[3]);
                *(u32x4*)(G + (size_t)(row0 + ai * HALF + m * 16) * DFF + col0) = w;
            }
        wtn[tq] = wq0; if (tq < 256) wtn[512 + tq] = wq1;
    }
};

__device__ __forceinline__ void panel_rms(const f32x4 (&v)[2][2][4][2], const Unit& u, int wr, int wc, int fr, int fq, int tid, float* xg, unsigned* cnt, LAS float* tab) {
#pragma unroll
    for (int ai = 0; ai < 2; ++ai)
#pragma unroll
        for (int m = 0; m < 4; ++m) { float ss = 0.f;
#pragma unroll
            for (int bj = 0; bj < 2; ++bj)
#pragma unroll
                for (int n = 0; n < 2; ++n) { const f32x4 x = v[ai][bj][m][n]; ss += (x[0] * x[0] + x[1] * x[1]) + (x[2] * x[2] + x[3] * x[3]); }
            ss += __shfl_xor(ss, 16); ss += __shfl_xor(ss, 32);
            if (fq == 0) tab[(ai * HALF + wr * 64 + m * 16 + fr) * 4 + wc] = ss; }
    LDS_WAIT(); __builtin_amdgcn_s_barrier(); asm volatile("" ::: "memory");
    if (tid < 256) { const f32x4 p = *(const LAS f32x4*)(tab + tid * 4);
        __hip_atomic_store(xg + ((size_t)u.pm * 256 + tid) * 4 + u.pn, (p[0] + p[1]) + (p[2] + p[3]), __ATOMIC_RELAXED, __HIP_MEMORY_SCOPE_AGENT);
        asm volatile("s_waitcnt vmcnt(0)" ::: "memory");
        if ((tid & 63) == 0) __hip_atomic_fetch_add(cnt + 64 * u.pm, 1u, __ATOMIC_RELAXED, __HIP_MEMORY_SCOPE_AGENT); }
    if (tid < 64) { unsigned sp = 0;
        while ((unsigned)__builtin_amdgcn_readfirstlane(__hip_atomic_load(cnt + 64 * u.pm, __ATOMIC_RELAXED, __HIP_MEMORY_SCOPE_AGENT)) < 16u) { __builtin_amdgcn_s_sleep(1); if (++sp > (1u << 20)) break; }
        asm volatile("" ::: "memory"); }
    asm volatile("" ::: "memory"); __builtin_amdgcn_s_barrier(); asm volatile("" ::: "memory");
    if (tid < 256) { const float* q = xg + ((size_t)u.pm * 256 + tid) * 4; float s = 0.f;
#pragma unroll
        for (int k = 0; k < 4; ++k) s += __hip_atomic_load(q + k, __ATOMIC_RELAXED, __HIP_MEMORY_SCOPE_AGENT);
        tab[1024 + tid] = rsqrtf(s * (1.0f / D) + EPS); }
    LDS_WAIT(); __builtin_amdgcn_s_barrier(); asm volatile("" ::: "memory");
}
struct EpiDownNorm {
    static constexpr bool PERM = true, PERM_A = false;
    float* out; const float* mod; const float* gpost; float* xg; unsigned* cnt; LAS float* tab;
    __device__ __forceinline__ void begin(const Unit&) const {}
    __device__ __forceinline__ void operator()(const f32x4 (&acc)[2][2][4][2], const Unit& u, int wr, int wc, int fr_, int fq_, int, int) const {
        int lq = lane_id(); asm volatile("" : "+v"(lq));
        const int fr = lq & 15, fq = (lq >> 4) & 3, tid = (wr * 4 + wc) * 64 + lq;
        panel_rms(acc, u, wr, wc, fr, fq, tid, xg, cnt, tab);
        const int row0 = u.pm * BM + wr * 64 + fr, col0 = u.pn * BM + wc * 32 + 8 * fq, b = u.pm >> 4;
#pragma unroll
        for (int bj = 0; bj < 2; ++bj) {
            __builtin_amdgcn_sched_barrier(0);
            const int cb = col0 + bj * HALF;
            const f32x4 c0 = *(const f32x4*)(mod + b * NMOD + 5 * D + cb) * *(const f32x4*)(gpost + cb), c1 = *(const f32x4*)(mod + b * NMOD + 5 * D + cb + 4) * *(const f32x4*)(gpost + cb + 4);
#pragma unroll
            for (int ai = 0; ai < 2; ++ai)
#pragma unroll
                for (int m = 0; m < 4; ++m) { const int rl = ai * HALF + wr * 64 + m * 16 + fr; const float rs = tab[1024 + rl];
                    float* op = out + (size_t)(row0 + ai * HALF + m * 16) * D + cb;
                    const f32x4 x0 = *(const f32x4*)op, x1 = *(const f32x4*)(op + 4);
                    __builtin_nontemporal_store(x0 + c0 * (acc[ai][bj][m][0] * rs), (f32x4*)op); __builtin_nontemporal_store(x1 + c1 * (acc[ai][bj][m][1] * rs), (f32x4*)(op + 4)); }
        }
    }
};

struct EpiOutNorm {
    static constexpr bool PERM = true, PERM_A = false;
    const float* x; float* out; bf16_t* H; const float* mod; const float* gpostmix; const float* gpreffn; float* xg; unsigned* cnt; LAS float* tab;
    __device__ __forceinline__ void begin(const Unit&) const {}
    __device__ __forceinline__ void operator()(f32x4 (&acc)[2][2][4][2], const Unit& u, int wr, int wc, int fr_, int fq_, int, int) const {
        int lq = lane_id(); asm volatile("" : "+v"(lq));
        const int fr = lq & 15, fq = (lq >> 4) & 3, tid = (wr * 4 + wc) * 64 + lq;
        panel_rms(acc, u, wr, wc, fr, fq, tid, xg, cnt, tab);
        const int row0 = u.pm * BM + wr * 64 + fr, col0 = u.pn * BM + wc * 32 + 8 * fq, b = u.pm >> 4;
        const float* mb = mod + b * NMOD;
#pragma unroll
        for (int bj = 0; bj < 2; ++bj) {
            __builtin_amdgcn_sched_barrier(0);
            const int cb = col0 + bj * HALF;
            const f32x4 c0 = *(const f32x4*)(mb + 2 * D + cb) * *(const f32x4*)(gpostmix + cb), c1 = *(const f32x4*)(mb + 2 * D + cb + 4) * *(const f32x4*)(gpostmix + cb + 4);
#pragma unroll
            for (int ai = 0; ai < 2; ++ai)
#pragma unroll
                for (int m = 0; m < 4; ++m) { const int rl = ai * HALF + wr * 64 + m * 16 + fr; const float rs = tab[1024 + rl];
                    const size_t off = (size_t)(row0 + ai * HALF + m * 16) * D + cb;
                    const f32x4 x0 = *(const f32x4*)(x + off), x1 = *(const f32x4*)(x + off + 4);
                    const f32x4 y0 = x0 + c0 * (acc[ai][bj][m][0] * rs), y1 = x1 + c1 * (acc[ai][bj][m][1] * rs);
                    *(f32x4*)(out + off) = y0; *(f32x4*)(out + off + 4) = y1;
                    acc[ai][bj][m][0] = y0; acc[ai][bj][m][1] = y1; }
        }
        __builtin_amdgcn_sched_barrier(0);
        panel_rms(acc, u, wr, wc, fr, fq, tid, xg + (size_t)M * 4, cnt + 128 * 64, tab);
#pragma unroll
        for (int bj = 0; bj < 2; ++bj) {
            __builtin_amdgcn_sched_barrier(0);
            const int cb = col0 + bj * HALF;
            const f32x4 g0 = *(const f32x4*)(gpreffn + cb) * (*(const f32x4*)(mb + 4 * D + cb) + 1.0f), g1 = *(const f32x4*)(gpreffn + cb + 4) * (*(const f32x4*)(mb + 4 * D + cb + 4) + 1.0f);
            const f32x4 s0 = *(const f32x4*)(mb + 3 * D + cb), s1 = *(const f32x4*)(mb + 3 * D + cb + 4);
#pragma unroll
            for (int ai = 0; ai < 2; ++ai)
#pragma unroll
                for (int m = 0; m < 4; ++m) { const int rl = ai * HALF + wr * 64 + m * 16 + fr; const float rs = tab[1024 + rl];
                    const f32x4 h0 = acc[ai][bj][m][0] * rs * g0 + s0, h1 = acc[ai][bj][m][1] * rs * g1 + s1;
                    u32x4 w; w.x = pk2(h0[0], h0[1]); w.y = pk2(h0[2], h0[3]); w.z = pk2(h1[0], h1[1]); w.w = pk2(h1[2], h1[3]);
                    *(u32x4*)(H + (size_t)(row0 + ai * HALF + m * 16) * D + cb) = w; }
        }
    }
};

struct EpiIn {
    static constexpr bool PERM = true, PERM_A = true;
    bf16_t* Y; bf16_t* U; float* HTI; const float* convw; const float* gconv; LAS float* xb;
    __device__ __forceinline__ void begin(const Unit&) const {
        const int t = __builtin_amdgcn_readfirstlane(threadIdx.x >> 6) * 64 + lane_id();
        LAS float* wl = xb + 512 + 1024;
#pragma unroll
        for (int k = 0; k < 3; ++k) wl[k * 512 + t] = convw[k * 512 + t];
        wl[3 * 512 + t] = gconv[t];
    }
    __device__ __forceinline__ void operator()(f32x4 (&acc)[2][2][4][2], const Unit& u, int wr, int wc, int fr_, int fq_, int, int) const {
        int lq = lane_id(); asm volatile("" : "+v"(lq));
        const int fr = lq & 15, fq = (lq >> 4) & 3;
        const int ch4 = 16 * wc + 4 * fq, gch = 64 * u.pn + ch4;
        LAS float* tab = xb + 512;
        const LAS float* wl = xb + 512 + 1024;
#pragma unroll
        for (int ai = 0; ai < 2; ++ai)
#pragma unroll
            for (int m = 0; m < 4; ++m) acc[ai][0][m][0] = acc[ai][0][m][0] * acc[ai][0][m][1];
        if (fr == 15) {
#pragma unroll
            for (int ai = 0; ai < 2; ++ai) { *(LAS f32x4*)(xb + ((ai * 2 + wr) * 2 + 0) * 64 + ch4) = acc[ai][0][2][0]; *(LAS f32x4*)(xb + ((ai * 2 + wr) * 2 + 1) * 64 + ch4) = acc[ai][0][3][0]; }
        }
        if (wr == 0 && fr == 0) { float* hp = HTI + ((size_t)u.pm * 6) * 512 + gch;
            *(f32x4*)(hp) = acc[0][0][0][0]; *(f32x4*)(hp + 512) = acc[0][0][1][0]; *(f32x4*)(hp + 4 * 512) = acc[0][1][0][0]; *(f32x4*)(hp + 5 * 512) = acc[0][1][1][0]; }
        if (wr == 1 && fr == 15) { float* hp = HTI + ((size_t)u.pm * 6 + 2) * 512 + gch; *(f32x4*)(hp) = acc[1][0][2][0]; *(f32x4*)(hp + 512) = acc[1][0][3][0]; }
        LDS_WAIT(); __builtin_amdgcn_s_barrier(); asm volatile("" ::: "memory");
        const f32x4 w0 = *(const LAS f32x4*)(wl + gch), w1 = *(const LAS f32x4*)(wl + 512 + gch), w2 = *(const LAS f32x4*)(wl + 1024 + gch);
#pragma unroll
        for (int ai = 0; ai < 2; ++ai) {
            __builtin_amdgcn_sched_barrier(0);
            const int blk = ai * 2 + wr, pblk = blk > 0 ? blk - 1 : 0;
            const bool halo = (fr == 0) && (blk > 0);
            const f32x4 h2 = *(const LAS f32x4*)(xb + (pblk * 2 + 0) * 64 + ch4), h3 = *(const LAS f32x4*)(xb + (pblk * 2 + 1) * 64 + ch4);
#pragma unroll
            for (int e = 0; e < 4; ++e) {
                const float w1m = halo ? w1[e] : 0.f, w0m = halo ? w0[e] : 0.f;
                const float c0 = acc[ai][0][0][0][e], c1 = acc[ai][0][1][0][e], c2 = acc[ai][0][2][0][e], c3 = acc[ai][0][3][0][e];
                float o1 = w2[e] * c1 + w1[e] * c0 + w0m * h3[e];
                float o0 = w2[e] * c0 + w1m * h3[e] + w0m * h2[e];
                fmac_shr1(o1, c3, w0[e]); fmac_shr1b(o0, c3, w1[e]); fmac_shr1b(o0, c2, w0[e]);
                acc[ai][0][3][0][e] = acc[ai][1][3][0][e] * (w2[e] * c3 + w1[e] * c2 + w0[e] * c1);
                acc[ai][0][2][0][e] = acc[ai][1][2][0][e] * (w2[e] * c2 + w1[e] * c1 + w0[e] * c0);
                acc[ai][0][1][0][e] = acc[ai][1][1][0][e] * o1; acc[ai][0][0][0][e] = acc[ai][1][0][0][e] * o0;
            }
        }
#pragma unroll
        for (int ai = 0; ai < 2; ++ai)
#pragma unroll
            for (int m = 0; m < 4; ++m) { const f32x4 y = acc[ai][0][m][0]; float ss = (y[0] * y[0] + y[1] * y[1]) + (y[2] * y[2] + y[3] * y[3]);
                ss += __shfl_xor(ss, 16); ss += __shfl_xor(ss, 32);
                if (fq == 0) tab[(ai * HALF + wr * 64 + 4 * fr + m) * 4 + wc] = ss; }
        LDS_WAIT(); __builtin_amdgcn_s_barrier(); asm volatile("" ::: "memory");
        const f32x4 gg = *(const LAS f32x4*)(wl + 1536 + gch);
        const int row0 = u.pm * BM + wr * 64 + 4 * fr;
#pragma unroll
        for (int ai = 0; ai < 2; ++ai)
#pragma unroll
            for (int m = 0; m < 4; ++m) { const int rl = ai * HALF + wr * 64 + 4 * fr + m; const f32x4 pp = *(const LAS f32x4*)(tab + rl * 4);
                const float rs = rsqrtf(((pp[0] + pp[1]) + (pp[2] + pp[3])) * (1.0f / 64.0f) + EPS);
                const f32x4 y = acc[ai][0][m][0] * rs * gg, uu = acc[ai][1][m][1];
                const size_t row = (size_t)(row0 + ai * HALF + m);
                u32x2 wy; wy.x = pk2(y[0], y[1]); wy.y = pk2(y[2], y[3]); *(u32x2*)(Y + row * D + 512 + gch) = wy;
                u32x2 wu; wu.x = pk2(uu[0], uu[1]); wu.y = pk2(uu[2], uu[3]); *(u32x2*)(U + row * DSSM + gch) = wu; }
    }
};
#undef PG8_BAR
}

#define XB_TMO      128
#define XB_XCNT(j)  (256  + 64 * (j))
#define XB_XSUB(j)  (1280 + 64 * (j))
#define XB_XGEN(j)  (2304 + 64 * (j))
#define XB_TOP      3328
#define XB_TOPGEN   3392
#define XCD_BAR_WORDS 3456
#define XB_SPIN_CAP (1u << 18)

__device__ __forceinline__ unsigned xb_ld(unsigned* p)              { return __hip_atomic_load(p, __ATOMIC_RELAXED, __HIP_MEMORY_SCOPE_AGENT); }
__device__ __forceinline__ unsigned xb_add(unsigned* p, unsigned v) { return __hip_atomic_fetch_add(p, v, __ATOMIC_RELAXED, __HIP_MEMORY_SCOPE_AGENT); }
__device__ __forceinline__ unsigned xb_xcc_id() { return (unsigned)__builtin_amdgcn_s_getreg((3 << 11) | 20) & 0xFu; }
#define XB_SPIN(cond, bar) do { unsigned _sp = 0; while (cond) { __builtin_amdgcn_s_sleep(1); \
    if ((++_sp & 255u) == 0u) { if (xb_ld(&(bar)[XB_TMO])) break; if (_sp > XB_SPIN_CAP) { atomicAdd(&(bar)[XB_TMO], 1u); break; } } } } while (0)

struct XcdBarrier {
    unsigned* bar; unsigned x;
    volatile LAS unsigned* st;
};

__device__ __forceinline__ XcdBarrier xcd_barrier_post(unsigned* bar, volatile LAS unsigned* st) {
    XcdBarrier b; b.bar = bar; b.x = xb_xcc_id(); b.st = st;
    if (threadIdx.x == 0) (void)xb_add(&bar[XB_XCNT(b.x)], 1u);
    return b;
}
__device__ __forceinline__ void xcd_barrier_complete(unsigned* bar, unsigned x, unsigned& nloc, unsigned& nx) {
    const unsigned G = gridDim.x * gridDim.y * gridDim.z;
    unsigned sum, cnt, mine, sp = 0u;
    for (;;) {
        sum = 0u; cnt = 0u; mine = 0u;
#pragma unroll
        for (unsigned j = 0; j < 16; ++j) { const unsigned c = xb_ld(&bar[XB_XCNT(j)]); sum += c; cnt += (c > 0u) ? 1u : 0u; mine = (j == x) ? c : mine; }
        if (sum == G) break;
        __builtin_amdgcn_s_sleep(1);
        if ((++sp & 255u) == 0u) { if (xb_ld(&bar[XB_TMO])) break; if (sp > XB_SPIN_CAP) { atomicAdd(&bar[XB_TMO], 1u); break; } }
    }
    nloc = mine > 0u ? mine : 1u; nx = cnt > 0u ? cnt : 1u;
}

__device__ __forceinline__ void xcd_barrier(const XcdBarrier& b) {
    asm volatile("s_waitcnt vmcnt(0)" ::: "memory");
    __syncthreads();
    if (threadIdx.x == 0) {
        unsigned* bar = b.bar;
        __builtin_amdgcn_s_waitcnt(0);
        unsigned nloc = b.st[0], nx = b.st[1];
        if (nloc == 0u) { xcd_barrier_complete(bar, b.x, nloc, nx); b.st[0] = nloc; b.st[1] = nx; }
        const unsigned old = xb_add(&bar[XB_XSUB(b.x)], 1u);
        const unsigned gen = old / nloc;
        if (old + 1u == (gen + 1u) * nloc) {
            __builtin_amdgcn_fence(__ATOMIC_RELEASE, "agent");
            asm volatile("s_waitcnt vmcnt(0)" ::: "memory");
            const unsigned og = xb_add(&bar[XB_TOP], 1u);
            const unsigned tg = og / nx;
            if (og + 1u == (tg + 1u) * nx) xb_add(&bar[XB_TOPGEN], 1u);
            else XB_SPIN(xb_ld(&bar[XB_TOPGEN]) == tg, bar);
            __builtin_amdgcn_fence(__ATOMIC_ACQUIRE, "agent");
            xb_add(&bar[XB_XGEN(b.x)], 1u);
            asm volatile("s_waitcnt vmcnt(0)" ::: "memory");
        } else {
            XB_SPIN(xb_ld(&bar[XB_XGEN(b.x)]) == gen, bar);
            __builtin_amdgcn_fence(__ATOMIC_ACQUIRE, "agent");
            asm volatile("s_waitcnt vmcnt(0)" ::: "memory");
        }
    }
    __syncthreads();
}


struct Args { const float* in[26]; float* out; unsigned char* ws; int ph_lo, ph_hi; };
typedef const __attribute__((address_space(4))) Args* ArgsP;
__device__ __forceinline__ ArgsP opaque_args() { ArgsP p = (ArgsP)__builtin_amdgcn_kernarg_segment_ptr(); asm volatile("" : "+s"(p)); return p; }
enum { I_X = 0, I_C, I_WADA, I_BADA, I_GPREMIX, I_GPOSTMIX, I_WIN, I_LRE, I_LIM, I_LSTEP, I_BRE, I_BIM, I_CRE, I_CIM, I_DSKIP, I_GLUW, I_GLUB,
       I_GOSSM, I_CONVW, I_GOCONV, I_WOUT, I_GPREFFN, I_GPOSTFFN, I_WUP, I_FCW, I_WDN };

__device__ __forceinline__ int win_row(int col) {
    const int sec = col >> 9, within = col & 511, pn = within >> 6, ch = within & 63, wc = ch >> 4, fq = (ch >> 2) & 3, e = ch & 3;
    const int bj = (sec == 0 || sec == 1) ? 1 : 0, n = (sec == 0 || sec == 3) ? 1 : 0;
    return pn * 256 + bj * 128 + wc * 32 + fq * 8 + n * 4 + e;
}
template <bool WIN = false>
__device__ __forceinline__ void transpose_item(const float* W, int K, int N, bf16_t* WT, int drow, int k0, int n0, LAS float* scr, int lane) {
#pragma unroll
    for (int i = 0; i < 32; ++i) { const int kk = 2 * i + (lane >> 5); scr[kk * 33 + (lane & 31)] = __builtin_nontemporal_load(W + (size_t)(k0 + kk) * N + n0 + (lane & 31)); }
    LDS_WAIT();
    const int c = lane & 7;
#pragma unroll
    for (int j = 0; j < 4; ++j) { const int n = (lane >> 3) + 8 * j; const LAS float* s = scr + (8 * c) * 33 + n;
        u32x4 o; o.x = pk2(s[0 * 33], s[1 * 33]); o.y = pk2(s[2 * 33], s[3 * 33]); o.z = pk2(s[4 * 33], s[5 * 33]); o.w = pk2(s[6 * 33], s[7 * 33]);
        *(u32x4*)(WT + (size_t)(WIN ? win_row(n0 + n) : drow + n) * K + k0 + 8 * c) = o; }
    LDS_WAIT();
}

__device__ __forceinline__ void build_tables(ArgsP ap, LAS unsigned char* lds, int g, int tid) {
    LAS float* lamp = (LAS float*)(lds);
    LAS float* bbar = (LAS float*)(lds + 8704);
    LAS float* cc = (LAS float*)(lds + 8704 + 8192);
    unsigned char* img = ap->ws + WS_TAB + (size_t)g * TAB_BYTES;
    __syncthreads();
    const float step = expf(ap->in[I_LSTEP][g]);
    for (int i = tid; i < 17 * 64; i += 512) { const int d = i >> 6, p = i & 63;
        const float lr = fminf(ap->in[I_LRE][g * 64 + p], -1e-4f), li = ap->in[I_LIM][g * 64 + p];
        const float er = expf(lr * step * (float)d); float sn, cs; sincosf(li * step * (float)d, &sn, &cs);
        lamp[i * 2] = er * cs; lamp[i * 2 + 1] = er * sn;
        if (d == 16) { ((float*)(img + TAB_LAMT))[p * 2] = er * cs; ((float*)(img + TAB_LAMT))[p * 2 + 1] = er * sn; } }
    for (int i = tid; i < 64 * 16; i += 512) { const int p = i >> 4;
        const float lr = fminf(ap->in[I_LRE][g * 64 + p], -1e-4f), li = ap->in[I_LIM][g * 64 + p];
        const float ar = lr * step, ai = li * step;
        float sn, cs; sincosf(ai, &sn, &cs); const float em1 = expm1f(ar), ea = em1 + 1.0f; const float sh = sinf(0.5f * ai);
        const float nr = em1 * cs - 2.0f * sh * sh, ni = ea * sn;
        const float den = 1.0f / (lr * lr + li * li);
        const float qr = (nr * lr + ni * li) * den, qi = (ni * lr - nr * li) * den;
        const float br = ap->in[I_BRE][(size_t)g * 1024 + i], bi = ap->in[I_BIM][(size_t)g * 1024 + i];
        bbar[i * 2] = qr * br - qi * bi; bbar[i * 2 + 1] = qr * bi + qi * br; }
    for (int i = tid; i < 16 * 64; i += 512) { const int h = i >> 6, p = i & 63; cc[(p * 16 + h) * 2] = ap->in[I_CRE][(size_t)g * 1024 + i]; cc[(p * 16 + h) * 2 + 1] = ap->in[I_CIM][(size_t)g * 1024 + i]; }
    for (int i = tid; i < 128; i += 512) ((unsigned*)(img + TAB_KTAB))[i] = 0u;
    __syncthreads();
    if (tid < 256) { const int d = tid >> 4, h = tid & 15; float acc[16];
#pragma unroll
        for (int e = 0; e < 16; ++e) acc[e] = 0.f;
        for (int p = 0; p < 64; ++p) { const float lr = lamp[(d * 64 + p) * 2], li = lamp[(d * 64 + p) * 2 + 1], cr = cc[(p * 16 + h) * 2], ci = cc[(p * 16 + h) * 2 + 1];
            const float tr = cr * lr - ci * li, ti = cr * li + ci * lr;
#pragma unroll
            for (int q = 0; q < 8; ++q) { const f32x4 bb = *(const LAS f32x4*)(bbar + p * 32 + 4 * q); acc[2 * q] += tr * bb[0] - ti * bb[1]; acc[2 * q + 1] += tr * bb[2] - ti * bb[3]; } }
        if (d == 0) {
#pragma unroll
            for (int e = 0; e < 16; ++e) if (e == h) acc[e] += ap->in[I_DSKIP][16 * g + h]; }
        u32x4 o0, o1; o0.x = pk2(acc[0], acc[1]); o0.y = pk2(acc[2], acc[3]); o0.z = pk2(acc[4], acc[5]); o0.w = pk2(acc[6], acc[7]);
        o1.x = pk2(acc[8], acc[9]); o1.y = pk2(acc[10], acc[11]); o1.z = pk2(acc[12], acc[13]); o1.w = pk2(acc[14], acc[15]);
        u32x4* dst = (u32x4*)(img + TAB_KTAB + 512 + tid * 32); dst[0] = o0; dst[1] = o1; }
    for (int i = tid; i < 128 * 128; i += 512) { const int n = i >> 7, k = (i & 127) * 2, p = n & 63, j = k >> 4, hp = k & 15;
        const float lr = lamp[((15 - j) * 64 + p) * 2], li = lamp[((15 - j) * 64 + p) * 2 + 1];
        const f32x4 bb = *(const LAS f32x4*)(bbar + (p * 16 + hp) * 2);
        const float v0 = n < 64 ? (lr * bb[0] - li * bb[1]) : (lr * bb[1] + li * bb[0]), v1 = n < 64 ? (lr * bb[2] - li * bb[3]) : (lr * bb[3] + li * bb[2]);
        *(unsigned*)(img + TAB_M3 + n * 528 + k * 2) = pk2(v0, v1); }
    for (int i = tid; i < 256 * 64; i += 512) { const int n = i >> 6, q = (i & 63) * 2, p = q & 63, ii = n >> 4, h = n & 15;
        float v[2];
#pragma unroll
        for (int e = 0; e < 2; ++e) { const float lr = lamp[((ii + 1) * 64 + p + e) * 2], li = lamp[((ii + 1) * 64 + p + e) * 2 + 1], cr = cc[((p + e) * 16 + h) * 2], ci = cc[((p + e) * 16 + h) * 2 + 1];
            v[e] = q < 64 ? (cr * lr - ci * li) : -(cr * li + ci * lr); }
        *(unsigned*)(img + TAB_M2 + n * 272 + q * 2) = pk2(v[0], v[1]); }
    __syncthreads();
}
__device__ __forceinline__ void p0_prologue(ArgsP ap, LAS unsigned char* lds, int wid0) {
    int tid_ = wid0 * 64 + lane_id(); asm volatile("" : "+v"(tid_));
    const int tid = tid_, lane = tid & 63, wave = tid >> 6, G = gridDim.x;
    unsigned char* ws = ap->ws;
    if ((int)blockIdx.x < 96) {
        LAS float* cact = (LAS float*)(lds + 72 * 1024);
        LAS float* red = (LAS float*)(lds + 104 * 1024);
        const float* c = ap->in[I_C];
        for (int i = tid; i < NB * D; i += 512) cact[i] = siluf_(c[i]);
        __syncthreads();
        for (int item = blockIdx.x; item < 96; item += G) {
            const int col = item * 64 + lane, k0 = wave * 128;
            const float* wp = ap->in[I_WADA] + (size_t)k0 * NMOD + col;
            float acc[NB];
#pragma unroll
            for (int b = 0; b < NB; ++b) acc[b] = 0.f;
#pragma unroll 16
            for (int k = 0; k < 128; ++k) { const float w = __builtin_nontemporal_load(wp + (size_t)k * NMOD);
#pragma unroll
                for (int b = 0; b < NB; ++b) acc[b] += cact[b * D + k0 + k] * w; }
#pragma unroll
            for (int b = 0; b < NB; ++b) red[(wave * NB + b) * 64 + lane] = acc[b];
            __syncthreads();
            { const int b = wave; float s = ap->in[I_BADA][col];
#pragma unroll
              for (int w = 0; w < 8; ++w) s += red[(w * NB + b) * 64 + lane];
              ((float*)(ws + WS_MOD))[b * NMOD + col] = s; }
            asm volatile("s_waitcnt vmcnt(0)" ::: "memory");
            __syncthreads();
            if (tid == 0) { __builtin_amdgcn_fence(__ATOMIC_RELEASE, "agent"); asm volatile("s_waitcnt vmcnt(0)" ::: "memory");
                __hip_atomic_fetch_add((unsigned*)(ws + WS_BAR) + 64, 1u, __ATOMIC_RELAXED, __HIP_MEMORY_SCOPE_AGENT); }
        }
    }
    for (int w = blockIdx.x; w < 128; w += G) if (w >= 96) build_tables(ap, lds, w - 96, tid);
    LAS float* scr = (LAS float*)(lds + wave * 8704);
    const bool split = (G >= 256);
    if (split && (int)blockIdx.x < 128) return;
    const int gw = (split ? (int)blockIdx.x - 128 : (int)blockIdx.x) * 8 + wave, NGW = (split ? G - 128 : G) * 8;
    constexpr int I1 = 16 * 64, I2 = 8 * 16, I3 = 16 * 32, I4 = 16 * 176, I5 = 44 * 32, NIT = I1 + I2 + I3 + I4 + I5;
    for (int it = gw; it < NIT; it += NGW) {
        int r = it;
        if (r < I1) { const int nb = r % 64, kb = r / 64; transpose_item<true>(ap->in[I_WIN], D, DIN, (bf16_t*)(ws + WS_WIN), 0, 64 * kb, 32 * nb, scr, lane); continue; } r -= I1;
        if (r < I2) { const int nb = r % 16, kb = r / 16; transpose_item(ap->in[I_GLUW], DSSM, DSSM, (bf16_t*)(ws + WS_GLU), 32 * nb, 64 * kb, 32 * nb, scr, lane); continue; } r -= I2;
        if (r < I3) { const int nb = r % 32, kb = r / 32; transpose_item(ap->in[I_WOUT], D, D, (bf16_t*)(ws + WS_WOUT), 32 * nb, 64 * kb, 32 * nb, scr, lane); continue; } r -= I3;
        if (r < I4) { const int nb = r % 176, kb = r / 176; const int n0 = 32 * nb; const int j = n0 < DFF ? n0 : n0 - DFF;
            const int drow = (j / 128) * 256 + (n0 < DFF ? 0 : 128) + (j % 128);
            transpose_item(ap->in[I_WUP], D, NUP, (bf16_t*)(ws + WS_WUP), drow, 64 * kb, n0, scr, lane); continue; } r -= I4;
        { const int nb = r % 32, kb = r / 32; transpose_item(ap->in[I_WDN], DFF, D, (bf16_t*)(ws + WS_WDN), 32 * nb, 64 * kb, 32 * nb, scr, lane); }
    }
}

__device__ __forceinline__ void p1_rows(ArgsP ap, int wid0, bool wait_mod) {
    int tid_ = wid0 * 64 + lane_id(); asm volatile("" : "+v"(tid_));
    const int lane = tid_ & 63, wave = tid_ >> 6, G = gridDim.x;
    const float* mod = (const float*)(ap->ws + WS_MOD);
    bf16_t* H = (bf16_t*)(ap->ws + WS_H);
    if (wait_mod) {
        if (tid_ == 0) { unsigned* cnt = (unsigned*)(ap->ws + WS_BAR) + 64; unsigned sp = 0;
            while (__hip_atomic_load(cnt, __ATOMIC_RELAXED, __HIP_MEMORY_SCOPE_AGENT) < 96u) { __builtin_amdgcn_s_sleep(2); if (++sp > (1u << 22)) break; }
            __builtin_amdgcn_fence(__ATOMIC_ACQUIRE, "agent"); asm volatile("s_waitcnt vmcnt(0)" ::: "memory"); }
        __syncthreads();
    }
    const int vb = (G % 8 == 0) ? (int)(blockIdx.x % 8) * (G / 8) + (int)(blockIdx.x / 8) : (int)blockIdx.x;
    for (int base = (vb * 8 + wave) * 16; base < M; base += G * 8 * 16) {
        const int b = base / SEQ;
        f32x4 gs[4], sh[4];
#pragma unroll
        for (int j = 0; j < 4; ++j) { const int col = 4 * lane + 256 * j;
            const f32x4 g = *(const f32x4*)(ap->in[I_GPREMIX] + col), sc = *(const f32x4*)(mod + b * NMOD + D + col);
            gs[j] = g * (sc + 1.0f); sh[j] = *(const f32x4*)(mod + b * NMOD + col); }
#pragma unroll 1
        for (int rb = 0; rb < 16; rb += 4) {
            f32x4 v[4][4];
#pragma unroll
            for (int r = 0; r < 4; ++r) { const f32x4* xr = (const f32x4*)(ap->in[I_X] + (size_t)(base + rb + r) * D) + lane;
#pragma unroll
                for (int j = 0; j < 4; ++j) v[r][j] = __builtin_nontemporal_load(xr + 64 * j); }
#pragma unroll
            for (int r = 0; r < 4; ++r) { const size_t row = base + rb + r; float ss = 0.f;
#pragma unroll
                for (int j = 0; j < 4; ++j) ss += (v[r][j].x * v[r][j].x + v[r][j].y * v[r][j].y) + (v[r][j].z * v[r][j].z + v[r][j].w * v[r][j].w);
                const float rs = rsqrtf(wave_sum(ss) * (1.0f / D) + EPS);
                u32x2* o = (u32x2*)(H + row * D) + lane;
#pragma unroll
                for (int j = 0; j < 4; ++j) { const f32x4 h = v[r][j] * rs * gs[j] + sh[j]; u32x2 w; w.x = pk2(h.x, h.y); w.y = pk2(h.z, h.w); o[64 * j] = w; }
            }
        }
    }
}

constexpr int L_KTAB = 0, L_XS = 8704, L_MT = 78336, L_CARRY = 147968;
constexpr int L_BBAR = L_XS, L_CC = L_XS + 8192, L_LAMP = L_XS + 16384;
__device__ __forceinline__ void ssm_unit(ArgsP ap, LAS unsigned char* lds, int unit, int wid0) {
    int tid_ = wid0 * 64 + lane_id(); asm volatile("" : "+v"(tid_));
    const int tid = tid_, lane = tid & 63, wave = __builtin_amdgcn_readfirstlane(tid >> 6), b = unit & 7, g = unit >> 3;
    const bf16_t* UB = (const bf16_t*)(ap->ws + WS_U);
    bf16_t* Z = (bf16_t*)(ap->ws + WS_Z);
    float* SS = (float*)(ap->ws + WS_SS) + (size_t)unit * NCH * 128;
    const unsigned char* img = ap->ws + WS_TAB + (size_t)g * TAB_BYTES;
    __syncthreads();
    u32x4 t0[2], t1[9], m2r[9];
#pragma unroll
    for (int k = 0; k < 2; ++k) { const int i = tid + 512 * k; if (i < 8704 / 16) t0[k] = ((const u32x4*)(img + TAB_KTAB))[i]; }
#pragma unroll
    for (int k = 0; k < 9; ++k) { const int i = tid + 512 * k; if (i < 67584 / 16) t1[k] = ((const u32x4*)(img + TAB_M3))[i]; }
    const int r32 = lane & 31, hh = lane >> 5, c0 = wave * 32;
    const bf16_t* up = UB + ((size_t)b * SEQ + (size_t)(c0 + r32) * TCH) * DSSM + 16 * g + 8 * hh;
    f32x16 accS[4];
    {
    bf16x8 ufr[16];
#pragma unroll
    for (int j = 0; j < 16; ++j) ufr[j] = *(const bf16x8*)(up + (size_t)j * DSSM);
#pragma unroll
    for (int k = 0; k < 9; ++k) { const int i = tid + 512 * k; if (i < 69632 / 16) m2r[k] = ((const u32x4*)(img + TAB_M2))[i]; }
#pragma unroll
    for (int k = 0; k < 2; ++k) { const int i = tid + 512 * k; if (i < 8704 / 16) ((LAS u32x4*)(lds + L_KTAB))[i] = t0[k]; }
#pragma unroll
    for (int k = 0; k < 9; ++k) { const int i = tid + 512 * k; if (i < 67584 / 16) ((LAS u32x4*)(lds + L_MT))[i] = t1[k]; }
    __syncthreads();
#pragma unroll
    for (int nb = 0; nb < 4; ++nb) {
        __builtin_amdgcn_sched_barrier(0);
#pragma unroll
        for (int e = 0; e < 16; ++e) accS[nb][e] = 0.f;
#pragma unroll
        for (int j = 0; j < 16; ++j) { const bf16x8 bf = *(const LAS bf16x8*)(lds + L_MT + (32 * nb + r32) * 528 + (16 * j + 8 * hh) * 2);
            accS[nb] = __builtin_amdgcn_mfma_f32_32x32x16_bf16(ufr[j], bf, accS[nb], 0, 0, 0); }
    }
    }
    const int p = lane, sb = wave;
    const float ltr = ((const float*)(img + TAB_LAMT))[p * 2], lti = ((const float*)(img + TAB_LAMT))[p * 2 + 1];
    __syncthreads();
    { LAS float* sl = (LAS float*)(lds + L_XS);
#pragma unroll
      for (int nb = 0; nb < 4; ++nb)
#pragma unroll
          for (int e = 0; e < 16; ++e) sl[(c0 + (e & 3) + 8 * (e >> 2) + 4 * hh) * 128 + 32 * nb + r32] = accS[nb][e]; }
    __syncthreads();
    float er[32], ei[32];
    { const LAS float* sp = (const LAS float*)(lds + L_XS) + (32 * sb) * 128 + p;
#pragma unroll
      for (int k = 0; k < 32; ++k) { er[k] = sp[k * 128]; ei[k] = sp[k * 128 + 64]; } }
    __syncthreads();
#pragma unroll
    for (int k = 0; k < 9; ++k) { const int i = tid + 512 * k; if (i < 69632 / 16) ((LAS u32x4*)(lds + L_MT))[i] = m2r[k]; }
    { float xr = 0.f, xi = 0.f;
#pragma unroll
      for (int k = 0; k < 32; ++k) { const float sr = er[k], si = ei[k]; er[k] = xr; ei[k] = xi;
          const float nr = ltr * xr - lti * xi + sr, ni = ltr * xi + lti * xr + si; xr = nr; xi = ni; }
      LAS float* carry = (LAS float*)(lds + L_CARRY);
      carry[(sb * 64 + p) * 2] = xr; carry[(sb * 64 + p) * 2 + 1] = xi; }
    __syncthreads();
    { float l32r = ltr, l32i = lti;
#pragma unroll
      for (int s = 0; s < 5; ++s) { const float nr = l32r * l32r - l32i * l32i, ni = 2.0f * l32r * l32i; l32r = nr; l32i = ni; }
      const LAS float* carry = (const LAS float*)(lds + L_CARRY);
      float xr = 0.f, xi = 0.f;
      for (int s = 0; s < sb; ++s) { const float nr = l32r * xr - l32i * xi + carry[(s * 64 + p) * 2], ni = l32r * xi + l32i * xr + carry[(s * 64 + p) * 2 + 1]; xr = nr; xi = ni; }
      float pr = 1.f, pi = 0.f;
#pragma unroll
      for (int k = 0; k < 32; ++k) { const float vr = er[k] + pr * xr - pi * xi, vi = ei[k] + pr * xi + pi * xr;
          LAS bf16_t* xs = (LAS bf16_t*)(lds + L_XS + (32 * sb + k) * 272);
          const unsigned w = pk2(vr, vi); xs[p] = (bf16_t)(w & 0xffffu); xs[64 + p] = (bf16_t)(w >> 16);
          const float nr = pr * ltr - pi * lti, ni = pr * lti + pi * ltr; pr = nr; pi = ni; } }
    __syncthreads();
    __builtin_amdgcn_sched_barrier(0);
    bf16x8 ufr[16];
    { int l2 = lane_id(); asm volatile("" : "+v"(l2)); const int r2 = l2 & 31, h2 = (l2 >> 5) & 1;
      const bf16_t* up2 = UB + ((size_t)b * SEQ + (size_t)(c0 + r2) * TCH) * DSSM + 16 * g + 8 * h2;
#pragma unroll
      for (int j = 0; j < 16; ++j) ufr[j] = *(const bf16x8*)(up2 + (size_t)j * DSSM); }
#pragma unroll
    for (int half = 0; half < 2; ++half) {
        __builtin_amdgcn_sched_barrier(0);
        f32x16 acc[4];
#pragma unroll
        for (int q = 0; q < 4; ++q)
#pragma unroll
            for (int e = 0; e < 16; ++e) acc[q][e] = 0.f;
#pragma unroll
        for (int j = 0; j < 8 * half + 8; ++j)
#pragma unroll
            for (int q = 0; q < 4; ++q) { const int nb = 4 * half + q;
                if (j <= 2 * nb + 1) { int d1 = 2 * nb - j + (r32 >> 4) + 1; d1 = d1 < 0 ? 0 : d1;
                    const bf16x8 bf = *(const LAS bf16x8*)(lds + L_KTAB + d1 * 512 + (lane & 15) * 32 + 16 * hh);
                    acc[q] = __builtin_amdgcn_mfma_f32_32x32x16_bf16(ufr[j], bf, acc[q], 0, 0, 0); } }
#pragma unroll
        for (int ks = 0; ks < 8; ++ks) { const bf16x8 af = *(const LAS bf16x8*)(lds + L_XS + (c0 + r32) * 272 + (16 * ks + 8 * hh) * 2);
#pragma unroll
            for (int q = 0; q < 4; ++q) { const int nb = 4 * half + q;
                const bf16x8 bf = *(const LAS bf16x8*)(lds + L_MT + (32 * nb + r32) * 272 + (16 * ks + 8 * hh) * 2);
                acc[q] = __builtin_amdgcn_mfma_f32_32x32x16_bf16(af, bf, acc[q], 0, 0, 0); } }
#pragma unroll
        for (int q = 0; q < 4; ++q) { __builtin_amdgcn_sched_barrier(0); const int n = 32 * (4 * half + q) + r32, ii = n >> 4, ch = 16 * g + (n & 15);
#pragma unroll
            for (int e = 0; e < 16; ++e) { const int chunk = c0 + (e & 3) + 8 * (e >> 2) + 4 * hh; const size_t t = (size_t)b * SEQ + (size_t)chunk * TCH + ii;
                Z[t * DSSM + ch] = (bf16_t)(pk2(gelu_tanh(acc[q][e]), 0.f) & 0xffffu); } }
    }
    __syncthreads();
}
__device__ __forceinline__ void fix_conv_rows(ArgsP ap, int wid0) {
    const int lane = lane_id(), G = gridDim.x;
    const float* HTI = (const float*)(ap->ws + WS_HT);
    bf16_t* Y = (bf16_t*)(ap->ws + WS_Y);
    const int ch = 8 * lane;
    for (int it = blockIdx.x * 8 + wid0; it < (M / 256) * 2; it += G * 8) {
        const int pm = it >> 1, r = it & 1;
        if ((pm & 15) == 0) continue;
        const float* hp = HTI + ((size_t)(pm - 1) * 6) * 512 + ch, *hc = HTI + ((size_t)pm * 6) * 512 + ch;
        float yb[8]; float ss = 0.f;
#pragma unroll
        for (int e = 0; e < 8; ++e) {
            const float pm2 = hp[2 * 512 + e], pm1 = hp[3 * 512 + e], p0 = hc[e], p1 = hc[512 + e];
            const float w0 = ap->in[I_CONVW][ch + e], w1 = ap->in[I_CONVW][512 + ch + e], w2 = ap->in[I_CONVW][1024 + ch + e];
            const float cv = r == 0 ? (w0 * pm2 + w1 * pm1 + w2 * p0) : (w0 * pm1 + w1 * p0 + w2 * p1);
            yb[e] = hc[(4 + r) * 512 + e] * cv; ss += yb[e] * yb[e]; }
        ss += __shfl_xor(ss, 1); ss += __shfl_xor(ss, 2); ss += __shfl_xor(ss, 4);
        const float rs = rsqrtf(ss * (1.0f / 64.0f) + EPS);
        u32x4 w;
        w.x = pk2(yb[0] * rs * ap->in[I_GOCONV][ch + 0], yb[1] * rs * ap->in[I_GOCONV][ch + 1]); w.y = pk2(yb[2] * rs * ap->in[I_GOCONV][ch + 2], yb[3] * rs * ap->in[I_GOCONV][ch + 3]);
        w.z = pk2(yb[4] * rs * ap->in[I_GOCONV][ch + 4], yb[5] * rs * ap->in[I_GOCONV][ch + 5]); w.w = pk2(yb[6] * rs * ap->in[I_GOCONV][ch + 6], yb[7] * rs * ap->in[I_GOCONV][ch + 7]);
        *(u32x4*)(Y + ((size_t)pm * 256 + r) * D + 512 + ch) = w;
    }
}
__device__ __forceinline__ void fix_panel(ArgsP ap, int pm, int tid) {
    if ((pm & 15) == 0) return;
    const float* HT = (const float*)(ap->ws + WS_HT);
    const float* fcw = ap->in[I_FCW];
    bf16_t* Gm = (bf16_t*)(ap->ws + WS_G);
    const float* hp = HT + ((size_t)(pm - 1) * 4) * NUP, *hc = HT + ((size_t)pm * 4) * NUP;
    for (int j = tid; j < DFF; j += 512) {
        const int ia = (j >> 7) * 256 + (j & 127), iv = ia + 128;
        const float am2 = hp[2 * NUP + ia], am1 = hp[3 * NUP + ia], a0 = hc[ia], a1 = hc[NUP + ia];
        const float vm2 = hp[2 * NUP + iv], vm1 = hp[3 * NUP + iv], v0 = hc[iv], v1 = hc[NUP + iv];
        const float wa0 = fcw[j], wa1 = fcw[NUP + j], wa2 = fcw[2 * NUP + j], wv0 = fcw[DFF + j], wv1 = fcw[NUP + DFF + j], wv2 = fcw[2 * NUP + DFF + j];
        const float ca0 = wa0 * am2 + wa1 * am1 + wa2 * a0, ca1 = wa0 * am1 + wa1 * a0 + wa2 * a1;
        const float cv0 = wv0 * vm2 + wv1 * vm1 + wv2 * v0, cv1 = wv0 * vm1 + wv1 * v0 + wv2 * v1;
        Gm[((size_t)pm * 256) * DFF + j] = (bf16_t)(pk2(siluf_(ca0) * cv0, 0.f) & 0xffffu);
        Gm[((size_t)pm * 256 + 1) * DFF + j] = (bf16_t)(pk2(siluf_(ca1) * cv1, 0.f) & 0xffffu);
    }
}
__global__ void __launch_bounds__(512, 2) hymba_fwd(Args a_unused) {
    extern __shared__ __attribute__((aligned(16))) unsigned char shm[];
    LAS unsigned char* lds = (LAS unsigned char*)shm;
    cg::grid_group grid = cg::this_grid();
    const int wid0 = __builtin_amdgcn_readfirstlane(threadIdx.x >> 6);
    if (threadIdx.x < 4) ((LAS unsigned*)(lds + L_BARST))[threadIdx.x] = 0u;
    __syncthreads();
    XcdBarrier xbar = xcd_barrier_post((unsigned*)(opaque_args()->ws + WS_BAR), (volatile LAS unsigned*)(lds + L_BARST));
    if (opaque_args()->ph_lo < 0) grid.sync();
    const int G = gridDim.x;
#define SEAM() xcd_barrier(xbar)
    p0_prologue(opaque_args(), lds, wid0);
    p1_rows(opaque_args(), wid0, true);
    SEAM();
    {
        ArgsP ap = opaque_args(); unsigned char* ws = ap->ws;
        pg8::Gemm g{(const bf16_t*)(ws + WS_H), (const bf16_t*)(ws + WS_WIN), M, DIN, D}; pg8::StaticOrder S; S.init(M, DIN, G, blockIdx.x);
        pg8::EpiIn E{(bf16_t*)(ws + WS_Y), (bf16_t*)(ws + WS_U), (float*)(ws + WS_HT), ap->in[I_CONVW], ap->in[I_GOCONV], (LAS float*)(lds + pg8::STAGE_BYTES)};
        pg8::gemm_phase<pg8::EpiIn, true, true>(lds, g, S, E, wid0);
    }
    SEAM();
    fix_conv_rows(opaque_args(), wid0);
    for (int u = blockIdx.x; u < NB * NGRP; u += G) ssm_unit(opaque_args(), lds, u, wid0);
    SEAM();
    {
        ArgsP ap = opaque_args(); unsigned char* ws = ap->ws;
        pg8::Gemm g{(const bf16_t*)(ws + WS_Z), (const bf16_t*)(ws + WS_GLU), M, DSSM, DSSM}; pg8::StaticOrder S; S.init(M, DSSM, G, blockIdx.x);
        pg8::EpiGlu E{(const bf16_t*)(ws + WS_Z), (bf16_t*)(ws + WS_Y), ap->in[I_GLUB], ap->in[I_GOSSM]};
        pg8::gemm_phase<pg8::EpiGlu, true, true>(lds, g, S, E, wid0);
    }
    SEAM();
    {
        ArgsP ap = opaque_args(); unsigned char* ws = ap->ws;
        pg8::Gemm g{(const bf16_t*)(ws + WS_Y), (const bf16_t*)(ws + WS_WOUT), M, D, D}; pg8::StaticOrder S; S.init(M, D, G, blockIdx.x);
        pg8::EpiOutNorm E{ap->in[I_X], ap->out, (bf16_t*)(ws + WS_H), (const float*)(ws + WS_MOD), ap->in[I_GPOSTMIX], ap->in[I_GPREFFN],
                          (float*)(ws + WS_XG) + (size_t)M * 4, (unsigned*)(ws + WS_CNT) + 128 * 64, (LAS float*)(lds + pg8::STAGE_BYTES)};
        pg8::gemm_phase<pg8::EpiOutNorm, true, true>(lds, g, S, E, wid0);
    }
    SEAM();
    {
        ArgsP ap = opaque_args(); unsigned char* ws = ap->ws;
        pg8::Gemm g{(const bf16_t*)(ws + WS_H), (const bf16_t*)(ws + WS_WUP), M, NUP, D}; pg8::StaticOrder S; S.init(M, NUP, G, blockIdx.x);
        pg8::EpiUp E{(bf16_t*)(ws + WS_G), (float*)(ws + WS_HT), ap->in[I_FCW], (LAS float*)(lds + pg8::STAGE_BYTES)};
        pg8::gemm_phase<pg8::EpiUp, true, true>(lds, g, S, E, wid0);
    }
    SEAM();
    {
        ArgsP ap = opaque_args(); unsigned char* ws = ap->ws;
        pg8::Gemm g{(const bf16_t*)(ws + WS_G), (const bf16_t*)(ws + WS_WDN), M, D, DFF}; pg8::StaticOrder S; S.init(M, D, G, blockIdx.x);
        { pg8::Unit fu; const int ftid = wid0 * 64 + lane_id(); for (int i = 0; S.next(i, fu); ++i) fix_panel(ap, fu.pm, ftid);
          asm volatile("s_waitcnt vmcnt(0)" ::: "memory"); __syncthreads(); }
        pg8::EpiDownNorm E{ap->out, (const float*)(ws + WS_MOD), ap->in[I_GPOSTFFN], (float*)(ws + WS_XG), (unsigned*)(ws + WS_CNT), (LAS float*)(lds + pg8::STAGE_BYTES)};
        pg8::gemm_phase<pg8::EpiDownNorm, true, true>(lds, g, S, E, wid0);
    }
#undef SEAM
}

extern "C" void kernel_launch(void* const* d_in, const int* in_sizes, int n_in, void* d_out, int out_size, void* d_ws, size_t ws_size, hipStream_t stream) {
    static int grid = 0;
    if (grid == 0) {
        if (n_in != 26 || in_sizes[0] != M * D || out_size != M * D || ws_size < WS_END) { fprintf(stderr, "kernel_launch: unexpected shapes (n_in %d, ws %zu)\n", n_in, ws_size); grid = -1; return; }
        int dev = 0, cus = 0, per_cu = 0;
        hipGetDevice(&dev); hipDeviceGetAttribute(&cus, hipDeviceAttributeMultiprocessorCount, dev);
        if (hipFuncSetAttribute((const void*)hymba_fwd, hipFuncAttributeMaxDynamicSharedMemorySize, LDS_BYTES) != hipSuccess) { fprintf(stderr, "kernel_launch: hipFuncSetAttribute failed\n"); }
        if (hipOccupancyMaxActiveBlocksPerMultiprocessor(&per_cu, (const void*)hymba_fwd, 512, LDS_BYTES) != hipSuccess || per_cu < 1) per_cu = 1;
        (void)hipGetLastError();
        grid = cus * per_cu;
        if (grid > 256) grid = 256;
    }
    if (grid < 0) return;
    Args a{};
    for (int i = 0; i < 26; ++i) a.in[i] = (const float*)d_in[i];
    a.out = (float*)d_out; a.ws = (unsigned char*)d_ws;
    (void)hipMemsetAsync((char*)d_ws + WS_BAR, 0, CTL_ZERO, stream);
    a.ph_lo = 0; a.ph_hi = 0;
    void* args[] = {&a};
    hipError_t e = hipLaunchCooperativeKernel((const void*)hymba_fwd, dim3(grid), dim3(512), args, LDS_BYTES, stream);
    if (e != hipSuccess) fprintf(stderr, "cooperative launch failed: %s (grid %d)\n", hipGetErrorString(e), grid);

}
```

```cpp
#include <hip/hip_runtime.h>
#include <hip/hip_cooperative_groups.h>
#include <cstdio>
#include <cstdint>
namespace cg = cooperative_groups;


#define LAS __attribute__((address_space(3)))
typedef unsigned short bf16_t;
typedef short bf16x8 __attribute__((ext_vector_type(8)));
typedef float f32x4 __attribute__((ext_vector_type(4)));
typedef float f32x16 __attribute__((ext_vector_type(16)));
typedef unsigned u32x4 __attribute__((ext_vector_type(4)));
typedef unsigned u32x2 __attribute__((ext_vector_type(2)));

constexpr int NB = 8, SEQ = 4096, D = 1024, M = NB * SEQ;
constexpr int DSSM = 512, DIN = 2048, DFF = 2816, NUP = 2 * DFF, NMOD = 6 * D;
constexpr int NGRP = 32, TCH = 16, NCH = SEQ / TCH;
constexpr float EPS = 1e-6f;

constexpr size_t MiB = 1u << 20;
constexpr size_t WS_MOD = 0, WS_WIN = 1 * MiB, WS_GLU = 5 * MiB, WS_WOUT = 6 * MiB, WS_WUP = 8 * MiB, WS_WDN = 19 * MiB,
                 WS_HT = 25 * MiB, WS_SS = 36 * MiB, WS_H = 68 * MiB, WS_PROJ = 132 * MiB, WS_Z = 260 * MiB, WS_Y = 292 * MiB,
                 WS_T = 356 * MiB, WS_G = 132 * MiB, WS_TAB = 420 * MiB, WS_XG = 426 * MiB, WS_END = 428 * MiB;
constexpr int TAB_KTAB = 0, TAB_M3 = 8704, TAB_M2 = 76288, TAB_LAMT = 145920, TAB_BYTES = 146432;

constexpr size_t WS_CNT = 512 * 1024 + 16384;
constexpr size_t CTL_ZERO = 16384 + 3 * 128 * 256;
constexpr size_t WS_BAR = 512 * 1024;
constexpr size_t WS_U = WS_PROJ;
constexpr int L_BARST = 152064, LDS_BYTES = 152080;

__device__ __forceinline__ unsigned pk2(float lo, float hi) { unsigned r; asm("v_cvt_pk_bf16_f32 %0, %1, %2" : "=v"(r) : "v"(lo), "v"(hi)); return r; }
__device__ __forceinline__ float bflo(unsigned w) { return __uint_as_float(w << 16); }
__device__ __forceinline__ float bfhi(unsigned w) { return __uint_as_float(w & 0xffff0000u); }
__device__ __forceinline__ float bf1(bf16_t h) { return __uint_as_float(((unsigned)h) << 16); }
__device__ __forceinline__ float wave_sum(float v) {
#pragma unroll
    for (int o = 1; o < 64; o <<= 1) v += __shfl_xor(v, o);
    return v;
}
__device__ __forceinline__ float sigmoidf_(float x) { return __builtin_amdgcn_rcpf(1.0f + __expf(-x)); }
__device__ __forceinline__ float siluf_(float x) { return x * __builtin_amdgcn_rcpf(1.0f + __expf(-x)); }
__device__ __forceinline__ float gelu_tanh(float y) {
    const float y2 = y * y;
    const float t = y * (-2.302208198f + -0.1029432397f * y2);
    return y * __builtin_amdgcn_rcpf(1.0f + __builtin_amdgcn_exp2f(t));
}
__device__ __forceinline__ int lane_id() { return (int)__builtin_amdgcn_mbcnt_hi(~0u, __builtin_amdgcn_mbcnt_lo(~0u, 0u)); }
#define LDS_WAIT() asm volatile("s_waitcnt lgkmcnt(0)" ::: "memory")

namespace pg8 {
constexpr int BM = 256, BK = 64, HALF = 128, HTB = HALF * BK * 2, STAGE_BYTES = 8 * HTB, NXCD = 8, WGM = 8;
__host__ __device__ __forceinline__ int lds_byte(int r, int c) { const int st = (r >> 4) * 2 + (c >> 5), rr = r & 15, cc = c & 31, ob = rr * 64 + cc * 2; return st * 1024 + (ob ^ (((ob >> 9) & 1) << 5)); }
__host__ __device__ __forceinline__ void stage_rc(int b, int& R, int& C) { const int st = b / 1024, sb = b % 1024, swz = sb ^ (((sb >> 9) & 1) << 5); R = (st >> 1) * 16 + swz / 64; C = (st & 1) * 32 + (swz % 64) / 2; }
__host__ __device__ __forceinline__ int perm32(int rho) { const int n = rho >> 4, i = rho & 15; return 8 * (i >> 2) + 4 * n + (i & 3); }
struct Unit { int pm, pn; };
struct Gemm { const bf16_t* A; const bf16_t* Bt; int M, N, K; };
struct StaticOrder {
    int nM, nN, nwg, G, c;
    __device__ void init(int M_, int N_, int G_, int c_) { nM = M_ / BM; nN = N_ / BM; nwg = nM * nN; G = G_; c = c_; }
    __device__ bool next(int i, Unit& u) const {
        const long L = (long)i * G + c; if (L >= nwg) return false;
        int wgid = (int)L; { const int q = nwg / NXCD, r = nwg % NXCD, xcd = wgid % NXCD, off = wgid / NXCD; wgid = (xcd < r ? xcd * (q + 1) : r * (q + 1) + (xcd - r) * q) + off; }
        const int nig = WGM * nN, gid = wgid / nig, fm = gid * WGM, gsz = (nM - fm) < WGM ? (nM - fm) : WGM;
        u.pm = fm + ((wgid % nig) % gsz); u.pn = (wgid % nig) / gsz; return true;
    }
};

template <class Epi, bool ALIGN_EPI, bool SP2>
__device__ __forceinline__ void gemm_phase(LAS unsigned char* lds, const Gemm g, const StaticOrder& S, const Epi& E, int wid0) {
    int tid_ = wid0 * 64 + lane_id(); asm volatile("" : "+v"(tid_));
    const int tid = tid_, wid = __builtin_amdgcn_readfirstlane(tid >> 6), lane = tid & 63, wr = wid >> 2, wc = wid & 3, fr = lane & 15, fq = lane >> 4;
    const int K = g.K, nt = K / BK;
    unsigned voffA[2], voffB[2];
#pragma unroll
    for (int i = 0; i < 2; ++i) { int R, C; stage_rc(tid * 16 + i * 8192, R, C); const int Rb = Epi::PERM ? ((R & ~31) + perm32(R & 31)) : R;
        const int Ra = Epi::PERM_A ? ((R & ~63) + 4 * (R & 15) + ((R >> 4) & 3)) : R;
        voffA[i] = (unsigned)(Ra * K + C) * 2u; voffB[i] = (unsigned)(Rb * K + C) * 2u; }
    const size_t kstep = (size_t)(BK * 2);
    const size_t hstep = (size_t)HALF * K * 2;
    const size_t tstep = 2 * hstep;
    const unsigned ldsw = (unsigned)wid * 1024u;
    const int aoff = lds_byte(wr * 64 + fr, fq * 8), boff = lds_byte(wc * 32 + fr, fq * 8);
#define PG8_SA(b, h) (((b) * 2 + (h)) * HTB)
#define PG8_SB(b, h) ((4 + (b) * 2 + (h)) * HTB)
#define PG8_STAGE(bufoff, gbase, voff) do { _Pragma("unroll") for (int _i = 0; _i < 2; ++_i) \
        __builtin_amdgcn_global_load_lds((const unsigned*)((const char*)(gbase) + (voff)[_i]), (LAS unsigned*)(lds + (bufoff) + ldsw + _i * 8192), 16, 0, 0); } while (0)
#define PG8_LDA(dst, b, h) do { _Pragma("unroll") for (int m = 0; m < 4; ++m) _Pragma("unroll") for (int k = 0; k < 2; ++k) dst[m][k] = *(const LAS bf16x8*)(lds + PG8_SA(b, h) + aoff + m * 2048 + k * 1024); } while (0)
#define PG8_LDB(dst, b, h) do { _Pragma("unroll") for (int n = 0; n < 2; ++n) _Pragma("unroll") for (int k = 0; k < 2; ++k) dst[n][k] = *(const LAS bf16x8*)(lds + PG8_SB(b, h) + boff + n * 2048 + k * 1024); } while (0)
#define PG8_MMA(ai, bj, At, Bt) do { __builtin_amdgcn_s_setprio(1); _Pragma("unroll") for (int m = 0; m < 4; ++m) _Pragma("unroll") for (int n = 0; n < 2; ++n) _Pragma("unroll") for (int k = 0; k < 2; ++k) \
        acc[ai][bj][m][n] = __builtin_amdgcn_mfma_f32_16x16x32_bf16(Bt[n][k], At[m][k], acc[ai][bj][m][n], 0, 0, 0); __builtin_amdgcn_s_setprio(0); } while (0)
#define PG8_WAIT_V(n) asm volatile("s_waitcnt vmcnt(" #n ")" ::: "memory")
#define PG8_WAIT_L(n) asm volatile("s_waitcnt lgkmcnt(" #n ")" ::: "memory")
#define PG8_BAR __builtin_amdgcn_s_barrier()
#define PG8_SCHED __builtin_amdgcn_sched_barrier(0)
    Unit cur, nxt; int ui = 0;
    if (!S.next(0, cur)) return;
    f32x4 acc[2][2][4][2];
#pragma unroll
    for (int a = 0; a < 2; ++a)
#pragma unroll
        for (int b = 0; b < 2; ++b)
#pragma unroll
            for (int m = 0; m < 4; ++m)
#pragma unroll
                for (int n = 0; n < 2; ++n) acc[a][b][m][n] = (f32x4){0.f, 0.f, 0.f, 0.f};
    bf16x8 At[4][2], B0[2][2], B1[2][2];
    const char* cA = (const char*)g.A + (size_t)cur.pm * tstep; const char* cB = (const char*)g.Bt + (size_t)cur.pn * tstep;
    E.begin(cur);
    if constexpr (SP2) {
        PG8_STAGE(PG8_SB(0, 0), cB, voffB); PG8_STAGE(PG8_SB(0, 1), cB + hstep, voffB); PG8_STAGE(PG8_SA(0, 0), cA, voffA); PG8_STAGE(PG8_SA(0, 1), cA + hstep, voffA);
        if (wr == 1) PG8_BAR;
        PG8_WAIT_V(2); PG8_BAR;
        PG8_STAGE(PG8_SB(1, 0), cB + kstep, voffB); PG8_STAGE(PG8_SA(1, 0), cA + kstep, voffA); PG8_STAGE(PG8_SB(1, 1), cB + hstep + kstep, voffB);
        PG8_WAIT_V(6); PG8_BAR;
    } else {
        PG8_STAGE(PG8_SB(0, 0), cB, voffB); PG8_STAGE(PG8_SA(0, 0), cA, voffA); PG8_STAGE(PG8_SB(0, 1), cB + hstep, voffB); PG8_STAGE(PG8_SA(0, 1), cA + hstep, voffA);
        if (wr == 1) PG8_BAR;
        PG8_WAIT_V(4); PG8_BAR;
        PG8_STAGE(PG8_SB(1, 0), cB + kstep, voffB); PG8_STAGE(PG8_SA(1, 0), cA + kstep, voffA); PG8_STAGE(PG8_SB(1, 1), cB + hstep + kstep, voffB);
        PG8_WAIT_V(6); PG8_BAR;
    }
    for (;;) {
        const bool has_next = S.next(ui + 1, nxt);
        const char* nA = has_next ? (const char*)g.A + (size_t)nxt.pm * tstep : cA; const char* nB = has_next ? (const char*)g.Bt + (size_t)nxt.pn * tstep : cB;
        for (int t = 0; t < nt; t += 2) {
            const bool last = (t == nt - 2);
            const char* a1 = cA + (size_t)(t + 1) * kstep;
            const char* a2 = last ? nA : cA + (size_t)(t + 2) * kstep; const char* b2 = last ? nB : cB + (size_t)(t + 2) * kstep;
            const char* a3 = a2 + kstep; const char* b3 = b2 + kstep;
            if constexpr (SP2) {
            PG8_LDB(B0, 0, 0); PG8_LDB(B1, 0, 1); PG8_SCHED; PG8_LDA(At, 0, 0); PG8_STAGE(PG8_SA(1, 1), a1 + hstep, voffA);
            PG8_WAIT_V(8); PG8_WAIT_L(0); PG8_BAR; PG8_MMA(0, 0, At, B0); PG8_MMA(0, 1, At, B1); PG8_BAR; PG8_SCHED;
            PG8_LDA(At, 0, 1); PG8_STAGE(PG8_SB(0, 0), b2, voffB); PG8_STAGE(PG8_SB(0, 1), b2 + hstep, voffB); PG8_STAGE(PG8_SA(0, 0), a2, voffA);
            PG8_WAIT_V(8); PG8_WAIT_L(0); PG8_BAR; PG8_MMA(1, 0, At, B0); PG8_MMA(1, 1, At, B1); PG8_BAR; PG8_SCHED;
            PG8_LDB(B0, 1, 0); PG8_LDB(B1, 1, 1); PG8_SCHED; PG8_LDA(At, 1, 0); PG8_STAGE(PG8_SA(0, 1), a2 + hstep, voffA);
            PG8_WAIT_V(8); PG8_WAIT_L(0); PG8_BAR; PG8_MMA(0, 0, At, B0); PG8_MMA(0, 1, At, B1); PG8_BAR; PG8_SCHED;
            PG8_LDA(At, 1, 1); PG8_STAGE(PG8_SB(1, 0), b3, voffB); PG8_STAGE(PG8_SB(1, 1), b3 + hstep, voffB); PG8_STAGE(PG8_SA(1, 0), a3, voffA);
            PG8_WAIT_V(8); PG8_WAIT_L(0); PG8_BAR; PG8_MMA(1, 0, At, B0); PG8_MMA(1, 1, At, B1); PG8_BAR; PG8_SCHED;
            } else {
            PG8_LDB(B0, 0, 0); PG8_SCHED; PG8_LDA(At, 0, 0); PG8_STAGE(PG8_SA(1, 1), a1 + hstep, voffA);
            PG8_WAIT_L(8); PG8_BAR; PG8_WAIT_L(0); PG8_MMA(0, 0, At, B0); PG8_BAR; PG8_SCHED;
            PG8_LDB(B1, 0, 1); PG8_STAGE(PG8_SB(0, 0), b2, voffB);
            PG8_BAR; PG8_WAIT_L(0); PG8_MMA(0, 1, At, B1); PG8_BAR;
            PG8_LDA(At, 0, 1); PG8_STAGE(PG8_SA(0, 0), a2, voffA);
            PG8_BAR; PG8_WAIT_L(0); PG8_MMA(1, 0, At, B0); PG8_BAR; PG8_SCHED;
            PG8_STAGE(PG8_SB(0, 1), b2 + hstep, voffB);
            PG8_WAIT_V(6); PG8_BAR; PG8_MMA(1, 1, At, B1); PG8_BAR;
            PG8_LDB(B0, 1, 0); PG8_SCHED; PG8_LDA(At, 1, 0); PG8_STAGE(PG8_SA(0, 1), a2 + hstep, voffA);
            PG8_WAIT_L(8); PG8_BAR; PG8_WAIT_L(0); PG8_MMA(0, 0, At, B0); PG8_BAR; PG8_SCHED;
            PG8_LDB(B1, 1, 1); PG8_STAGE(PG8_SB(1, 0), b3, voffB);
            PG8_BAR; PG8_WAIT_L(0); PG8_MMA(0, 1, At, B1); PG8_BAR;
            PG8_LDA(At, 1, 1); PG8_STAGE(PG8_SA(1, 0), a3, voffA);
            PG8_BAR; PG8_WAIT_L(0); PG8_MMA(1, 0, At, B0); PG8_BAR; PG8_SCHED;
            PG8_STAGE(PG8_SB(1, 1), b3 + hstep, voffB);
            PG8_WAIT_V(6); PG8_BAR; PG8_MMA(1, 1, At, B1); PG8_BAR;
            }
        }
        if constexpr (ALIGN_EPI) { if (wr == 0) PG8_BAR; }
        E(acc, cur, wr, wc, fr, fq, has_next ? nxt.pn : -1, ui);
        if (!has_next) break;
#pragma unroll
        for (int a = 0; a < 2; ++a)
#pragma unroll
            for (int b = 0; b < 2; ++b)
#pragma unroll
                for (int m = 0; m < 4; ++m)
#pragma unroll
                    for (int n = 0; n < 2; ++n) acc[a][b][m][n] = (f32x4){0.f, 0.f, 0.f, 0.f};
        cur = nxt; cA = nA; cB = nB; ++ui;
        if constexpr (ALIGN_EPI) { if (wr == 1) PG8_BAR; }
    }
    PG8_WAIT_V(0);
    if constexpr (!ALIGN_EPI) { if (wr == 0) PG8_BAR; }
    PG8_BAR;
#undef PG8_SA
#undef PG8_SB
#undef PG8_STAGE
#undef PG8_LDA
#undef PG8_LDB
#undef PG8_MMA
#undef PG8_WAIT_V
#undef PG8_WAIT_L
#undef PG8_SCHED
}

struct EpiGlu {
    static constexpr bool PERM = true, PERM_A = false;
    const bf16_t* Z; bf16_t* Y; const float* glu_b; const float* gss;
    __device__ __forceinline__ void begin(const Unit&) const {}
    __device__ __forceinline__ void operator()(const f32x4 (&acc)[2][2][4][2], const Unit& u, int wr, int wc, int fr, int fq, int, int) const {
        const int row0 = u.pm * BM + wr * 64 + fr, col0 = u.pn * BM + wc * 32 + 8 * fq;
#pragma unroll
        for (int bj = 0; bj < 2; ++bj) {
            const int cb = col0 + bj * HALF;
            const f32x4 b0 = *(const f32x4*)(glu_b + cb), b1 = *(const f32x4*)(glu_b + cb + 4);
            const f32x4 g0 = *(const f32x4*)(gss + cb), g1 = *(const f32x4*)(gss + cb + 4);
#pragma unroll
            for (int ai = 0; ai < 2; ++ai)
#pragma unroll
                for (int m = 0; m < 4; ++m) {
                    const size_t row = (size_t)(row0 + ai * HALF + m * 16);
                    const u32x4 zr = *(const u32x4*)(Z + row * DSSM + cb);
                    float z[8] = {bflo(zr.x), bfhi(zr.x), bflo(zr.y), bfhi(zr.y), bflo(zr.z), bfhi(zr.z), bflo(zr.w), bfhi(zr.w)};
                    float y[8]; float ss = 0.f;
#pragma unroll
                    for (int e = 0; e < 4; ++e) { y[e] = z[e] * sigmoidf_(acc[ai][bj][m][0][e] + b0[e]); y[4 + e] = z[4 + e] * sigmoidf_(acc[ai][bj][m][1][e] + b1[e]); }
#pragma unroll
                    for (int e = 0; e < 8; ++e) ss += y[e] * y[e];
                    ss += __shfl_xor(ss, 16);
                    const float rs = rsqrtf(ss * (1.0f / 16.0f) + EPS);
                    u32x4 w; w.x = pk2(y[0] * rs * g0[0], y[1] * rs * g0[1]); w.y = pk2(y[2] * rs * g0[2], y[3] * rs * g0[3]);
                    w.z = pk2(y[4] * rs * g1[0], y[5] * rs * g1[1]); w.w = pk2(y[6] * rs * g1[2], y[7] * rs * g1[3]);
                    *(u32x4*)(Y + row * D + cb) = w;
                }
        }
    }
};
__device__ __forceinline__ void fmac_shr1(float& o, float src, float w) { asm volatile("s_nop 1\n\tv_fmac_f32_dpp %0, %1, %2 row_shr:1 row_mask:0xf bank_mask:0xf bound_ctrl:1" : "+v"(o) : "v"(src), "v"(w)); }
__device__ __forceinline__ void fmac_shr1b(float& o, float src, float w) { asm volatile("v_fmac_f32_dpp %0, %1, %2 row_shr:1 row_mask:0xf bank_mask:0xf bound_ctrl:1" : "+v"(o) : "v"(src), "v"(w)); }
__device__ __forceinline__ void fmac_shr2(float& o, float src, float w) { asm volatile("v_fmac_f32_dpp %0, %1, %2 row_shr:2 row_mask:0xf bank_mask:0xf bound_ctrl:1" : "+v"(o) : "v"(src), "v"(w)); }
__device__ __forceinline__ void fmac_ror1(float& o, float src, float w) { asm volatile("v_fmac_f32_dpp %0, %1, %2 row_ror:1 row_mask:0xf bank_mask:0xf" : "+v"(o) : "v"(src), "v"(w)); }
__device__ __forceinline__ void fmac_ror2(float& o, float src, float w) { asm volatile("v_fmac_f32_dpp %0, %1, %2 row_ror:2 row_mask:0xf bank_mask:0xf" : "+v"(o) : "v"(src), "v"(w)); }
struct EpiUp {
    static constexpr bool PERM = true, PERM_A = false;
    bf16_t* G; float* HT; const float* fcw; LAS float* xb;
    __device__ __forceinline__ void begin(const Unit& u) const {
        const int tq = __builtin_amdgcn_readfirstlane(threadIdx.x >> 6) * 64 + lane_id();
        const int c0w = tq & 255, oc0 = (c0w < 128 ? 0 : DFF - 128) + u.pn * HALF + c0w;
        LAS float* wt = xb + 2048;
        wt[tq] = fcw[(size_t)(tq >> 8) * NUP + oc0]; if (tq < 256) wt[512 + tq] = fcw[2 * (size_t)NUP + oc0];
    }
    __device__ __forceinline__ void operator()(f32x4 (&acc)[2][2][4][2], const Unit& u, int wr, int wc, int fr_, int fq_, int next_pn, int ui) const {
        int lq = lane_id(); asm volatile("" : "+v"(lq));
        const int fr = lq & 15, fq = (lq >> 4) & 3;
        const int ct0 = wc * 32 + 8 * fq;
        LAS float* wt = xb + 2048 + (ui & 1) * 768;
        LAS float* wtn = xb + 2048 + ((ui + 1) & 1) * 768;
        const int tq = (wr * 4 + wc) * 64 + lq;
        const int c0w = tq & 255, oc0 = (c0w < 128 ? 0 : DFF - 128) + (next_pn < 0 ? 0 : next_pn) * HALF + c0w;
        const float wq0 = fcw[(size_t)(tq >> 8) * NUP + oc0];
        const float wq1 = (tq < 256) ? fcw[2 * (size_t)NUP + oc0] : 0.f;
        if (fr >= 14) {
#pragma unroll
            for (int ai = 0; ai < 2; ++ai)
#pragma unroll
                for (int bj = 0; bj < 2; ++bj)
#pragma unroll
                    for (int n = 0; n < 2; ++n) *(LAS f32x4*)(xb + ((ai * 2 + wr) * 2 + (fr - 14)) * 256 + bj * HALF + ct0 + 4 * n) = acc[ai][bj][3][n];
        }
        if (wr == 0 && fr < 2) {
            float* hp = HT + ((size_t)u.pm * 4 + fr) * NUP + (size_t)u.pn * 256 + ct0;
#pragma unroll
            for (int bj = 0; bj < 2; ++bj)
#pragma unroll
                for (int n = 0; n < 2; ++n) *(f32x4*)(hp + bj * HALF + 4 * n) = acc[0][bj][0][n];
        }
        if (wr == 1 && fr >= 14) {
            float* hp = HT + ((size_t)u.pm * 4 + 2 + (fr - 14)) * NUP + (size_t)u.pn * 256 + ct0;
#pragma unroll
            for (int bj = 0; bj < 2; ++bj)
#pragma unroll
                for (int n = 0; n < 2; ++n) *(f32x4*)(hp + bj * HALF + 4 * n) = acc[1][bj][3][n];
        }
        LDS_WAIT(); __builtin_amdgcn_s_barrier(); asm volatile("" ::: "memory");
#pragma unroll
        for (int bj = 0; bj < 2; ++bj)
#pragma unroll
            for (int n = 0; n < 2; ++n) {
                __builtin_amdgcn_sched_barrier(0);
                const int tc = bj * HALF + ct0 + 4 * n;
                const f32x4 w0 = *(const LAS f32x4*)(wt + tc), w1 = *(const LAS f32x4*)(wt + 256 + tc), w2 = *(const LAS f32x4*)(wt + 512 + tc);
                const int b0 = wr, b1 = 2 + wr;
                const f32x4 q14 = *(const LAS f32x4*)(xb + ((b0 > 0 ? b0 - 1 : 0) * 2 + 0) * 256 + tc), q15 = *(const LAS f32x4*)(xb + ((b0 > 0 ? b0 - 1 : 0) * 2 + 1) * 256 + tc);
                const f32x4 s14 = *(const LAS f32x4*)(xb + ((b1 - 1) * 2 + 0) * 256 + tc), s15 = *(const LAS f32x4*)(xb + ((b1 - 1) * 2 + 1) * 256 + tc);
#pragma unroll
                for (int e = 0; e < 4; ++e) {
                    const float w1m = (fr == 0) ? w1[e] : 0.f, w0m = (fr < 2) ? w0[e] : 0.f;
#pragma unroll
                    for (int ai = 0; ai < 2; ++ai) {
                        const float r14 = ai ? s14[e] : q14[e], r15 = ai ? s15[e] : q15[e];
                        float h = w1m * r15 + w0m * ((fr == 0) ? r14 : r15);
                        if (ai == 0 && b0 == 0) h = 0.f;
#pragma unroll
                        for (int m = 3; m >= 0; --m) {
                            const float cur = acc[ai][bj][m][n][e];
                            float v = w2[e] * cur;
                            fmac_shr1(v, cur, w1[e]); fmac_shr2(v, cur, w0[e]);
                            if (m > 0) { const float pb = acc[ai][bj][m - 1][n][e]; fmac_ror1(v, pb, w1m); fmac_ror2(v, pb, w0m); }
                            else v += h;
                            acc[ai][bj][m][n][e] = v;
                        }
                    }
                }
            }
        const int row0 = u.pm * BM + wr * 64 + fr, col0 = u.pn * HALF + ct0;
#pragma unroll
        for (int ai = 0; ai < 2; ++ai)
#pragma unroll
            for (int m = 0; m < 4; ++m) {
                __builtin_amdgcn_sched_barrier(0);
                const f32x4 a0 = acc[ai][0][m][0], a1 = acc[ai][0][m][1], v0 = acc[ai][1][m][0], v1 = acc[ai][1][m][1];
                u32x4 w; w.x = pk2(siluf_(a0[0]) * v0[0], siluf_(a0[1]) * v0[1]); w.y = pk2(siluf_(a0[2]) * v0[2], siluf_(a0[3]) * v0[3]);
                w.z = pk2(siluf_(a1[0]) * v1[0], siluf_(a1[1]) * v1[1]); w.w = pk2(siluf_(a1[2]) * v1[2], siluf_(a1[3]) * v1[3]);
                __builtin_nontemporal_store(w, (u32x4*)(G + (size_t)(row0 + ai * HALF + m * 16) * DFF + col0));
            }
        wtn[tq] = wq0; if (tq < 256) wtn[512 + tq] = wq1;
    }
};

__device__ __forceinline__ void panel_rms(const f32x4 (&v)[2][2][4][2], const Unit& u, int wr, int wc, int fr, int fq, int tid, float* xg, unsigned* cnt, LAS float* tab) {
#pragma unroll
    for (int ai = 0; ai < 2; ++ai)
#pragma unroll
        for (int m = 0; m < 4; ++m) { float ss = 0.f;
#pragma unroll
            for (int bj = 0; bj < 2; ++bj)
#pragma unroll
                for (int n = 0; n < 2; ++n) { const f32x4 x = v[ai][bj][m][n]; ss += (x[0] * x[0] + x[1] * x[1]) + (x[2] * x[2] + x[3] * x[3]); }
            ss += __shfl_xor(ss, 16); ss += __shfl_xor(ss, 32);
            if (fq == 0) tab[(ai * HALF + wr * 64 + m * 16 + fr) * 4 + wc] = ss; }
    LDS_WAIT(); __builtin_amdgcn_s_barrier(); asm volatile("" ::: "memory");
    if (tid < 256) { const f32x4 p = *(const LAS f32x4*)(tab + tid * 4);
        __hip_atomic_store(xg + ((size_t)u.pm * 256 + tid) * 4 + u.pn, (p[0] + p[1]) + (p[2] + p[3]), __ATOMIC_RELAXED, __HIP_MEMORY_SCOPE_AGENT);
        asm volatile("s_waitcnt vmcnt(0)" ::: "memory");
        if ((tid & 63) == 0) __hip_atomic_fetch_add(cnt + 64 * u.pm, 1u, __ATOMIC_RELAXED, __HIP_MEMORY_SCOPE_AGENT); }
    if (tid < 64) { unsigned sp = 0;
        while ((unsigned)__builtin_amdgcn_readfirstlane(__hip_atomic_load(cnt + 64 * u.pm, __ATOMIC_RELAXED, __HIP_MEMORY_SCOPE_AGENT)) < 16u) { __builtin_amdgcn_s_sleep(1); if (++sp > (1u << 20)) break; }
        asm volatile("" ::: "memory"); }
    asm volatile("" ::: "memory"); __builtin_amdgcn_s_barrier(); asm volatile("" ::: "memory");
    if (tid < 256) { const float* q = xg + ((size_t)u.pm * 256 + tid) * 4; float s = 0.f;
#pragma unroll
        for (int k = 0; k < 4; ++k) s += __hip_atomic_load(q + k, __ATOMIC_RELAXED, __HIP_MEMORY_SCOPE_AGENT);
        tab[1024 + tid] = rsqrtf(s * (1.0f / D) + EPS); }
    LDS_WAIT(); __builtin_amdgcn_s_barrier(); asm volatile("" ::: "memory");
}
struct EpiDownNorm {
    static constexpr bool PERM = true, PERM_A = false;
    float* out; const float* mod; const float* gpost; float* xg; unsigned* cnt; LAS float* tab;
    __device__ __forceinline__ void begin(const Unit&) const {}
    __device__ __forceinline__ void operator()(const f32x4 (&acc)[2][2][4][2], const Unit& u, int wr, int wc, int fr_, int fq_, int, int) const {
        int lq = lane_id(); asm volatile("" : "+v"(lq));
        const int fr = lq & 15, fq = (lq >> 4) & 3, tid = (wr * 4 + wc) * 64 + lq;
        panel_rms(acc, u, wr, wc, fr, fq, tid, xg, cnt, tab);
        const int row0 = u.pm * BM + wr * 64 + fr, col0 = u.pn * BM + wc * 32 + 8 * fq, b = u.pm >> 4;
#pragma unroll
        for (int bj = 0; bj < 2; ++bj) {
            __builtin_amdgcn_sched_barrier(0);
            const int cb = col0 + bj * HALF;
            const f32x4 c0 = *(const f32x4*)(mod + b * NMOD + 5 * D + cb) * *(const f32x4*)(gpost + cb), c1 = *(const f32x4*)(mod + b * NMOD + 5 * D + cb + 4) * *(const f32x4*)(gpost + cb + 4);
#pragma unroll
            for (int ai = 0; ai < 2; ++ai)
#pragma unroll
                for (int m = 0; m < 4; ++m) { const int rl = ai * HALF + wr * 64 + m * 16 + fr; const float rs = tab[1024 + rl];
                    float* op = out + (size_t)(row0 + ai * HALF + m * 16) * D + cb;
                    const f32x4 x0 = *(const f32x4*)op, x1 = *(const f32x4*)(op + 4);
                    __builtin_nontemporal_store(x0 + c0 * (acc[ai][bj][m][0] * rs), (f32x4*)op); __builtin_nontemporal_store(x1 + c1 * (acc[ai][bj][m][1] * rs), (f32x4*)(op + 4)); }
        }
    }
};

struct EpiOutNorm {
    static constexpr bool PERM = true, PERM_A = false;
    const float* x; float* out; bf16_t* H; const float* mod; const float* gpostmix; const float* gpreffn; float* xg; unsigned* cnt; LAS float* tab;
    __device__ __forceinline__ void begin(const Unit&) const {}
    __device__ __forceinline__ void operator()(f32x4 (&acc)[2][2][4][2], const Unit& u, int wr, int wc, int fr_, int fq_, int, int) const {
        int lq = lane_id(); asm volatile("" : "+v"(lq));
        const int fr = lq & 15, fq = (lq >> 4) & 3, tid = (wr * 4 + wc) * 64 + lq;
        panel_rms(acc, u, wr, wc, fr, fq, tid, xg, cnt, tab);
        const int row0 = u.pm * BM + wr * 64 + fr, col0 = u.pn * BM + wc * 32 + 8 * fq, b = u.pm >> 4;
        const float* mb = mod + b * NMOD;
#pragma unroll
        for (int bj = 0; bj < 2; ++bj) {
            __builtin_amdgcn_sched_barrier(0);
            const int cb = col0 + bj * HALF;
            const f32x4 c0 = *(const f32x4*)(mb + 2 * D + cb) * *(const f32x4*)(gpostmix + cb), c1 = *(const f32x4*)(mb + 2 * D + cb + 4) * *(const f32x4*)(gpostmix + cb + 4);
#pragma unroll
            for (int ai = 0; ai < 2; ++ai)
#pragma unroll
                for (int m = 0; m < 4; ++m) { const int rl = ai * HALF + wr * 64 + m * 16 + fr; const float rs = tab[1024 + rl];
                    const size_t off = (size_t)(row0 + ai * HALF + m * 16) * D + cb;
                    const f32x4 x0 = *(const f32x4*)(x + off), x1 = *(const f32x4*)(x + off + 4);
                    const f32x4 y0 = x0 + c0 * (acc[ai][bj][m][0] * rs), y1 = x1 + c1 * (acc[ai][bj][m][1] * rs);
                    *(f32x4*)(out + off) = y0; *(f32x4*)(out + off + 4) = y1;
                    acc[ai][bj][m][0] = y0; acc[ai][bj][m][1] = y1; }
        }
        __builtin_amdgcn_sched_barrier(0);
        panel_rms(acc, u, wr, wc, fr, fq, tid, xg + (size_t)M * 4, cnt + 128 * 64, tab);
#pragma unroll
        for (int bj = 0; bj < 2; ++bj) {
            __builtin_amdgcn_sched_barrier(0);
            const int cb = col0 + bj * HALF;
            const f32x4 g0 = *(const f32x4*)(gpreffn + cb) * (*(const f32x4*)(mb + 4 * D + cb) + 1.0f), g1 = *(const f32x4*)(gpreffn + cb + 4) * (*(const f32x4*)(mb + 4 * D + cb + 4) + 1.0f);
            const f32x4 s0 = *(const f32x4*)(mb + 3 * D + cb), s1 = *(const f32x4*)(mb + 3 * D + cb + 4);
#pragma unroll
            for (int ai = 0; ai < 2; ++ai)
#pragma unroll
                for (int m = 0; m < 4; ++m) { const int rl = ai * HALF + wr * 64 + m * 16 + fr; const float rs = tab[1024 + rl];
                    const f32x4 h0 = acc[ai][bj][m][0] * rs * g0 + s0, h1 = acc[ai][bj][m][1] * rs * g1 + s1;
                    u32x4 w; w.x = pk2(h0[0], h0[1]); w.y = pk2(h0[2], h0[3]); w.z = pk2(h1[0], h1[1]); w.w = pk2(h1[2], h1[3]);
                    *(u32x4*)(H + (size_t)(row0 + ai * HALF + m * 16) * D + cb) = w; }
        }
    }
};

struct EpiIn {
    static constexpr bool PERM = true, PERM_A = true;
    bf16_t* Y; bf16_t* U; float* HTI; const float* convw; const float* gconv; LAS float* xb;
    __device__ __forceinline__ void begin(const Unit&) const {
        const int t = __builtin_amdgcn_readfirstlane(threadIdx.x >> 6) * 64 + lane_id();
        LAS float* wl = xb + 512 + 1024;
#pragma unroll
        for (int k = 0; k < 3; ++k) wl[k * 512 + t] = convw[k * 512 + t];
        wl[3 * 512 + t] = gconv[t];
    }
    __device__ __forceinline__ void operator()(f32x4 (&acc)[2][2][4][2], const Unit& u, int wr, int wc, int fr_, int fq_, int, int) const {
        int lq = lane_id(); asm volatile("" : "+v"(lq));
        const int fr = lq & 15, fq = (lq >> 4) & 3;
        const int ch4 = 16 * wc + 4 * fq, gch = 64 * u.pn + ch4;
        LAS float* tab = xb + 512;
        const LAS float* wl = xb + 512 + 1024;
#pragma unroll
        for (int ai = 0; ai < 2; ++ai)
#pragma unroll
            for (int m = 0; m < 4; ++m) acc[ai][0][m][0] = acc[ai][0][m][0] * acc[ai][0][m][1];
        if (fr == 15) {
#pragma unroll
            for (int ai = 0; ai < 2; ++ai) { *(LAS f32x4*)(xb + ((ai * 2 + wr) * 2 + 0) * 64 + ch4) = acc[ai][0][2][0]; *(LAS f32x4*)(xb + ((ai * 2 + wr) * 2 + 1) * 64 + ch4) = acc[ai][0][3][0]; }
        }
        if (wr == 0 && fr == 0) { float* hp = HTI + ((size_t)u.pm * 6) * 512 + gch;
            *(f32x4*)(hp) = acc[0][0][0][0]; *(f32x4*)(hp + 512) = acc[0][0][1][0]; *(f32x4*)(hp + 4 * 512) = acc[0][1][0][0]; *(f32x4*)(hp + 5 * 512) = acc[0][1][1][0]; }
        if (wr == 1 && fr == 15) { float* hp = HTI + ((size_t)u.pm * 6 + 2) * 512 + gch; *(f32x4*)(hp) = acc[1][0][2][0]; *(f32x4*)(hp + 512) = acc[1][0][3][0]; }
        LDS_WAIT(); __builtin_amdgcn_s_barrier(); asm volatile("" ::: "memory");
        const f32x4 w0 = *(const LAS f32x4*)(wl + gch), w1 = *(const LAS f32x4*)(wl + 512 + gch), w2 = *(const LAS f32x4*)(wl + 1024 + gch);
#pragma unroll
        for (int ai = 0; ai < 2; ++ai) {
            __builtin_amdgcn_sched_barrier(0);
            const int blk = ai * 2 + wr, pblk = blk > 0 ? blk - 1 : 0;
            const bool halo = (fr == 0) && (blk > 0);
            const f32x4 h2 = *(const LAS f32x4*)(xb + (pblk * 2 + 0) * 64 + ch4), h3 = *(const LAS f32x4*)(xb + (pblk * 2 + 1) * 64 + ch4);
#pragma unroll
            for (int e = 0; e < 4; ++e) {
                const float w1m = halo ? w1[e] : 0.f, w0m = halo ? w0[e] : 0.f;
                const float c0 = acc[ai][0][0][0][e], c1 = acc[ai][0][1][0][e], c2 = acc[ai][0][2][0][e], c3 = acc[ai][0][3][0][e];
                float o1 = w2[e] * c1 + w1[e] * c0 + w0m * h3[e];
                float o0 = w2[e] * c0 + w1m * h3[e] + w0m * h2[e];
                fmac_shr1(o1, c3, w0[e]); fmac_shr1b(o0, c3, w1[e]); fmac_shr1b(o0, c2, w0[e]);
                acc[ai][0][3][0][e] = acc[ai][1][3][0][e] * (w2[e] * c3 + w1[e] * c2 + w0[e] * c1);
                acc[ai][0][2][0][e] = acc[ai][1][2][0][e] * (w2[e] * c2 + w1[e] * c1 + w0[e] * c0);
                acc[ai][0][1][0][e] = acc[ai][1][1][0][e] * o1; acc[ai][0][0][0][e] = acc[ai][1][0][0][e] * o0;
            }
        }
#pragma unroll
        for (int ai = 0; ai < 2; ++ai)
#pragma unroll
            for (int m = 0; m < 4; ++m) { const f32x4 y = acc[ai][0][m][0]; float ss = (y[0] * y[0] + y[1] * y[1]) + (y[2] * y[2] + y[3] * y[3]);
                ss += __shfl_xor(ss, 16); ss += __shfl_xor(ss, 32);
                if (fq == 0) tab[(ai * HALF + wr * 64 + 4 * fr + m) * 4 + wc] = ss; }
        LDS_WAIT(); __builtin_amdgcn_s_barrier(); asm volatile("" ::: "memory");
        const f32x4 gg = *(const LAS f32x4*)(wl + 1536 + gch);
        const int row0 = u.pm * BM + wr * 64 + 4 * fr;
#pragma unroll
        for (int ai = 0; ai < 2; ++ai)
#pragma unroll
            for (int m = 0; m < 4; ++m) { const int rl = ai * HALF + wr * 64 + 4 * fr + m; const f32x4 pp = *(const LAS f32x4*)(tab + rl * 4);
                const float rs = rsqrtf(((pp[0] + pp[1]) + (pp[2] + pp[3])) * (1.0f / 64.0f) + EPS);
                const f32x4 y = acc[ai][0][m][0] * rs * gg, uu = acc[ai][1][m][1];
                const size_t row = (size_t)(row0 + ai * HALF + m);
                u32x2 wy; wy.x = pk2(y[0], y[1]); wy.y = pk2(y[2], y[3]); *(u32x2*)(Y + row * D + 512 + gch) = wy;
                u32x2 wu; wu.x = pk2(uu[0], uu[1]); wu.y = pk2(uu[2], uu[3]); *(u32x2*)(U + row * DSSM + gch) = wu; }
    }
};
#undef PG8_BAR
}

#define XB_TMO      128
#define XB_XCNT(j)  (256  + 64 * (j))
#define XB_XSUB(j)  (1280 + 64 * (j))
#define XB_XGEN(j)  (2304 + 64 * (j))
#define XB_TOP      3328
#define XB_TOPGEN   3392
#define XCD_BAR_WORDS 3456
#define XB_SPIN_CAP (1u << 18)

__device__ __forceinline__ unsigned xb_ld(unsigned* p)              { return __hip_atomic_load(p, __ATOMIC_RELAXED, __HIP_MEMORY_SCOPE_AGENT); }
__device__ __forceinline__ unsigned xb_add(unsigned* p, unsigned v) { return __hip_atomic_fetch_add(p, v, __ATOMIC_RELAXED, __HIP_MEMORY_SCOPE_AGENT); }
__device__ __forceinline__ unsigned xb_xcc_id() { return (unsigned)__builtin_amdgcn_s_getreg((3 << 11) | 20) & 0xFu; }
#define XB_SPIN(cond, bar) do { unsigned _sp = 0; while (cond) { __builtin_amdgcn_s_sleep(1); \
    if ((++_sp & 255u) == 0u) { if (xb_ld(&(bar)[XB_TMO])) break; if (_sp > XB_SPIN_CAP) { atomicAdd(&(bar)[XB_TMO], 1u); break; } } } } while (0)

struct XcdBarrier {
    unsigned* bar; unsigned x;
    volatile LAS unsigned* st;
};

__device__ __forceinline__ XcdBarrier xcd_barrier_post(unsigned* bar, volatile LAS unsigned* st) {
    XcdBarrier b; b.bar = bar; b.x = xb_xcc_id(); b.st = st;
    if (threadIdx.x == 0) (void)xb_add(&bar[XB_XCNT(b.x)], 1u);
    return b;
}
__device__ __forceinline__ void xcd_barrier_complete(unsigned* bar, unsigned x, unsigned& nloc, unsigned& nx) {
    const unsigned G = gridDim.x * gridDim.y * gridDim.z;
    unsigned sum, cnt, mine, sp = 0u;
    for (;;) {
        sum = 0u; cnt = 0u; mine = 0u;
#pragma unroll
        for (unsigned j = 0; j < 16; ++j) { const unsigned c = xb_ld(&bar[XB_XCNT(j)]); sum += c; cnt += (c > 0u) ? 1u : 0u; mine = (j == x) ? c : mine; }
        if (sum == G) break;
        __builtin_amdgcn_s_sleep(1);
        if ((++sp & 255u) == 0u) { if (xb_ld(&bar[XB_TMO])) break; if (sp > XB_SPIN_CAP) { atomicAdd(&bar[XB_TMO], 1u); break; } }
    }
    nloc = mine > 0u ? mine : 1u; nx = cnt > 0u ? cnt : 1u;
}

__device__ __forceinline__ void xcd_barrier(const XcdBarrier& b) {
    asm volatile("s_waitcnt vmcnt(0)" ::: "memory");
    __syncthreads();
    if (threadIdx.x == 0) {
        unsigned* bar = b.bar;
        __builtin_amdgcn_s_waitcnt(0);
        unsigned nloc = b.st[0], nx = b.st[1];
        if (nloc == 0u) { xcd_barrier_complete(bar, b.x, nloc, nx); b.st[0] = nloc; b.st[1] = nx; }
        const unsigned old = xb_add(&bar[XB_XSUB(b.x)], 1u);
        const unsigned gen = old / nloc;
        if (old + 1u == (gen + 1u) * nloc) {
            __builtin_amdgcn_fence(__ATOMIC_RELEASE, "agent");
            asm volatile("s_waitcnt vmcnt(0)" ::: "memory");
            const unsigned og = xb_add(&bar[XB_TOP], 1u);
            const unsigned tg = og / nx;
            if (og + 1u == (tg + 1u) * nx) xb_add(&bar[XB_TOPGEN], 1u);
            else XB_SPIN(xb_ld(&bar[XB_TOPGEN]) == tg, bar);
            __builtin_amdgcn_fence(__ATOMIC_ACQUIRE, "agent");
            xb_add(&bar[XB_XGEN(b.x)], 1u);
            asm volatile("s_waitcnt vmcnt(0)" ::: "memory");
        } else {
            XB_SPIN(xb_ld(&bar[XB_XGEN(b.x)]) == gen, bar);
            __builtin_amdgcn_fence(__ATOMIC_ACQUIRE, "agent");
            asm volatile("s_waitcnt vmcnt(0)" ::: "memory");
        }
    }
    __syncthreads();
}


struct Args { const float* in[26]; float* out; unsigned char* ws; int ph_lo, ph_hi; };
typedef const __attribute__((address_space(4))) Args* ArgsP;
__device__ __forceinline__ ArgsP opaque_args() { ArgsP p = (ArgsP)__builtin_amdgcn_kernarg_segment_ptr(); asm volatile("" : "+s"(p)); return p; }
enum { I_X = 0, I_C, I_WADA, I_BADA, I_GPREMIX, I_GPOSTMIX, I_WIN, I_LRE, I_LIM, I_LSTEP, I_BRE, I_BIM, I_CRE, I_CIM, I_DSKIP, I_GLUW, I_GLUB,
       I_GOSSM, I_CONVW, I_GOCONV, I_WOUT, I_GPREFFN, I_GPOSTFFN, I_WUP, I_FCW, I_WDN };

__device__ __forceinline__ int win_row(int col) {
    const int sec = col >> 9, within = col & 511, pn = within >> 6, ch = within & 63, wc = ch >> 4, fq = (ch >> 2) & 3, e = ch & 3;
    const int bj = (sec == 0 || sec == 1) ? 1 : 0, n = (sec == 0 || sec == 3) ? 1 : 0;
    return pn * 256 + bj * 128 + wc * 32 + fq * 8 + n * 4 + e;
}
template <bool WIN = false>
__device__ __forceinline__ void transpose_item(const float* W, int K, int N, bf16_t* WT, int drow, int k0, int n0, LAS float* scr, int lane) {
#pragma unroll
    for (int i = 0; i < 32; ++i) { const int kk = 2 * i + (lane >> 5); scr[kk * 33 + (lane & 31)] = __builtin_nontemporal_load(W + (size_t)(k0 + kk) * N + n0 + (lane & 31)); }
    LDS_WAIT();
    const int c = lane & 7;
#pragma unroll
    for (int j = 0; j < 4; ++j) { const int n = (lane >> 3) + 8 * j; const LAS float* s = scr + (8 * c) * 33 + n;
        u32x4 o; o.x = pk2(s[0 * 33], s[1 * 33]); o.y = pk2(s[2 * 33], s[3 * 33]); o.z = pk2(s[4 * 33], s[5 * 33]); o.w = pk2(s[6 * 33], s[7 * 33]);
        *(u32x4*)(WT + (size_t)(WIN ? win_row(n0 + n) : drow + n) * K + k0 + 8 * c) = o; }
    LDS_WAIT();
}

__device__ __forceinline__ void build_tables(ArgsP ap, LAS unsigned char* lds, int g, int tid) {
    LAS float* lamp = (LAS float*)(lds);
    LAS float* bbar = (LAS float*)(lds + 8704);
    LAS float* cc = (LAS float*)(lds + 8704 + 8192);
    unsigned char* img = ap->ws + WS_TAB + (size_t)g * TAB_BYTES;
    __syncthreads();
    const float step = expf(ap->in[I_LSTEP][g]);
    for (int i = tid; i < 17 * 64; i += 512) { const int d = i >> 6, p = i & 63;
        const float lr = fminf(ap->in[I_LRE][g * 64 + p], -1e-4f), li = ap->in[I_LIM][g * 64 + p];
        const float er = expf(lr * step * (float)d); float sn, cs; sincosf(li * step * (float)d, &sn, &cs);
        lamp[i * 2] = er * cs; lamp[i * 2 + 1] = er * sn;
        if (d == 16) { ((float*)(img + TAB_LAMT))[p * 2] = er * cs; ((float*)(img + TAB_LAMT))[p * 2 + 1] = er * sn; } }
    for (int i = tid; i < 64 * 16; i += 512) { const int p = i >> 4;
        const float lr = fminf(ap->in[I_LRE][g * 64 + p], -1e-4f), li = ap->in[I_LIM][g * 64 + p];
        const float ar = lr * step, ai = li * step;
        float sn, cs; sincosf(ai, &sn, &cs); const float em1 = expm1f(ar), ea = em1 + 1.0f; const float sh = sinf(0.5f * ai);
        const float nr = em1 * cs - 2.0f * sh * sh, ni = ea * sn;
        const float den = 1.0f / (lr * lr + li * li);
        const float qr = (nr * lr + ni * li) * den, qi = (ni * lr - nr * li) * den;
        const float br = ap->in[I_BRE][(size_t)g * 1024 + i], bi = ap->in[I_BIM][(size_t)g * 1024 + i];
        bbar[i * 2] = qr * br - qi * bi; bbar[i * 2 + 1] = qr * bi + qi * br; }
    for (int i = tid; i < 16 * 64; i += 512) { const int h = i >> 6, p = i & 63; cc[(p * 16 + h) * 2] = ap->in[I_CRE][(size_t)g * 1024 + i]; cc[(p * 16 + h) * 2 + 1] = ap->in[I_CIM][(size_t)g * 1024 + i]; }
    for (int i = tid; i < 128; i += 512) ((unsigned*)(img + TAB_KTAB))[i] = 0u;
    __syncthreads();
    if (tid < 256) { const int d = tid >> 4, h = tid & 15; float acc[16];
#pragma unroll
        for (int e = 0; e < 16; ++e) acc[e] = 0.f;
        for (int p = 0; p < 64; ++p) { const float lr = lamp[(d * 64 + p) * 2], li = lamp[(d * 64 + p) * 2 + 1], cr = cc[(p * 16 + h) * 2], ci = cc[(p * 16 + h) * 2 + 1];
            const float tr = cr * lr - ci * li, ti = cr * li + ci * lr;
#pragma unroll
            for (int q = 0; q < 8; ++q) { const f32x4 bb = *(const LAS f32x4*)(bbar + p * 32 + 4 * q); acc[2 * q] += tr * bb[0] - ti * bb[1]; acc[2 * q + 1] += tr * bb[2] - ti * bb[3]; } }
        if (d == 0) {
#pragma unroll
            for (int e = 0; e < 16; ++e) if (e == h) acc[e] += ap->in[I_DSKIP][16 * g + h]; }
        u32x4 o0, o1; o0.x = pk2(acc[0], acc[1]); o0.y = pk2(acc[2], acc[3]); o0.z = pk2(acc[4], acc[5]); o0.w = pk2(acc[6], acc[7]);
        o1.x = pk2(acc[8], acc[9]); o1.y = pk2(acc[10], acc[11]); o1.z = pk2(acc[12], acc[13]); o1.w = pk2(acc[14], acc[15]);
        u32x4* dst = (u32x4*)(img + TAB_KTAB + 512 + tid * 32); dst[0] = o0; dst[1] = o1; }
    for (int i = tid; i < 128 * 128; i += 512) { const int n = i >> 7, k = (i & 127) * 2, p = n & 63, j = k >> 4, hp = k & 15;
        const float lr = lamp[((15 - j) * 64 + p) * 2], li = lamp[((15 - j) * 64 + p) * 2 + 1];
        const f32x4 bb = *(const LAS f32x4*)(bbar + (p * 16 + hp) * 2);
        const float v0 = n < 64 ? (lr * bb[0] - li * bb[1]) : (lr * bb[1] + li * bb[0]), v1 = n < 64 ? (lr * bb[2] - li * bb[3]) : (lr * bb[3] + li * bb[2]);
        *(unsigned*)(img + TAB_M3 + n * 528 + k * 2) = pk2(v0, v1); }
    for (int i = tid; i < 256 * 64; i += 512) { const int n = i >> 6, q = (i & 63) * 2, p = q & 63, ii = n >> 4, h = n & 15;
        float v[2];
#pragma unroll
        for (int e = 0; e < 2; ++e) { const float lr = lamp[((ii + 1) * 64 + p + e) * 2], li = lamp[((ii + 1) * 64 + p + e) * 2 + 1], cr = cc[((p + e) * 16 + h) * 2], ci = cc[((p + e) * 16 + h) * 2 + 1];
            v[e] = q < 64 ? (cr * lr - ci * li) : -(cr * li + ci * lr); }
        *(unsigned*)(img + TAB_M2 + n * 272 + q * 2) = pk2(v[0], v[1]); }
    __syncthreads();
}
__device__ __forceinline__ void p0_prologue(ArgsP ap, LAS unsigned char* lds, int wid0) {
    int tid_ = wid0 * 64 + lane_id(); asm volatile("" : "+v"(tid_));
    const int tid = tid_, lane = tid & 63, wave = tid >> 6, G = gridDim.x;
    unsigned char* ws = ap->ws;
    if ((int)blockIdx.x < 96) {
        LAS float* cact = (LAS float*)(lds + 72 * 1024);
        LAS float* red = (LAS float*)(lds + 104 * 1024);
        const float* c = ap->in[I_C];
        for (int i = tid; i < NB * D; i += 512) cact[i] = siluf_(c[i]);
        __syncthreads();
        for (int item = blockIdx.x; item < 96; item += G) {
            const int col = item * 64 + lane, k0 = wave * 128;
            const float* wp = ap->in[I_WADA] + (size_t)k0 * NMOD + col;
            float acc[NB];
#pragma unroll
            for (int b = 0; b < NB; ++b) acc[b] = 0.f;
#pragma unroll 16
            for (int k = 0; k < 128; ++k) { const float w = __builtin_nontemporal_load(wp + (size_t)k * NMOD);
#pragma unroll
                for (int b = 0; b < NB; ++b) acc[b] += cact[b * D + k0 + k] * w; }
#pragma unroll
            for (int b = 0; b < NB; ++b) red[(wave * NB + b) * 64 + lane] = acc[b];
            __syncthreads();
            { const int b = wave; float s = ap->in[I_BADA][col];
#pragma unroll
              for (int w = 0; w < 8; ++w) s += red[(w * NB + b) * 64 + lane];
              ((float*)(ws + WS_MOD))[b * NMOD + col] = s; }
            asm volatile("s_waitcnt vmcnt(0)" ::: "memory");
            __syncthreads();
            if (tid == 0) { __builtin_amdgcn_fence(__ATOMIC_RELEASE, "agent"); asm volatile("s_waitcnt vmcnt(0)" ::: "memory");
                __hip_atomic_fetch_add((unsigned*)(ws + WS_BAR) + 64, 1u, __ATOMIC_RELAXED, __HIP_MEMORY_SCOPE_AGENT); }
        }
    }
    for (int w = blockIdx.x; w < 128; w += G) if (w >= 96) build_tables(ap, lds, w - 96, tid);
    LAS float* scr = (LAS float*)(lds + wave * 8704);
    const bool split = (G >= 256);
    if (split && (int)blockIdx.x < 128) return;
    const int gw = (split ? (int)blockIdx.x - 128 : (int)blockIdx.x) * 8 + wave, NGW = (split ? G - 128 : G) * 8;
    constexpr int I1 = 16 * 64, I2 = 8 * 16, I3 = 16 * 32, I4 = 16 * 176, I5 = 44 * 32, NIT = I1 + I2 + I3 + I4 + I5;
    for (int it = gw; it < NIT; it += NGW) {
        int r = it;
        if (r < I1) { const int nb = r % 64, kb = r / 64; transpose_item<true>(ap->in[I_WIN], D, DIN, (bf16_t*)(ws + WS_WIN), 0, 64 * kb, 32 * nb, scr, lane); continue; } r -= I1;
        if (r < I2) { const int nb = r % 16, kb = r / 16; transpose_item(ap->in[I_GLUW], DSSM, DSSM, (bf16_t*)(ws + WS_GLU), 32 * nb, 64 * kb, 32 * nb, scr, lane); continue; } r -= I2;
        if (r < I3) { const int nb = r % 32, kb = r / 32; transpose_item(ap->in[I_WOUT], D, D, (bf16_t*)(ws + WS_WOUT), 32 * nb, 64 * kb, 32 * nb, scr, lane); continue; } r -= I3;
        if (r < I4) { const int nb = r % 176, kb = r / 176; const int n0 = 32 * nb; const int j = n0 < DFF ? n0 : n0 - DFF;
            const int drow = (j / 128) * 256 + (n0 < DFF ? 0 : 128) + (j % 128);
            transpose_item(ap->in[I_WUP], D, NUP, (bf16_t*)(ws + WS_WUP), drow, 64 * kb, n0, scr, lane); continue; } r -= I4;
        { const int nb = r % 32, kb = r / 32; transpose_item(ap->in[I_WDN], DFF, D, (bf16_t*)(ws + WS_WDN), 32 * nb, 64 * kb, 32 * nb, scr, lane); }
    }
}

__device__ __forceinline__ void p1_rows(ArgsP ap, int wid0, bool wait_mod) {
    int tid_ = wid0 * 64 + lane_id(); asm volatile("" : "+v"(tid_));
    const int lane = tid_ & 63, wave = tid_ >> 6, G = gridDim.x;
    const float* mod = (const float*)(ap->ws + WS_MOD);
    bf16_t* H = (bf16_t*)(ap->ws + WS_H);
    if (wait_mod) {
        if (tid_ == 0) { unsigned* cnt = (unsigned*)(ap->ws + WS_BAR) + 64; unsigned sp = 0;
            while (__hip_atomic_load(cnt, __ATOMIC_RELAXED, __HIP_MEMORY_SCOPE_AGENT) < 96u) { __builtin_amdgcn_s_sleep(2); if (++sp > (1u << 22)) break; }
            __builtin_amdgcn_fence(__ATOMIC_ACQUIRE, "agent"); asm volatile("s_waitcnt vmcnt(0)" ::: "memory"); }
        __syncthreads();
    }
    const int vb = (G % 8 == 0) ? (int)(blockIdx.x % 8) * (G / 8) + (int)(blockIdx.x / 8) : (int)blockIdx.x;
    for (int base = (vb * 8 + wave) * 16; base < M; base += G * 8 * 16) {
        const int b = base / SEQ;
        f32x4 gs[4], sh[4];
#pragma unroll
        for (int j = 0; j < 4; ++j) { const int col = 4 * lane + 256 * j;
            const f32x4 g = *(const f32x4*)(ap->in[I_GPREMIX] + col), sc = *(const f32x4*)(mod + b * NMOD + D + col);
            gs[j] = g * (sc + 1.0f); sh[j] = *(const f32x4*)(mod + b * NMOD + col); }
#pragma unroll 1
        for (int rb = 0; rb < 16; rb += 4) {
            f32x4 v[4][4];
#pragma unroll
            for (int r = 0; r < 4; ++r) { const f32x4* xr = (const f32x4*)(ap->in[I_X] + (size_t)(base + rb + r) * D) + lane;
#pragma unroll
                for (int j = 0; j < 4; ++j) v[r][j] = __builtin_nontemporal_load(xr + 64 * j); }
#pragma unroll
            for (int r = 0; r < 4; ++r) { const size_t row = base + rb + r; float ss = 0.f;
#pragma unroll
                for (int j = 0; j < 4; ++j) ss += (v[r][j].x * v[r][j].x + v[r][j].y * v[r][j].y) + (v[r][j].z * v[r][j].z + v[r][j].w * v[r][j].w);
                const float rs = rsqrtf(wave_sum(ss) * (1.0f / D) + EPS);
                u32x2* o = (u32x2*)(H + row * D) + lane;
#pragma unroll
                for (int j = 0; j < 4; ++j) { const f32x4 h = v[r][j] * rs * gs[j] + sh[j]; u32x2 w; w.x = pk2(h.x, h.y); w.y = pk2(h.z, h.w); o[64 * j] = w; }
            }
        }
    }
}

constexpr int L_KTAB = 0, L_XS = 8704, L_MT = 78336, L_CARRY = 147968;
constexpr int L_BBAR = L_XS, L_CC = L_XS + 8192, L_LAMP = L_XS + 16384;
__device__ __forceinline__ void ssm_unit(ArgsP ap, LAS unsigned char* lds, int unit, int wid0) {
    int tid_ = wid0 * 64 + lane_id(); asm volatile("" : "+v"(tid_));
    const int tid = tid_, lane = tid & 63, wave = __builtin_amdgcn_readfirstlane(tid >> 6), b = unit & 7, g = unit >> 3;
    const bf16_t* UB = (const bf16_t*)(ap->ws + WS_U);
    bf16_t* Z = (bf16_t*)(ap->ws + WS_Z);
    float* SS = (float*)(ap->ws + WS_SS) + (size_t)unit * NCH * 128;
    const unsigned char* img = ap->ws + WS_TAB + (size_t)g * TAB_BYTES;
    __syncthreads();
    u32x4 t0[2], t1[9], m2r[9];
#pragma unroll
    for (int k = 0; k < 2; ++k) { const int i = tid + 512 * k; if (i < 8704 / 16) t0[k] = ((const u32x4*)(img + TAB_KTAB))[i]; }
#pragma unroll
    for (int k = 0; k < 9; ++k) { const int i = tid + 512 * k; if (i < 67584 / 16) t1[k] = ((const u32x4*)(img + TAB_M3))[i]; }
    const int r32 = lane & 31, hh = lane >> 5, c0 = wave * 32;
    const bf16_t* up = UB + ((size_t)b * SEQ + (size_t)(c0 + r32) * TCH) * DSSM + 16 * g + 8 * hh;
    f32x16 accS[4];
    {
    bf16x8 ufr[16];
#pragma unroll
    for (int j = 0; j < 16; ++j) ufr[j] = *(const bf16x8*)(up + (size_t)j * DSSM);
#pragma unroll
    for (int k = 0; k < 9; ++k) { const int i = tid + 512 * k; if (i < 69632 / 16) m2r[k] = ((const u32x4*)(img + TAB_M2))[i]; }
#pragma unroll
    for (int k = 0; k < 2; ++k) { const int i = tid + 512 * k; if (i < 8704 / 16) ((LAS u32x4*)(lds + L_KTAB))[i] = t0[k]; }
#pragma unroll
    for (int k = 0; k < 9; ++k) { const int i = tid + 512 * k; if (i < 67584 / 16) ((LAS u32x4*)(lds + L_MT))[i] = t1[k]; }
    __syncthreads();
#pragma unroll
    for (int nb = 0; nb < 4; ++nb) {
        __builtin_amdgcn_sched_barrier(0);
#pragma unroll
        for (int e = 0; e < 16; ++e) accS[nb][e] = 0.f;
#pragma unroll
        for (int j = 0; j < 16; ++j) { const bf16x8 bf = *(const LAS bf16x8*)(lds + L_MT + (32 * nb + r32) * 528 + (16 * j + 8 * hh) * 2);
            accS[nb] = __builtin_amdgcn_mfma_f32_32x32x16_bf16(ufr[j], bf, accS[nb], 0, 0, 0); }
    }
    }
    const int p = lane, sb = wave;
    const float ltr = ((const float*)(img + TAB_LAMT))[p * 2], lti = ((const float*)(img + TAB_LAMT))[p * 2 + 1];
    __syncthreads();
    { LAS float* sl = (LAS float*)(lds + L_XS);
#pragma unroll
      for (int nb = 0; nb < 4; ++nb)
#pragma unroll
          for (int e = 0; e < 16; ++e) sl[(c0 + (e & 3) + 8 * (e >> 2) + 4 * hh) * 128 + 32 * nb + r32] = accS[nb][e]; }
    __syncthreads();
    float er[32], ei[32];
    { const LAS float* sp = (const LAS float*)(lds + L_XS) + (32 * sb) * 128 + p;
#pragma unroll
      for (int k = 0; k < 32; ++k) { er[k] = sp[k * 128]; ei[k] = sp[k * 128 + 64]; } }
    __syncthreads();
#pragma unroll
    for (int k = 0; k < 9; ++k) { const int i = tid + 512 * k; if (i < 69632 / 16) ((LAS u32x4*)(lds + L_MT))[i] = m2r[k]; }
    { float xr = 0.f, xi = 0.f;
#pragma unroll
      for (int k = 0; k < 32; ++k) { const float sr = er[k], si = ei[k]; er[k] = xr; ei[k] = xi;
          const float nr = ltr * xr - lti * xi + sr, ni = ltr * xi + lti * xr + si; xr = nr; xi = ni; }
      LAS float* carry = (LAS float*)(lds + L_CARRY);
      carry[(sb * 64 + p) * 2] = xr; carry[(sb * 64 + p) * 2 + 1] = xi; }
    __syncthreads();
    { float l32r = ltr, l32i = lti;
#pragma unroll
      for (int s = 0; s < 5; ++s) { const float nr = l32r * l32r - l32i * l32i, ni = 2.0f * l32r * l32i; l32r = nr; l32i = ni; }
      const LAS float* carry = (const LAS float*)(lds + L_CARRY);
      float xr = 0.f, xi = 0.f;
      for (int s = 0; s < sb; ++s) { const float nr = l32r * xr - l32i * xi + carry[(s * 64 + p) * 2], ni = l32r * xi + l32i * xr + carry[(s * 64 + p) * 2 + 1]; xr = nr; xi = ni; }
      float pr = 1.f, pi = 0.f;
#pragma unroll
      for (int k = 0; k < 32; ++k) { const float vr = er[k] + pr * xr - pi * xi, vi = ei[k] + pr * xi + pi * xr;
          LAS bf16_t* xs = (LAS bf16_t*)(lds + L_XS + (32 * sb + k) * 272);
          const unsigned w = pk2(vr, vi); xs[p] = (bf16_t)(w & 0xffffu); xs[64 + p] = (bf16_t)(w >> 16);
          const float nr = pr * ltr - pi * lti, ni = pr * lti + pi * ltr; pr = nr; pi = ni; } }
    __syncthreads();
    __builtin_amdgcn_sched_barrier(0);
    bf16x8 ufr[16];
    { int l2 = lane_id(); asm volatile("" : "+v"(l2)); const int r2 = l2 & 31, h2 = (l2 >> 5) & 1;
      const bf16_t* up2 = UB + ((size_t)b * SEQ + (size_t)(c0 + r2) * TCH) * DSSM + 16 * g + 8 * h2;
#pragma unroll
      for (int j = 0; j < 16; ++j) ufr[j] = *(const bf16x8*)(up2 + (size_t)j * DSSM); }
#pragma unroll
    for (int half = 0; half < 2; ++half) {
        __builtin_amdgcn_sched_barrier(0);
        f32x16 acc[4];
#pragma unroll
        for (int q = 0; q < 4; ++q)
#pragma unroll
            for (int e = 0; e < 16; ++e) acc[q][e] = 0.f;
#pragma unroll
        for (int j = 0; j < 8 * half + 8; ++j)
#pragma unroll
            for (int q = 0; q < 4; ++q) { const int nb = 4 * half + q;
                if (j <= 2 * nb + 1) { int d1 = 2 * nb - j + (r32 >> 4) + 1; d1 = d1 < 0 ? 0 : d1;
                    const bf16x8 bf = *(const LAS bf16x8*)(lds + L_KTAB + d1 * 512 + (lane & 15) * 32 + 16 * hh);
                    acc[q] = __builtin_amdgcn_mfma_f32_32x32x16_bf16(ufr[j], bf, acc[q], 0, 0, 0); } }
#pragma unroll
        for (int ks = 0; ks < 8; ++ks) { const bf16x8 af = *(const LAS bf16x8*)(lds + L_XS + (c0 + r32) * 272 + (16 * ks + 8 * hh) * 2);
#pragma unroll
            for (int q = 0; q < 4; ++q) { const int nb = 4 * half + q;
                const bf16x8 bf = *(const LAS bf16x8*)(lds + L_MT + (32 * nb + r32) * 272 + (16 * ks + 8 * hh) * 2);
                acc[q] = __builtin_amdgcn_mfma_f32_32x32x16_bf16(af, bf, acc[q], 0, 0, 0); } }
#pragma unroll
        for (int q = 0; q < 4; ++q) { __builtin_amdgcn_sched_barrier(0); const int n = 32 * (4 * half + q) + r32, ii = n >> 4, ch = 16 * g + (n & 15);
#pragma unroll
            for (int e = 0; e < 16; ++e) { const int chunk = c0 + (e & 3) + 8 * (e >> 2) + 4 * hh; const size_t t = (size_t)b * SEQ + (size_t)chunk * TCH + ii;
                Z[t * DSSM + ch] = (bf16_t)(pk2(gelu_tanh(acc[q][e]), 0.f) & 0xffffu); } }
    }
    __syncthreads();
}
__device__ __forceinline__ void fix_conv_rows(ArgsP ap, int wid0) {
    const int lane = lane_id(), G = gridDim.x;
    const float* HTI = (const float*)(ap->ws + WS_HT);
    bf16_t* Y = (bf16_t*)(ap->ws + WS_Y);
    const int ch = 8 * lane;
    for (int it = blockIdx.x * 8 + wid0; it < (M / 256) * 2; it += G * 8) {
        const int pm = it >> 1, r = it & 1;
        if ((pm & 15) == 0) continue;
        const float* hp = HTI + ((size_t)(pm - 1) * 6) * 512 + ch, *hc = HTI + ((size_t)pm * 6) * 512 + ch;
        float yb[8]; float ss = 0.f;
#pragma unroll
        for (int e = 0; e < 8; ++e) {
            const float pm2 = hp[2 * 512 + e], pm1 = hp[3 * 512 + e], p0 = hc[e], p1 = hc[512 + e];
            const float w0 = ap->in[I_CONVW][ch + e], w1 = ap->in[I_CONVW][512 + ch + e], w2 = ap->in[I_CONVW][1024 + ch + e];
            const float cv = r == 0 ? (w0 * pm2 + w1 * pm1 + w2 * p0) : (w0 * pm1 + w1 * p0 + w2 * p1);
            yb[e] = hc[(4 + r) * 512 + e] * cv; ss += yb[e] * yb[e]; }
        ss += __shfl_xor(ss, 1); ss += __shfl_xor(ss, 2); ss += __shfl_xor(ss, 4);
        const float rs = rsqrtf(ss * (1.0f / 64.0f) + EPS);
        u32x4 w;
        w.x = pk2(yb[0] * rs * ap->in[I_GOCONV][ch + 0], yb[1] * rs * ap->in[I_GOCONV][ch + 1]); w.y = pk2(yb[2] * rs * ap->in[I_GOCONV][ch + 2], yb[3] * rs * ap->in[I_GOCONV][ch + 3]);
        w.z = pk2(yb[4] * rs * ap->in[I_GOCONV][ch + 4], yb[5] * rs * ap->in[I_GOCONV][ch + 5]); w.w = pk2(yb[6] * rs * ap->in[I_GOCONV][ch + 6], yb[7] * rs * ap->in[I_GOCONV][ch + 7]);
        *(u32x4*)(Y + ((size_t)pm * 256 + r) * D + 512 + ch) = w;
    }
}
__device__ __forceinline__ void fix_panel(ArgsP ap, int pm, int tid) {
    if ((pm & 15) == 0) return;
    const float* HT = (const float*)(ap->ws + WS_HT);
    const float* fcw = ap->in[I_FCW];
    bf16_t* Gm = (bf16_t*)(ap->ws + WS_G);
    const float* hp = HT + ((size_t)(pm - 1) * 4) * NUP, *hc = HT + ((size_t)pm * 4) * NUP;
    for (int j = tid; j < DFF; j += 512) {
        const int ia = (j >> 7) * 256 + (j & 127), iv = ia + 128;
        const float am2 = hp[2 * NUP + ia], am1 = hp[3 * NUP + ia], a0 = hc[ia], a1 = hc[NUP + ia];
        const float vm2 = hp[2 * NUP + iv], vm1 = hp[3 * NUP + iv], v0 = hc[iv], v1 = hc[NUP + iv];
        const float wa0 = fcw[j], wa1 = fcw[NUP + j], wa2 = fcw[2 * NUP + j], wv0 = fcw[DFF + j], wv1 = fcw[NUP + DFF + j], wv2 = fcw[2 * NUP + DFF + j];
        const float ca0 = wa0 * am2 + wa1 * am1 + wa2 * a0, ca1 = wa0 * am1 + wa1 * a0 + wa2 * a1;
        const float cv0 = wv0 * vm2 + wv1 * vm1 + wv2 * v0, cv1 = wv0 * vm1 + wv1 * v0 + wv2 * v1;
        Gm[((size_t)pm * 256) * DFF + j] = (bf16_t)(pk2(siluf_(ca0) * cv0, 0.f) & 0xffffu);
        Gm[((size_t)pm * 256 + 1) * DFF + j] = (bf16_t)(pk2(siluf_(ca1) * cv1, 0.f) & 0xffffu);
    }
}
__global__ void __launch_bounds__(512, 2) hymba_fwd(Args a_unused) {
    extern __shared__ __attribute__((aligned(16))) unsigned char shm[];
    LAS unsigned char* lds = (LAS unsigned char*)shm;
    cg::grid_group grid = cg::this_grid();
    const int wid0 = __builtin_amdgcn_readfirstlane(threadIdx.x >> 6);
    if (threadIdx.x < 4) ((LAS unsigned*)(lds + L_BARST))[threadIdx.x] = 0u;
    __syncthreads();
    XcdBarrier xbar = xcd_barrier_post((unsigned*)(opaque_args()->ws + WS_BAR), (volatile LAS unsigned*)(lds + L_BARST));
    if (opaque_args()->ph_lo < 0) grid.sync();
    const int G = gridDim.x;
#define SEAM() xcd_barrier(xbar)
    p0_prologue(opaque_args(), lds, wid0);
    p1_rows(opaque_args(), wid0, true);
    SEAM();
    {
        ArgsP ap = opaque_args(); unsigned char* ws = ap->ws;
        pg8::Gemm g{(const bf16_t*)(ws + WS_H), (const bf16_t*)(ws + WS_WIN), M, DIN, D}; pg8::StaticOrder S; S.init(M, DIN, G, blockIdx.x);
        pg8::EpiIn E{(bf16_t*)(ws + WS_Y), (bf16_t*)(ws + WS_U), (float*)(ws + WS_HT), ap->in[I_CONVW], ap->in[I_GOCONV], (LAS float*)(lds + pg8::STAGE_BYTES)};
        pg8::gemm_phase<pg8::EpiIn, true, true>(lds, g, S, E, wid0);
    }
    SEAM();
    fix_conv_rows(opaque_args(), wid0);
    for (int u = blockIdx.x; u < NB * NGRP; u += G) ssm_unit(opaque_args(), lds, u, wid0);
    SEAM();
    {
        ArgsP ap = opaque_args(); unsigned char* ws = ap->ws;
        pg8::Gemm g{(const bf16_t*)(ws + WS_Z), (const bf16_t*)(ws + WS_GLU), M, DSSM, DSSM}; pg8::StaticOrder S; S.init(M, DSSM, G, blockIdx.x);
        pg8::EpiGlu E{(const bf16_t*)(ws + WS_Z), (bf16_t*)(ws + WS_Y), ap->in[I_GLUB], ap->in[I_GOSSM]};
        pg8::gemm_phase<pg8::EpiGlu, true, true>(lds, g, S, E, wid0);
    }
    SEAM();
    {
        ArgsP ap = opaque_args(); unsigned char* ws = ap->ws;
        pg8::Gemm g{(const bf16_t*)(ws + WS_Y), (const bf16_t*)(ws + WS_WOUT), M, D, D}; pg8::StaticOrder S; S.init(M, D, G, blockIdx.x);
        pg8::EpiOutNorm E{ap->in[I_X], ap->out, (bf16_t*)(ws + WS_H), (const float*)(ws + WS_MOD), ap->in[I_GPOSTMIX], ap->in[I_GPREFFN],
                          (float*)(ws + WS_XG) + (size_t)M * 4, (unsigned*)(ws + WS_CNT) + 128 * 64, (LAS float*)(lds + pg8::STAGE_BYTES)};
        pg8::gemm_phase<pg8::EpiOutNorm, true, true>(lds, g, S, E, wid0);
    }
    SEAM();
    {
        ArgsP ap = opaque_args(); unsigned char* ws = ap->ws;
        pg8::Gemm g{(const bf16_t*)(ws + WS_H), (const bf16_t*)(ws + WS_WUP), M, NUP, D}; pg8::StaticOrder S; S.init(M, NUP, G, blockIdx.x);
        pg8::EpiUp E{(bf16_t*)(ws + WS_G), (float*)(ws + WS_HT), ap->in[I_FCW], (LAS float*)(lds + pg8::STAGE_BYTES)};
        pg8::gemm_phase<pg8::EpiUp, true, true>(lds, g, S, E, wid0);
    }
    SEAM();
    {
        ArgsP ap = opaque_args(); unsigned char* ws = ap->ws;
        pg8::Gemm g{(const bf16_t*)(ws + WS_G), (const bf16_t*)(ws + WS_WDN), M, D, DFF}; pg8::StaticOrder S; S.init(M, D, G, blockIdx.x);
        { pg8::Unit fu; const int ftid = wid0 * 64 + lane_id(); for (int i = 0; S.next(i, fu); ++i) fix_panel(ap, fu.pm, ftid);
          asm volatile("s_waitcnt vmcnt(0)" ::: "memory"); __syncthreads(); }
        pg8::EpiDownNorm E{ap->out, (const float*)(ws + WS_MOD), ap->in[I_GPOSTFFN], (float*)(ws + WS_XG), (unsigned*)(ws + WS_CNT), (LAS float*)(lds + pg8::STAGE_BYTES)};
        pg8::gemm_phase<pg8::EpiDownNorm, true, true>(lds, g, S, E, wid0);
    }
#undef SEAM
}

extern "C" void kernel_launch(void* const* d_in, const int* in_sizes, int n_in, void* d_out, int out_size, void* d_ws, size_t ws_size, hipStream_t stream) {
    static int grid = 0;
    if (grid == 0) {
        if (n_in != 26 || in_sizes[0] != M * D || out_size != M * D || ws_size < WS_END) { fprintf(stderr, "kernel_launch: unexpected shapes (n_in %d, ws %zu)\n", n_in, ws_size); grid = -1; return; }
        int dev = 0, cus = 0, per_cu = 0;
        hipGetDevice(&dev); hipDeviceGetAttribute(&cus, hipDeviceAttributeMultiprocessorCount, dev);
        if (hipFuncSetAttribute((const void*)hymba_fwd, hipFuncAttributeMaxDynamicSharedMemorySize, LDS_BYTES) != hipSuccess) { fprintf(stderr, "kernel_launch: hipFuncSetAttribute failed\n"); }
        if (hipOccupancyMaxActiveBlocksPerMultiprocessor(&per_cu, (const void*)hymba_fwd, 512, LDS_BYTES) != hipSuccess || per_cu < 1) per_cu = 1;
        (void)hipGetLastError();
        grid = cus * per_cu;
        if (grid > 256) grid = 256;
    }
    if (grid < 0) return;
    Args a{};
    for (int i = 0; i < 26; ++i) a.in[i] = (const float*)d_in[i];
    a.out = (float*)d_out; a.ws = (unsigned char*)d_ws;
    (void)hipMemsetAsync((char*)d_ws + WS_BAR, 0, CTL_ZERO, stream);
    a.ph_lo = 0; a.ph_hi = 0;
    void* args[] = {&a};
    hipError_t e = hipLaunchCooperativeKernel((const void*)hymba_fwd, dim3(grid), dim3(512), args, LDS_BYTES, stream);
    if (e != hipSuccess) fprintf(stderr, "cooperative launch failed: %s (grid %d)\n", hipGetErrorString(e), grid);

}
```

```cpp
#include <hip/hip_runtime.h>
#include <hip/hip_cooperative_groups.h>
#include <cstdio>
#include <cstdint>
namespace cg = cooperative_groups;


#define LAS __attribute__((address_space(3)))
typedef unsigned short bf16_t;
typedef short bf16x8 __attribute__((ext_vector_type(8)));
typedef float f32x4 __attribute__((ext_vector_type(4)));
typedef float f32x16 __attribute__((ext_vector_type(16)));
typedef unsigned u32x4 __attribute__((ext_vector_type(4)));
typedef unsigned u32x2 __attribute__((ext_vector_type(2)));

constexpr int NB = 8, SEQ = 4096, D = 1024, M = NB * SEQ;
constexpr int DSSM = 512, DIN = 2048, DFF = 2816, NUP = 2 * DFF, NMOD = 6 * D;
constexpr int NGRP = 32, TCH = 16, NCH = SEQ / TCH;
constexpr float EPS = 1e-6f;

constexpr size_t MiB = 1u << 20;
constexpr size_t WS_MOD = 0, WS_WIN = 1 * MiB, WS_GLU = 5 * MiB, WS_WOUT = 6 * MiB, WS_WUP = 8 * MiB, WS_WDN = 19 * MiB,
                 WS_HT = 25 * MiB, WS_SS = 36 * MiB, WS_H = 68 * MiB, WS_PROJ = 132 * MiB, WS_Z = 260 * MiB, WS_Y = 292 * MiB,
                 WS_T = 356 * MiB, WS_G = 132 * MiB, WS_TAB = 420 * MiB, WS_XG = 426 * MiB, WS_END = 428 * MiB;
constexpr int TAB_KTAB = 0, TAB_M3 = 8704, TAB_M2 = 76288, TAB_LAMT = 145920, TAB_BYTES = 146432;

constexpr size_t WS_CNT = 512 * 1024 + 16384;
constexpr size_t CTL_ZERO = 16384 + 3 * 128 * 256;
constexpr size_t WS_BAR = 512 * 1024;
constexpr size_t WS_U = WS_PROJ;
constexpr int L_BARST = 152064, LDS_BYTES = 152080;

__device__ __forceinline__ unsigned pk2(float lo, float hi) { unsigned r; asm("v_cvt_pk_bf16_f32 %0, %1, %2" : "=v"(r) : "v"(lo), "v"(hi)); return r; }
__device__ __forceinline__ float bflo(unsigned w) { return __uint_as_float(w << 16); }
__device__ __forceinline__ float bfhi(unsigned w) { return __uint_as_float(w & 0xffff0000u); }
typedef _Float16 f16x2 __attribute__((ext_vector_type(2)));
__device__ __forceinline__ unsigned pkh(float a, float b) { const f16x2 h = {(_Float16)a, (_Float16)b}; return __builtin_bit_cast(unsigned, h); }
__device__ __forceinline__ float hlo(unsigned w) { return (float)__builtin_bit_cast(f16x2, w)[0]; }
__device__ __forceinline__ float hhi(unsigned w) { return (float)__builtin_bit_cast(f16x2, w)[1]; }
__device__ __forceinline__ float bf1(bf16_t h) { return __uint_as_float(((unsigned)h) << 16); }
__device__ __forceinline__ float wave_sum(float v) {
#pragma unroll
    for (int o = 1; o < 64; o <<= 1) v += __shfl_xor(v, o);
    return v;
}
__device__ __forceinline__ float sigmoidf_(float x) { return __builtin_amdgcn_rcpf(1.0f + __expf(-x)); }
__device__ __forceinline__ float siluf_(float x) { return x * __builtin_amdgcn_rcpf(1.0f + __expf(-x)); }
__device__ __forceinline__ float gelu_tanh(float y) {
    const float y2 = y * y;
    const float t = y * (-2.302208198f + -0.1029432397f * y2);
    return y * __builtin_amdgcn_rcpf(1.0f + __builtin_amdgcn_exp2f(t));
}
__device__ __forceinline__ int lane_id() { return (int)__builtin_amdgcn_mbcnt_hi(~0u, __builtin_amdgcn_mbcnt_lo(~0u, 0u)); }
#define LDS_WAIT() asm volatile("s_waitcnt lgkmcnt(0)" ::: "memory")

namespace pg8 {
constexpr int BM = 256, BK = 64, HALF = 128, HTB = HALF * BK * 2, STAGE_BYTES = 8 * HTB, NXCD = 8, WGM = 8;
__host__ __device__ __forceinline__ int lds_byte(int r, int c) { const int st = (r >> 4) * 2 + (c >> 5), rr = r & 15, cc = c & 31, ob = rr * 64 + cc * 2; return st * 1024 + (ob ^ (((ob >> 9) & 1) << 5)); }
__host__ __device__ __forceinline__ void stage_rc(int b, int& R, int& C) { const int st = b / 1024, sb = b % 1024, swz = sb ^ (((sb >> 9) & 1) << 5); R = (st >> 1) * 16 + swz / 64; C = (st & 1) * 32 + (swz % 64) / 2; }
__host__ __device__ __forceinline__ int perm32(int rho) { const int n = rho >> 4, i = rho & 15; return 8 * (i >> 2) + 4 * n + (i & 3); }
struct Unit { int pm, pn; };
struct Gemm { const bf16_t* A; const bf16_t* Bt; int M, N, K; };
struct StaticOrder {
    int nM, nN, nwg, G, c;
    __device__ void init(int M_, int N_, int G_, int c_) { nM = M_ / BM; nN = N_ / BM; nwg = nM * nN; G = G_; c = c_; }
    __device__ bool next(int i, Unit& u) const {
        const long L = (long)i * G + c; if (L >= nwg) return false;
        int wgid = (int)L; { const int q = nwg / NXCD, r = nwg % NXCD, xcd = wgid % NXCD, off = wgid / NXCD; wgid = (xcd < r ? xcd * (q + 1) : r * (q + 1) + (xcd - r) * q) + off; }
        const int nig = WGM * nN, gid = wgid / nig, fm = gid * WGM, gsz = (nM - fm) < WGM ? (nM - fm) : WGM;
        u.pm = fm + ((wgid % nig) % gsz); u.pn = (wgid % nig) / gsz; return true;
    }
};

template <class Epi, bool ALIGN_EPI, bool SP2>
__device__ __forceinline__ void gemm_phase(LAS unsigned char* lds, const Gemm g, const StaticOrder& S, const Epi& E, int wid0) {
    int tid_ = wid0 * 64 + lane_id(); asm volatile("" : "+v"(tid_));
    const int tid = tid_, wid = __builtin_amdgcn_readfirstlane(tid >> 6), lane = tid & 63, wr = wid >> 2, wc = wid & 3, fr = lane & 15, fq = lane >> 4;
    const int K = g.K, nt = K / BK;
    unsigned voffA[2], voffB[2];
#pragma unroll
    for (int i = 0; i < 2; ++i) { int R, C; stage_rc(tid * 16 + i * 8192, R, C); const int Rb = Epi::PERM ? ((R & ~31) + perm32(R & 31)) : R;
        const int Ra = Epi::PERM_A ? ((R & ~63) + 4 * (R & 15) + ((R >> 4) & 3)) : R;
        voffA[i] = (unsigned)(Ra * K + C) * 2u; voffB[i] = (unsigned)(Rb * K + C) * 2u; }
    const size_t kstep = (size_t)(BK * 2);
    const size_t hstep = (size_t)HALF * K * 2;
    const size_t tstep = 2 * hstep;
    const unsigned ldsw = (unsigned)wid * 1024u;
    const int aoff = lds_byte(wr * 64 + fr, fq * 8), boff = lds_byte(wc * 32 + fr, fq * 8);
#define PG8_SA(b, h) (((b) * 2 + (h)) * HTB)
#define PG8_SB(b, h) ((4 + (b) * 2 + (h)) * HTB)
#define PG8_STAGE(bufoff, gbase, voff) do { _Pragma("unroll") for (int _i = 0; _i < 2; ++_i) \
        __builtin_amdgcn_global_load_lds((const unsigned*)((const char*)(gbase) + (voff)[_i]), (LAS unsigned*)(lds + (bufoff) + ldsw + _i * 8192), 16, 0, 0); } while (0)
#define PG8_LDA(dst, b, h) do { _Pragma("unroll") for (int m = 0; m < 4; ++m) _Pragma("unroll") for (int k = 0; k < 2; ++k) dst[m][k] = *(const LAS bf16x8*)(lds + PG8_SA(b, h) + aoff + m * 2048 + k * 1024); } while (0)
#define PG8_LDB(dst, b, h) do { _Pragma("unroll") for (int n = 0; n < 2; ++n) _Pragma("unroll") for (int k = 0; k < 2; ++k) dst[n][k] = *(const LAS bf16x8*)(lds + PG8_SB(b, h) + boff + n * 2048 + k * 1024); } while (0)
#define PG8_MMA(ai, bj, At, Bt) do { __builtin_amdgcn_s_setprio(1); _Pragma("unroll") for (int m = 0; m < 4; ++m) _Pragma("unroll") for (int n = 0; n < 2; ++n) _Pragma("unroll") for (int k = 0; k < 2; ++k) \
        acc[ai][bj][m][n] = __builtin_amdgcn_mfma_f32_16x16x32_bf16(Bt[n][k], At[m][k], acc[ai][bj][m][n], 0, 0, 0); __builtin_amdgcn_s_setprio(0); } while (0)
#define PG8_WAIT_V(n) asm volatile("s_waitcnt vmcnt(" #n ")" ::: "memory")
#define PG8_WAIT_L(n) asm volatile("s_waitcnt lgkmcnt(" #n ")" ::: "memory")
#define PG8_BAR __builtin_amdgcn_s_barrier()
#define PG8_SCHED __builtin_amdgcn_sched_barrier(0)
    Unit cur, nxt; int ui = 0;
    if (!S.next(0, cur)) return;
    f32x4 acc[2][2][4][2];
#pragma unroll
    for (int a = 0; a < 2; ++a)
#pragma unroll
        for (int b = 0; b < 2; ++b)
#pragma unroll
            for (int m = 0; m < 4; ++m)
#pragma unroll
                for (int n = 0; n < 2; ++n) acc[a][b][m][n] = (f32x4){0.f, 0.f, 0.f, 0.f};
    bf16x8 At[4][2], B0[2][2], B1[2][2];
    const char* cA = (const char*)g.A + (size_t)cur.pm * tstep; const char* cB = (const char*)g.Bt + (size_t)cur.pn * tstep;
    E.begin(cur);
    if constexpr (SP2) {
        PG8_STAGE(PG8_SB(0, 0), cB, voffB); PG8_STAGE(PG8_SB(0, 1), cB + hstep, voffB); PG8_STAGE(PG8_SA(0, 0), cA, voffA); PG8_STAGE(PG8_SA(0, 1), cA + hstep, voffA);
        if (wr == 1) PG8_BAR;
        PG8_WAIT_V(2); PG8_BAR;
        PG8_STAGE(PG8_SB(1, 0), cB + kstep, voffB); PG8_STAGE(PG8_SA(1, 0), cA + kstep, voffA); PG8_STAGE(PG8_SB(1, 1), cB + hstep + kstep, voffB);
        PG8_WAIT_V(6); PG8_BAR;
    } else {
        PG8_STAGE(PG8_SB(0, 0), cB, voffB); PG8_STAGE(PG8_SA(0, 0), cA, voffA); PG8_STAGE(PG8_SB(0, 1), cB + hstep, voffB); PG8_STAGE(PG8_SA(0, 1), cA + hstep, voffA);
        if (wr == 1) PG8_BAR;
        PG8_WAIT_V(4); PG8_BAR;
        PG8_STAGE(PG8_SB(1, 0), cB + kstep, voffB); PG8_STAGE(PG8_SA(1, 0), cA + kstep, voffA); PG8_STAGE(PG8_SB(1, 1), cB + hstep + kstep, voffB);
        PG8_WAIT_V(6); PG8_BAR;
    }
    for (;;) {
        const bool has_next = S.next(ui + 1, nxt);
        const char* nA = has_next ? (const char*)g.A + (size_t)nxt.pm * tstep : cA; const char* nB = has_next ? (const char*)g.Bt + (size_t)nxt.pn * tstep : cB;
        for (int t = 0; t < nt; t += 2) {
            const bool last = (t == nt - 2);
            const char* a1 = cA + (size_t)(t + 1) * kstep;
            const char* a2 = last ? nA : cA + (size_t)(t + 2) * kstep; const char* b2 = last ? nB : cB + (size_t)(t + 2) * kstep;
            const char* a3 = a2 + kstep; const char* b3 = b2 + kstep;
            if constexpr (SP2) {
            PG8_LDB(B0, 0, 0); PG8_LDB(B1, 0, 1); PG8_SCHED; PG8_LDA(At, 0, 0); PG8_STAGE(PG8_SA(1, 1), a1 + hstep, voffA);
            PG8_WAIT_V(8); PG8_WAIT_L(0); PG8_BAR; PG8_MMA(0, 0, At, B0); PG8_MMA(0, 1, At, B1); PG8_BAR; PG8_SCHED;
            PG8_LDA(At, 0, 1); PG8_STAGE(PG8_SB(0, 0), b2, voffB); PG8_STAGE(PG8_SB(0, 1), b2 + hstep, voffB); PG8_STAGE(PG8_SA(0, 0), a2, voffA);
            PG8_WAIT_V(8); PG8_WAIT_L(0); PG8_BAR; PG8_MMA(1, 0, At, B0); PG8_MMA(1, 1, At, B1); PG8_BAR; PG8_SCHED;
            PG8_LDB(B0, 1, 0); PG8_LDB(B1, 1, 1); PG8_SCHED; PG8_LDA(At, 1, 0); PG8_STAGE(PG8_SA(0, 1), a2 + hstep, voffA);
            PG8_WAIT_V(8); PG8_WAIT_L(0); PG8_BAR; PG8_MMA(0, 0, At, B0); PG8_MMA(0, 1, At, B1); PG8_BAR; PG8_SCHED;
            PG8_LDA(At, 1, 1); PG8_STAGE(PG8_SB(1, 0), b3, voffB); PG8_STAGE(PG8_SB(1, 1), b3 + hstep, voffB); PG8_STAGE(PG8_SA(1, 0), a3, voffA);
            PG8_WAIT_V(8); PG8_WAIT_L(0); PG8_BAR; PG8_MMA(1, 0, At, B0); PG8_MMA(1, 1, At, B1); PG8_BAR; PG8_SCHED;
            } else {
            PG8_LDB(B0, 0, 0); PG8_SCHED; PG8_LDA(At, 0, 0); PG8_STAGE(PG8_SA(1, 1), a1 + hstep, voffA);
            PG8_WAIT_L(8); PG8_BAR; PG8_WAIT_L(0); PG8_MMA(0, 0, At, B0); PG8_BAR; PG8_SCHED;
            PG8_LDB(B1, 0, 1); PG8_STAGE(PG8_SB(0, 0), b2, voffB);
            PG8_BAR; PG8_WAIT_L(0); PG8_MMA(0, 1, At, B1); PG8_BAR;
            PG8_LDA(At, 0, 1); PG8_STAGE(PG8_SA(0, 0), a2, voffA);
            PG8_BAR; PG8_WAIT_L(0); PG8_MMA(1, 0, At, B0); PG8_BAR; PG8_SCHED;
            PG8_STAGE(PG8_SB(0, 1), b2 + hstep, voffB);
            PG8_WAIT_V(6); PG8_BAR; PG8_MMA(1, 1, At, B1); PG8_BAR;
            PG8_LDB(B0, 1, 0); PG8_SCHED; PG8_LDA(At, 1, 0); PG8_STAGE(PG8_SA(0, 1), a2 + hstep, voffA);
            PG8_WAIT_L(8); PG8_BAR; PG8_WAIT_L(0); PG8_MMA(0, 0, At, B0); PG8_BAR; PG8_SCHED;
            PG8_LDB(B1, 1, 1); PG8_STAGE(PG8_SB(1, 0), b3, voffB);
            PG8_BAR; PG8_WAIT_L(0); PG8_MMA(0, 1, At, B1); PG8_BAR;
            PG8_LDA(At, 1, 1); PG8_STAGE(PG8_SA(1, 0), a3, voffA);
            PG8_BAR; PG8_WAIT_L(0); PG8_MMA(1, 0, At, B0); PG8_BAR; PG8_SCHED;
            PG8_STAGE(PG8_SB(1, 1), b3 + hstep, voffB);
            PG8_WAIT_V(6); PG8_BAR; PG8_MMA(1, 1, At, B1); PG8_BAR;
            }
        }
        if constexpr (ALIGN_EPI) { if (wr == 0) PG8_BAR; }
        E(acc, cur, wr, wc, fr, fq, has_next ? nxt.pn : -1, ui);
        if (!has_next) break;
#pragma unroll
        for (int a = 0; a < 2; ++a)
#pragma unroll
            for (int b = 0; b < 2; ++b)
#pragma unroll
                for (int m = 0; m < 4; ++m)
#pragma unroll
                    for (int n = 0; n < 2; ++n) acc[a][b][m][n] = (f32x4){0.f, 0.f, 0.f, 0.f};
        cur = nxt; cA = nA; cB = nB; ++ui;
        if constexpr (ALIGN_EPI) { if (wr == 1) PG8_BAR; }
    }
    PG8_WAIT_V(0);
    if constexpr (!ALIGN_EPI) { if (wr == 0) PG8_BAR; }
    PG8_BAR;
#undef PG8_SA
#undef PG8_SB
#undef PG8_STAGE
#undef PG8_LDA
#undef PG8_LDB
#undef PG8_MMA
#undef PG8_WAIT_V
#undef PG8_WAIT_L
#undef PG8_SCHED
}

struct EpiGlu {
    static constexpr bool PERM = true, PERM_A = false;
    const bf16_t* Z; bf16_t* Y; const float* glu_b; const float* gss;
    __device__ __forceinline__ void begin(const Unit&) const {}
    __device__ __forceinline__ void operator()(const f32x4 (&acc)[2][2][4][2], const Unit& u, int wr, int wc, int fr, int fq, int, int) const {
        const int row0 = u.pm * BM + wr * 64 + fr, col0 = u.pn * BM + wc * 32 + 8 * fq;
#pragma unroll
        for (int bj = 0; bj < 2; ++bj) {
            const int cb = col0 + bj * HALF;
            const f32x4 b0 = *(const f32x4*)(glu_b + cb), b1 = *(const f32x4*)(glu_b + cb + 4);
            const f32x4 g0 = *(const f32x4*)(gss + cb), g1 = *(const f32x4*)(gss + cb + 4);
#pragma unroll
            for (int ai = 0; ai < 2; ++ai)
#pragma unroll
                for (int m = 0; m < 4; ++m) {
                    const size_t row = (size_t)(row0 + ai * HALF + m * 16);
                    const u32x4 zr = *(const u32x4*)(Z + row * DSSM + cb);
                    float z[8] = {bflo(zr.x), bfhi(zr.x), bflo(zr.y), bfhi(zr.y), bflo(zr.z), bfhi(zr.z), bflo(zr.w), bfhi(zr.w)};
                    float y[8]; float ss = 0.f;
#pragma unroll
                    for (int e = 0; e < 4; ++e) { y[e] = z[e] * sigmoidf_(acc[ai][bj][m][0][e] + b0[e]); y[4 + e] = z[4 + e] * sigmoidf_(acc[ai][bj][m][1][e] + b1[e]); }
#pragma unroll
                    for (int e = 0; e < 8; ++e) ss += y[e] * y[e];
                    ss += __shfl_xor(ss, 16);
                    const float rs = rsqrtf(ss * (1.0f / 16.0f) + EPS);
                    u32x4 w; w.x = pk2(y[0] * rs * g0[0], y[1] * rs * g0[1]); w.y = pk2(y[2] * rs * g0[2], y[3] * rs * g0[3]);
                    w.z = pk2(y[4] * rs * g1[0], y[5] * rs * g1[1]); w.w = pk2(y[6] * rs * g1[2], y[7] * rs * g1[3]);
                    *(u32x4*)(Y + row * D + cb) = w;
                }
        }
    }
};
__device__ __forceinline__ void fmac_shr1(float& o, float src, float w) { asm volatile("s_nop 1\n\tv_fmac_f32_dpp %0, %1, %2 row_shr:1 row_mask:0xf bank_mask:0xf bound_ctrl:1" : "+v"(o) : "v"(src), "v"(w)); }
__device__ __forceinline__ void fmac_shr1b(float& o, float src, float w) { asm volatile("v_fmac_f32_dpp %0, %1, %2 row_shr:1 row_mask:0xf bank_mask:0xf bound_ctrl:1" : "+v"(o) : "v"(src), "v"(w)); }
__device__ __forceinline__ void fmac_shr2(float& o, float src, float w) { asm volatile("v_fmac_f32_dpp %0, %1, %2 row_shr:2 row_mask:0xf bank_mask:0xf bound_ctrl:1" : "+v"(o) : "v"(src), "v"(w)); }
__device__ __forceinline__ void fmac_ror1(float& o, float src, float w) { asm volatile("v_fmac_f32_dpp %0, %1, %2 row_ror:1 row_mask:0xf bank_mask:0xf" : "+v"(o) : "v"(src), "v"(w)); }
__device__ __forceinline__ void fmac_ror2(float& o, float src, float w) { asm volatile("v_fmac_f32_dpp %0, %1, %2 row_ror:2 row_mask:0xf bank_mask:0xf" : "+v"(o) : "v"(src), "v"(w)); }
struct EpiUp {
    static constexpr bool PERM = true, PERM_A = false;
    bf16_t* G; float* HT; const float* fcw; LAS float* xb;
    __device__ __forceinline__ void begin(const Unit& u) const {
        const int tq = __builtin_amdgcn_readfirstlane(threadIdx.x >> 6) * 64 + lane_id();
        const int c0w = tq & 255, oc0 = (c0w < 128 ? 0 : DFF - 128) + u.pn * HALF + c0w;
        LAS float* wt = xb + 2048;
        wt[tq] = fcw[(size_t)(tq >> 8) * NUP + oc0]; if (tq < 256) wt[512 + tq] = fcw[2 * (size_t)NUP + oc0];
    }
    __device__ __forceinline__ void operator()(f32x4 (&acc)[2][2][4][2], const Unit& u, int wr, int wc, int fr_, int fq_, int next_pn, int ui) const {
        int lq = lane_id(); asm volatile("" : "+v"(lq));
        const int fr = lq & 15, fq = (lq >> 4) & 3;
        const int ct0 = wc * 32 + 8 * fq;
        LAS float* wt = xb + 2048 + (ui & 1) * 768;
        LAS float* wtn = xb + 2048 + ((ui + 1) & 1) * 768;
        const int tq = (wr * 4 + wc) * 64 + lq;
        const int c0w = tq & 255, oc0 = (c0w < 128 ? 0 : DFF - 128) + (next_pn < 0 ? 0 : next_pn) * HALF + c0w;
        const float wq0 = fcw[(size_t)(tq >> 8) * NUP + oc0];
        const float wq1 = (tq < 256) ? fcw[2 * (size_t)NUP + oc0] : 0.f;
        if (fr >= 14) {
#pragma unroll
            for (int ai = 0; ai < 2; ++ai)
#pragma unroll
                for (int bj = 0; bj < 2; ++bj)
#pragma unroll
                    for (int n = 0; n < 2; ++n) *(LAS f32x4*)(xb + ((ai * 2 + wr) * 2 + (fr - 14)) * 256 + bj * HALF + ct0 + 4 * n) = acc[ai][bj][3][n];
        }
        if (wr == 0 && fr < 2) {
            float* hp = HT + ((size_t)u.pm * 4 + fr) * NUP + (size_t)u.pn * 256 + ct0;
#pragma unroll
            for (int bj = 0; bj < 2; ++bj)
#pragma unroll
                for (int n = 0; n < 2; ++n) *(f32x4*)(hp + bj * HALF + 4 * n) = acc[0][bj][0][n];
        }
        if (wr == 1 && fr >= 14) {
            float* hp = HT + ((size_t)u.pm * 4 + 2 + (fr - 14)) * NUP + (size_t)u.pn * 256 + ct0;
#pragma unroll
            for (int bj = 0; bj < 2; ++bj)
#pragma unroll
                for (int n = 0; n < 2; ++n) *(f32x4*)(hp + bj * HALF + 4 * n) = acc[1][bj][3][n];
        }
        LDS_WAIT(); __builtin_amdgcn_s_barrier(); asm volatile("" ::: "memory");
#pragma unroll
        for (int bj = 0; bj < 2; ++bj)
#pragma unroll
            for (int n = 0; n < 2; ++n) {
                __builtin_amdgcn_sched_barrier(0);
                const int tc = bj * HALF + ct0 + 4 * n;
                const f32x4 w0 = *(const LAS f32x4*)(wt + tc), w1 = *(const LAS f32x4*)(wt + 256 + tc), w2 = *(const LAS f32x4*)(wt + 512 + tc);
                const int b0 = wr, b1 = 2 + wr;
                const f32x4 q14 = *(const LAS f32x4*)(xb + ((b0 > 0 ? b0 - 1 : 0) * 2 + 0) * 256 + tc), q15 = *(const LAS f32x4*)(xb + ((b0 > 0 ? b0 - 1 : 0) * 2 + 1) * 256 + tc);
                const f32x4 s14 = *(const LAS f32x4*)(xb + ((b1 - 1) * 2 + 0) * 256 + tc), s15 = *(const LAS f32x4*)(xb + ((b1 - 1) * 2 + 1) * 256 + tc);
#pragma unroll
                for (int e = 0; e < 4; ++e) {
                    const float w1m = (fr == 0) ? w1[e] : 0.f, w0m = (fr < 2) ? w0[e] : 0.f;
#pragma unroll
                    for (int ai = 0; ai < 2; ++ai) {
                        const float r14 = ai ? s14[e] : q14[e], r15 = ai ? s15[e] : q15[e];
                        float h = w1m * r15 + w0m * ((fr == 0) ? r14 : r15);
                        if (ai == 0 && b0 == 0) h = 0.f;
#pragma unroll
                        for (int m = 3; m >= 0; --m) {
                            const float cur = acc[ai][bj][m][n][e];
                            float v = w2[e] * cur;
                            fmac_shr1(v, cur, w1[e]); fmac_shr2(v, cur, w0[e]);
                            if (m > 0) { const float pb = acc[ai][bj][m - 1][n][e]; fmac_ror1(v, pb, w1m); fmac_ror2(v, pb, w0m); }
                            else v += h;
                            acc[ai][bj][m][n][e] = v;
                        }
                    }
                }
            }
        const int row0 = u.pm * BM + wr * 64 + fr, col0 = u.pn * HALF + ct0;
#pragma unroll
        for (int ai = 0; ai < 2; ++ai)
#pragma unroll
            for (int m = 0; m < 4; ++m) {
                __builtin_amdgcn_sched_barrier(0);
                const f32x4 a0 = acc[ai][0][m][0], a1 = acc[ai][0][m][1], v0 = acc[ai][1][m][0], v1 = acc[ai][1][m][1];
                u32x4 w; w.x = pk2(siluf_(a0[0]) * v0[0], siluf_(a0[1]) * v0[1]); w.y = pk2(siluf_(a0[2]) * v0[2], siluf_(a0[3]) * v0[3]);
                w.z = pk2(siluf_(a1[0]) * v1[0], siluf_(a1[1]) * v1[1]); w.w = pk2(siluf_(a1[2]) * v1[2], siluf_(a1[3]) * v1[3]);
                __builtin_nontemporal_store(w, (u32x4*)(G + (size_t)(row0 + ai * HALF + m * 16) * DFF + col0));
            }
        wtn[tq] = wq0; if (tq < 256) wtn[512 + tq] = wq1;
    }
};

__device__ __forceinline__ void panel_rms(const f32x4 (&v)[2][2][4][2], const Unit& u, int wr, int wc, int fr, int fq, int tid, float* xg, unsigned* cnt, LAS float* tab) {
#pragma unroll
    for (int ai = 0; ai < 2; ++ai)
#pragma unroll
        for (int m = 0; m < 4; ++m) { float ss = 0.f;
#pragma unroll
            for (int bj = 0; bj < 2; ++bj)
#pragma unroll
                for (int n = 0; n < 2; ++n) { const f32x4 x = v[ai][bj][m][n]; ss += (x[0] * x[0] + x[1] * x[1]) + (x[2] * x[2] + x[3] * x[3]); }
            ss += __shfl_xor(ss, 16); ss += __shfl_xor(ss, 32);
            if (fq == 0) tab[(ai * HALF + wr * 64 + m * 16 + fr) * 4 + wc] = ss; }
    LDS_WAIT(); __builtin_amdgcn_s_barrier(); asm volatile("" ::: "memory");
    if (tid < 256) { const f32x4 p = *(const LAS f32x4*)(tab + tid * 4);
        __hip_atomic_store(xg + ((size_t)u.pm * 256 + tid) * 4 + u.pn, (p[0] + p[1]) + (p[2] + p[3]), __ATOMIC_RELAXED, __HIP_MEMORY_SCOPE_AGENT);
        asm volatile("s_waitcnt vmcnt(0)" ::: "memory");
        if ((tid & 63) == 0) __hip_atomic_fetch_add(cnt + 64 * u.pm, 1u, __ATOMIC_RELAXED, __HIP_MEMORY_SCOPE_AGENT); }
    if (tid < 64) { unsigned sp = 0;
        while ((unsigned)__builtin_amdgcn_readfirstlane(__hip_atomic_load(cnt + 64 * u.pm, __ATOMIC_RELAXED, __HIP_MEMORY_SCOPE_AGENT)) < 16u) { __builtin_amdgcn_s_sleep(1); if (++sp > (1u << 20)) break; }
        asm volatile("" ::: "memory"); }
    asm volatile("" ::: "memory"); __builtin_amdgcn_s_barrier(); asm volatile("" ::: "memory");
    if (tid < 256) { const float* q = xg + ((size_t)u.pm * 256 + tid) * 4; float s = 0.f;
#pragma unroll
        for (int k = 0; k < 4; ++k) s += __hip_atomic_load(q + k, __ATOMIC_RELAXED, __HIP_MEMORY_SCOPE_AGENT);
        tab[1024 + tid] = rsqrtf(s * (1.0f / D) + EPS); }
    LDS_WAIT(); __builtin_amdgcn_s_barrier(); asm volatile("" ::: "memory");
}
struct EpiDownNorm {
    static constexpr bool PERM = true, PERM_A = false;
    float* out; const unsigned short* X1; const float* mod; const float* gpost; float* xg; unsigned* cnt; LAS float* tab;
    __device__ __forceinline__ void begin(const Unit&) const {}
    __device__ __forceinline__ void operator()(const f32x4 (&acc)[2][2][4][2], const Unit& u, int wr, int wc, int fr_, int fq_, int, int) const {
        int lq = lane_id(); asm volatile("" : "+v"(lq));
        const int fr = lq & 15, fq = (lq >> 4) & 3, tid = (wr * 4 + wc) * 64 + lq;
        panel_rms(acc, u, wr, wc, fr, fq, tid, xg, cnt, tab);
        const int row0 = u.pm * BM + wr * 64 + fr, col0 = u.pn * BM + wc * 32 + 8 * fq, b = u.pm >> 4;
#pragma unroll
        for (int bj = 0; bj < 2; ++bj) {
            __builtin_amdgcn_sched_barrier(0);
            const int cb = col0 + bj * HALF;
            const f32x4 c0 = *(const f32x4*)(mod + b * NMOD + 5 * D + cb) * *(const f32x4*)(gpost + cb), c1 = *(const f32x4*)(mod + b * NMOD + 5 * D + cb + 4) * *(const f32x4*)(gpost + cb + 4);
#pragma unroll
            for (int ai = 0; ai < 2; ++ai)
#pragma unroll
                for (int m = 0; m < 4; ++m) { const int rl = ai * HALF + wr * 64 + m * 16 + fr; const float rs = tab[1024 + rl];
                    float* op = out + (size_t)(row0 + ai * HALF + m * 16) * D + cb;
                    const u32x4 xw = *(const u32x4*)(X1 + (size_t)(row0 + ai * HALF + m * 16) * D + cb);
                    const f32x4 x0 = (f32x4){hlo(xw.x), hhi(xw.x), hlo(xw.y), hhi(xw.y)}, x1 = (f32x4){hlo(xw.z), hhi(xw.z), hlo(xw.w), hhi(xw.w)};
                    __builtin_nontemporal_store(x0 + c0 * (acc[ai][bj][m][0] * rs), (f32x4*)op); __builtin_nontemporal_store(x1 + c1 * (acc[ai][bj][m][1] * rs), (f32x4*)(op + 4)); }
        }
    }
};

struct EpiOutNorm {
    static constexpr bool PERM = true, PERM_A = false;
    const float* x; unsigned short* X1; bf16_t* H; const float* mod; const float* gpostmix; const float* gpreffn; float* xg; unsigned* cnt; LAS float* tab;
    __device__ __forceinline__ void begin(const Unit&) const {}
    __device__ __forceinline__ void operator()(f32x4 (&acc)[2][2][4][2], const Unit& u, int wr, int wc, int fr_, int fq_, int, int) const {
        int lq = lane_id(); asm volatile("" : "+v"(lq));
        const int fr = lq & 15, fq = (lq >> 4) & 3, tid = (wr * 4 + wc) * 64 + lq;
        panel_rms(acc, u, wr, wc, fr, fq, tid, xg, cnt, tab);
        const int row0 = u.pm * BM + wr * 64 + fr, col0 = u.pn * BM + wc * 32 + 8 * fq, b = u.pm >> 4;
        const float* mb = mod + b * NMOD;
#pragma unroll
        for (int bj = 0; bj < 2; ++bj) {
            __builtin_amdgcn_sched_barrier(0);
            const int cb = col0 + bj * HALF;
            const f32x4 c0 = *(const f32x4*)(mb + 2 * D + cb) * *(const f32x4*)(gpostmix + cb), c1 = *(const f32x4*)(mb + 2 * D + cb + 4) * *(const f32x4*)(gpostmix + cb + 4);
#pragma unroll
            for (int ai = 0; ai < 2; ++ai)
#pragma unroll
                for (int m = 0; m < 4; ++m) { const int rl = ai * HALF + wr * 64 + m * 16 + fr; const float rs = tab[1024 + rl];
                    const size_t off = (size_t)(row0 + ai * HALF + m * 16) * D + cb;
                    const f32x4 x0 = *(const f32x4*)(x + off), x1 = *(const f32x4*)(x + off + 4);
                    const f32x4 y0 = x0 + c0 * (acc[ai][bj][m][0] * rs), y1 = x1 + c1 * (acc[ai][bj][m][1] * rs);
                    { u32x4 xw; xw.x = pkh(y0[0], y0[1]); xw.y = pkh(y0[2], y0[3]); xw.z = pkh(y1[0], y1[1]); xw.w = pkh(y1[2], y1[3]); *(u32x4*)(X1 + off) = xw; }
                    acc[ai][bj][m][0] = y0; acc[ai][bj][m][1] = y1; }
        }
        __builtin_amdgcn_sched_barrier(0);
        panel_rms(acc, u, wr, wc, fr, fq, tid, xg + (size_t)M * 4, cnt + 128 * 64, tab);
#pragma unroll
        for (int bj = 0; bj < 2; ++bj) {
            __builtin_amdgcn_sched_barrier(0);
            const int cb = col0 + bj * HALF;
            const f32x4 g0 = *(const f32x4*)(gpreffn + cb) * (*(const f32x4*)(mb + 4 * D + cb) + 1.0f), g1 = *(const f32x4*)(gpreffn + cb + 4) * (*(const f32x4*)(mb + 4 * D + cb + 4) + 1.0f);
            const f32x4 s0 = *(const f32x4*)(mb + 3 * D + cb), s1 = *(const f32x4*)(mb + 3 * D + cb + 4);
#pragma unroll
            for (int ai = 0; ai < 2; ++ai)
#pragma unroll
                for (int m = 0; m < 4; ++m) { const int rl = ai * HALF + wr * 64 + m * 16 + fr; const float rs = tab[1024 + rl];
                    const f32x4 h0 = acc[ai][bj][m][0] * rs * g0 + s0, h1 = acc[ai][bj][m][1] * rs * g1 + s1;
                    u32x4 w; w.x = pk2(h0[0], h0[1]); w.y = pk2(h0[2], h0[3]); w.z = pk2(h1[0], h1[1]); w.w = pk2(h1[2], h1[3]);
                    *(u32x4*)(H + (size_t)(row0 + ai * HALF + m * 16) * D + cb) = w; }
        }
    }
};

struct EpiIn {
    static constexpr bool PERM = true, PERM_A = true;
    bf16_t* Y; bf16_t* U; float* HTI; const float* convw; const float* gconv; LAS float* xb;
    __device__ __forceinline__ void begin(const Unit&) const {
        const int t = __builtin_amdgcn_readfirstlane(threadIdx.x >> 6) * 64 + lane_id();
        LAS float* wl = xb + 512 + 1024;
#pragma unroll
        for (int k = 0; k < 3; ++k) wl[k * 512 + t] = convw[k * 512 + t];
        wl[3 * 512 + t] = gconv[t];
    }
    __device__ __forceinline__ void operator()(f32x4 (&acc)[2][2][4][2], const Unit& u, int wr, int wc, int fr_, int fq_, int, int) const {
        int lq = lane_id(); asm volatile("" : "+v"(lq));
        const int fr = lq & 15, fq = (lq >> 4) & 3;
        const int ch4 = 16 * wc + 4 * fq, gch = 64 * u.pn + ch4;
        LAS float* tab = xb + 512;
        const LAS float* wl = xb + 512 + 1024;
#pragma unroll
        for (int ai = 0; ai < 2; ++ai)
#pragma unroll
            for (int m = 0; m < 4; ++m) acc[ai][0][m][0] = acc[ai][0][m][0] * acc[ai][0][m][1];
        if (fr == 15) {
#pragma unroll
            for (int ai = 0; ai < 2; ++ai) { *(LAS f32x4*)(xb + ((ai * 2 + wr) * 2 + 0) * 64 + ch4) = acc[ai][0][2][0]; *(LAS f32x4*)(xb + ((ai * 2 + wr) * 2 + 1) * 64 + ch4) = acc[ai][0][3][0]; }
        }
        if (wr == 0 && fr == 0) { float* hp = HTI + ((size_t)u.pm * 6) * 512 + gch;
            *(f32x4*)(hp) = acc[0][0][0][0]; *(f32x4*)(hp + 512) = acc[0][0][1][0]; *(f32x4*)(hp + 4 * 512) = acc[0][1][0][0]; *(f32x4*)(hp + 5 * 512) = acc[0][1][1][0]; }
        if (wr == 1 && fr == 15) { float* hp = HTI + ((size_t)u.pm * 6 + 2) * 512 + gch; *(f32x4*)(hp) = acc[1][0][2][0]; *(f32x4*)(hp + 512) = acc[1][0][3][0]; }
        LDS_WAIT(); __builtin_amdgcn_s_barrier(); asm volatile("" ::: "memory");
        const f32x4 w0 = *(const LAS f32x4*)(wl + gch), w1 = *(const LAS f32x4*)(wl + 512 + gch), w2 = *(const LAS f32x4*)(wl + 1024 + gch);
#pragma unroll
        for (int ai = 0; ai < 2; ++ai) {
            __builtin_amdgcn_sched_barrier(0);
            const int blk = ai * 2 + wr, pblk = blk > 0 ? blk - 1 : 0;
            const bool halo = (fr == 0) && (blk > 0);
            const f32x4 h2 = *(const LAS f32x4*)(xb + (pblk * 2 + 0) * 64 + ch4), h3 = *(const LAS f32x4*)(xb + (pblk * 2 + 1) * 64 + ch4);
#pragma unroll
            for (int e = 0; e < 4; ++e) {
                const float w1m = halo ? w1[e] : 0.f, w0m = halo ? w0[e] : 0.f;
                const float c0 = acc[ai][0][0][0][e], c1 = acc[ai][0][1][0][e], c2 = acc[ai][0][2][0][e], c3 = acc[ai][0][3][0][e];
                float o1 = w2[e] * c1 + w1[e] * c0 + w0m * h3[e];
                float o0 = w2[e] * c0 + w1m * h3[e] + w0m * h2[e];
                fmac_shr1(o1, c3, w0[e]); fmac_shr1b(o0, c3, w1[e]); fmac_shr1b(o0, c2, w0[e]);
                acc[ai][0][3][0][e] = acc[ai][1][3][0][e] * (w2[e] * c3 + w1[e] * c2 + w0[e] * c1);
                acc[ai][0][2][0][e] = acc[ai][1][2][0][e] * (w2[e] * c2 + w1[e] * c1 + w0[e] * c0);
                acc[ai][0][1][0][e] = acc[ai][1][1][0][e] * o1; acc[ai][0][0][0][e] = acc[ai][1][0][0][e] * o0;
            }
        }
#pragma unroll
        for (int ai = 0; ai < 2; ++ai)
#pragma unroll
            for (int m = 0; m < 4; ++m) { const f32x4 y = acc[ai][0][m][0]; float ss = (y[0] * y[0] + y[1] * y[1]) + (y[2] * y[2] + y[3] * y[3]);
                ss += __shfl_xor(ss, 16); ss += __shfl_xor(ss, 32);
                if (fq == 0) tab[(ai * HALF + wr * 64 + 4 * fr + m) * 4 + wc] = ss; }
        LDS_WAIT(); __builtin_amdgcn_s_barrier(); asm volatile("" ::: "memory");
        const f32x4 gg = *(const LAS f32x4*)(wl + 1536 + gch);
        const int row0 = u.pm * BM + wr * 64 + 4 * fr;
#pragma unroll
        for (int ai = 0; ai < 2; ++ai)
#pragma unroll
            for (int m = 0; m < 4; ++m) { const int rl = ai * HALF + wr * 64 + 4 * fr + m; const f32x4 pp = *(const LAS f32x4*)(tab + rl * 4);
                const float rs = rsqrtf(((pp[0] + pp[1]) + (pp[2] + pp[3])) * (1.0f / 64.0f) + EPS);
                const f32x4 y = acc[ai][0][m][0] * rs * gg, uu = acc[ai][1][m][1];
                const size_t row = (size_t)(row0 + ai * HALF + m);
                u32x2 wy; wy.x = pk2(y[0], y[1]); wy.y = pk2(y[2], y[3]); *(u32x2*)(Y + row * D + 512 + gch) = wy;
                u32x2 wu; wu.x = pk2(uu[0], uu[1]); wu.y = pk2(uu[2], uu[3]); *(u32x2*)(U + row * DSSM + gch) = wu; }
    }
};
#undef PG8_BAR
}

#define XB_TMO      128
#define XB_XCNT(j)  (256  + 64 * (j))
#define XB_XSUB(j)  (1280 + 64 * (j))
#define XB_XGEN(j)  (2304 + 64 * (j))
#define XB_TOP      3328
#define XB_TOPGEN   3392
#define XCD_BAR_WORDS 3456
#define XB_SPIN_CAP (1u << 18)

__device__ __forceinline__ unsigned xb_ld(unsigned* p)              { return __hip_atomic_load(p, __ATOMIC_RELAXED, __HIP_MEMORY_SCOPE_AGENT); }
__device__ __forceinline__ unsigned xb_add(unsigned* p, unsigned v) { return __hip_atomic_fetch_add(p, v, __ATOMIC_RELAXED, __HIP_MEMORY_SCOPE_AGENT); }
__device__ __forceinline__ unsigned xb_xcc_id() { return (unsigned)__builtin_amdgcn_s_getreg((3 << 11) | 20) & 0xFu; }
#define XB_SPIN(cond, bar) do { unsigned _sp = 0; while (cond) { __builtin_amdgcn_s_sleep(1); \
    if ((++_sp & 255u) == 0u) { if (xb_ld(&(bar)[XB_TMO])) break; if (_sp > XB_SPIN_CAP) { atomicAdd(&(bar)[XB_TMO], 1u); break; } } } } while (0)

struct XcdBarrier {
    unsigned* bar; unsigned x;
    volatile LAS unsigned* st;
};

__device__ __forceinline__ XcdBarrier xcd_barrier_post(unsigned* bar, volatile LAS unsigned* st) {
    XcdBarrier b; b.bar = bar; b.x = xb_xcc_id(); b.st = st;
    if (threadIdx.x == 0) (void)xb_add(&bar[XB_XCNT(b.x)], 1u);
    return b;
}
__device__ __forceinline__ void xcd_barrier_complete(unsigned* bar, unsigned x, unsigned& nloc, unsigned& nx) {
    const unsigned G = gridDim.x * gridDim.y * gridDim.z;
    unsigned sum, cnt, mine, sp = 0u;
    for (;;) {
        sum = 0u; cnt = 0u; mine = 0u;
#pragma unroll
        for (unsigned j = 0; j < 16; ++j) { const unsigned c = xb_ld(&bar[XB_XCNT(j)]); sum += c; cnt += (c > 0u) ? 1u : 0u; mine = (j == x) ? c : mine; }
        if (sum == G) break;
        __builtin_amdgcn_s_sleep(1);
        if ((++sp & 255u) == 0u) { if (xb_ld(&bar[XB_TMO])) break; if (sp > XB_SPIN_CAP) { atomicAdd(&bar[XB_TMO], 1u); break; } }
    }
    nloc = mine > 0u ? mine : 1u; nx = cnt > 0u ? cnt : 1u;
}

__device__ __forceinline__ void xcd_barrier(const XcdBarrier& b) {
    asm volatile("s_waitcnt vmcnt(0)" ::: "memory");
    __syncthreads();
    if (threadIdx.x == 0) {
        unsigned* bar = b.bar;
        __builtin_amdgcn_s_waitcnt(0);
        unsigned nloc = b.st[0], nx = b.st[1];
        if (nloc == 0u) { xcd_barrier_complete(bar, b.x, nloc, nx); b.st[0] = nloc; b.st[1] = nx; }
        const unsigned old = xb_add(&bar[XB_XSUB(b.x)], 1u);
        const unsigned gen = old / nloc;
        if (old + 1u == (gen + 1u) * nloc) {
            __builtin_amdgcn_fence(__ATOMIC_RELEASE, "agent");
            asm volatile("s_waitcnt vmcnt(0)" ::: "memory");
            const unsigned og = xb_add(&bar[XB_TOP], 1u);
            const unsigned tg = og / nx;
            if (og + 1u == (tg + 1u) * nx) xb_add(&bar[XB_TOPGEN], 1u);
            else XB_SPIN(xb_ld(&bar[XB_TOPGEN]) == tg, bar);
            __builtin_amdgcn_fence(__ATOMIC_ACQUIRE, "agent");
            xb_add(&bar[XB_XGEN(b.x)], 1u);
            asm volatile("s_waitcnt vmcnt(0)" ::: "memory");
        } else {
            XB_SPIN(xb_ld(&bar[XB_XGEN(b.x)]) == gen, bar);
            __builtin_amdgcn_fence(__ATOMIC_ACQUIRE, "agent");
            asm volatile("s_waitcnt vmcnt(0)" ::: "memory");
        }
    }
    __syncthreads();
}


struct Args { const float* in[26]; float* out; unsigned char* ws; int ph_lo, ph_hi; };
typedef const __attribute__((address_space(4))) Args* ArgsP;
__device__ __forceinline__ ArgsP opaque_args() { ArgsP p = (ArgsP)__builtin_amdgcn_kernarg_segment_ptr(); asm volatile("" : "+s"(p)); return p; }
enum { I_X = 0, I_C, I_WADA, I_BADA, I_GPREMIX, I_GPOSTMIX, I_WIN, I_LRE, I_LIM, I_LSTEP, I_BRE, I_BIM, I_CRE, I_CIM, I_DSKIP, I_GLUW, I_GLUB,
       I_GOSSM, I_CONVW, I_GOCONV, I_WOUT, I_GPREFFN, I_GPOSTFFN, I_WUP, I_FCW, I_WDN };

__device__ __forceinline__ int win_row(int col) {
    const int sec = col >> 9, within = col & 511, pn = within >> 6, ch = within & 63, wc = ch >> 4, fq = (ch >> 2) & 3, e = ch & 3;
    const int bj = (sec == 0 || sec == 1) ? 1 : 0, n = (sec == 0 || sec == 3) ? 1 : 0;
    return pn * 256 + bj * 128 + wc * 32 + fq * 8 + n * 4 + e;
}
template <bool WIN = false>
__device__ __forceinline__ void transpose_item(const float* W, int K, int N, bf16_t* WT, int drow, int k0, int n0, LAS float* scr, int lane) {
#pragma unroll
    for (int i = 0; i < 32; ++i) { const int kk = 2 * i + (lane >> 5); scr[kk * 33 + (lane & 31)] = __builtin_nontemporal_load(W + (size_t)(k0 + kk) * N + n0 + (lane & 31)); }
    LDS_WAIT();
    const int c = lane & 7;
#pragma unroll
    for (int j = 0; j < 4; ++j) { const int n = (lane >> 3) + 8 * j; const LAS float* s = scr + (8 * c) * 33 + n;
        u32x4 o; o.x = pk2(s[0 * 33], s[1 * 33]); o.y = pk2(s[2 * 33], s[3 * 33]); o.z = pk2(s[4 * 33], s[5 * 33]); o.w = pk2(s[6 * 33], s[7 * 33]);
        *(u32x4*)(WT + (size_t)(WIN ? win_row(n0 + n) : drow + n) * K + k0 + 8 * c) = o; }
    LDS_WAIT();
}

__device__ __forceinline__ void build_tables(ArgsP ap, LAS unsigned char* lds, int g, int tid) {
    LAS float* lamp = (LAS float*)(lds);
    LAS float* bbar = (LAS float*)(lds + 8704);
    LAS float* cc = (LAS float*)(lds + 8704 + 8192);
    unsigned char* img = ap->ws + WS_TAB + (size_t)g * TAB_BYTES;
    __syncthreads();
    const float step = expf(ap->in[I_LSTEP][g]);
    for (int i = tid; i < 17 * 64; i += 512) { const int d = i >> 6, p = i & 63;
        const float lr = fminf(ap->in[I_LRE][g * 64 + p], -1e-4f), li = ap->in[I_LIM][g * 64 + p];
        const float er = expf(lr * step * (float)d); float sn, cs; sincosf(li * step * (float)d, &sn, &cs);
        lamp[i * 2] = er * cs; lamp[i * 2 + 1] = er * sn;
        if (d == 16) { ((float*)(img + TAB_LAMT))[p * 2] = er * cs; ((float*)(img + TAB_LAMT))[p * 2 + 1] = er * sn; } }
    for (int i = tid; i < 64 * 16; i += 512) { const int p = i >> 4;
        const float lr = fminf(ap->in[I_LRE][g * 64 + p], -1e-4f), li = ap->in[I_LIM][g * 64 + p];
        const float ar = lr * step, ai = li * step;
        float sn, cs; sincosf(ai, &sn, &cs); const float em1 = expm1f(ar), ea = em1 + 1.0f; const float sh = sinf(0.5f * ai);
        const float nr = em1 * cs - 2.0f * sh * sh, ni = ea * sn;
        const float den = 1.0f / (lr * lr + li * li);
        const float qr = (nr * lr + ni * li) * den, qi = (ni * lr - nr * li) * den;
        const float br = ap->in[I_BRE][(size_t)g * 1024 + i], bi = ap->in[I_BIM][(size_t)g * 1024 + i];
        bbar[i * 2] = qr * br - qi * bi; bbar[i * 2 + 1] = qr * bi + qi * br; }
    for (int i = tid; i < 16 * 64; i += 512) { const int h = i >> 6, p = i & 63; cc[(p * 16 + h) * 2] = ap->in[I_CRE][(size_t)g * 1024 + i]; cc[(p * 16 + h) * 2 + 1] = ap->in[I_CIM][(size_t)g * 1024 + i]; }
    for (int i = tid; i < 128; i += 512) ((unsigned*)(img + TAB_KTAB))[i] = 0u;
    __syncthreads();
    if (tid < 256) { const int d = tid >> 4, h = tid & 15; float acc[16];
#pragma unroll
        for (int e = 0; e < 16; ++e) acc[e] = 0.f;
        for (int p = 0; p < 64; ++p) { const float lr = lamp[(d * 64 + p) * 2], li = lamp[(d * 64 + p) * 2 + 1], cr = cc[(p * 16 + h) * 2], ci = cc[(p * 16 + h) * 2 + 1];
            const float tr = cr * lr - ci * li, ti = cr * li + ci * lr;
#pragma unroll
            for (int q = 0; q < 8; ++q) { const f32x4 bb = *(const LAS f32x4*)(bbar + p * 32 + 4 * q); acc[2 * q] += tr * bb[0] - ti * bb[1]; acc[2 * q + 1] += tr * bb[2] - ti * bb[3]; } }
        if (d == 0) {
#pragma unroll
            for (int e = 0; e < 16; ++e) if (e == h) acc[e] += ap->in[I_DSKIP][16 * g + h]; }
        u32x4 o0, o1; o0.x = pk2(acc[0], acc[1]); o0.y = pk2(acc[2], acc[3]); o0.z = pk2(acc[4], acc[5]); o0.w = pk2(acc[6], acc[7]);
        o1.x = pk2(acc[8], acc[9]); o1.y = pk2(acc[10], acc[11]); o1.z = pk2(acc[12], acc[13]); o1.w = pk2(acc[14], acc[15]);
        u32x4* dst = (u32x4*)(img + TAB_KTAB + 512 + tid * 32); dst[0] = o0; dst[1] = o1; }
    for (int i = tid; i < 128 * 128; i += 512) { const int n = i >> 7, k = (i & 127) * 2, p = n & 63, j = k >> 4, hp = k & 15;
        const float lr = lamp[((15 - j) * 64 + p) * 2], li = lamp[((15 - j) * 64 + p) * 2 + 1];
        const f32x4 bb = *(const LAS f32x4*)(bbar + (p * 16 + hp) * 2);
        const float v0 = n < 64 ? (lr * bb[0] - li * bb[1]) : (lr * bb[1] + li * bb[0]), v1 = n < 64 ? (lr * bb[2] - li * bb[3]) : (lr * bb[3] + li * bb[2]);
        *(unsigned*)(img + TAB_M3 + n * 528 + k * 2) = pk2(v0, v1); }
    for (int i = tid; i < 256 * 64; i += 512) { const int n = i >> 6, q = (i & 63) * 2, p = q & 63, ii = n >> 4, h = n & 15;
        float v[2];
#pragma unroll
        for (int e = 0; e < 2; ++e) { const float lr = lamp[((ii + 1) * 64 + p + e) * 2], li = lamp[((ii + 1) * 64 + p + e) * 2 + 1], cr = cc[((p + e) * 16 + h) * 2], ci = cc[((p + e) * 16 + h) * 2 + 1];
            v[e] = q < 64 ? (cr * lr - ci * li) : -(cr * li + ci * lr); }
        *(unsigned*)(img + TAB_M2 + n * 272 + q * 2) = pk2(v[0], v[1]); }
    __syncthreads();
}
__device__ __forceinline__ void p0_prologue(ArgsP ap, LAS unsigned char* lds, int wid0) {
    int tid_ = wid0 * 64 + lane_id(); asm volatile("" : "+v"(tid_));
    const int tid = tid_, lane = tid & 63, wave = tid >> 6, G = gridDim.x;
    unsigned char* ws = ap->ws;
    if ((int)blockIdx.x < 96) {
        LAS float* cact = (LAS float*)(lds + 72 * 1024);
        LAS float* red = (LAS float*)(lds + 104 * 1024);
        const float* c = ap->in[I_C];
        for (int i = tid; i < NB * D; i += 512) cact[i] = siluf_(c[i]);
        __syncthreads();
        for (int item = blockIdx.x; item < 96; item += G) {
            const int col = item * 64 + lane, k0 = wave * 128;
            const float* wp = ap->in[I_WADA] + (size_t)k0 * NMOD + col;
            float acc[NB];
#pragma unroll
            for (int b = 0; b < NB; ++b) acc[b] = 0.f;
#pragma unroll 16
            for (int k = 0; k < 128; ++k) { const float w = __builtin_nontemporal_load(wp + (size_t)k * NMOD);
#pragma unroll
                for (int b = 0; b < NB; ++b) acc[b] += cact[b * D + k0 + k] * w; }
#pragma unroll
            for (int b = 0; b < NB; ++b) red[(wave * NB + b) * 64 + lane] = acc[b];
            __syncthreads();
            { const int b = wave; float s = ap->in[I_BADA][col];
#pragma unroll
              for (int w = 0; w < 8; ++w) s += red[(w * NB + b) * 64 + lane];
              ((float*)(ws + WS_MOD))[b * NMOD + col] = s; }
            asm volatile("s_waitcnt vmcnt(0)" ::: "memory");
            __syncthreads();
            if (tid == 0) { __builtin_amdgcn_fence(__ATOMIC_RELEASE, "agent"); asm volatile("s_waitcnt vmcnt(0)" ::: "memory");
                __hip_atomic_fetch_add((unsigned*)(ws + WS_BAR) + 64, 1u, __ATOMIC_RELAXED, __HIP_MEMORY_SCOPE_AGENT); }
        }
    }
    for (int w = blockIdx.x; w < 128; w += G) if (w >= 96) build_tables(ap, lds, w - 96, tid);
    LAS float* scr = (LAS float*)(lds + wave * 8704);
    const bool split = (G >= 256);
    if (split && (int)blockIdx.x < 128) return;
    const int gw = (split ? (int)blockIdx.x - 128 : (int)blockIdx.x) * 8 + wave, NGW = (split ? G - 128 : G) * 8;
    constexpr int I1 = 16 * 64, I2 = 8 * 16, I3 = 16 * 32, I4 = 16 * 176, I5 = 44 * 32, NIT = I1 + I2 + I3 + I4 + I5;
    for (int it = gw; it < NIT; it += NGW) {
        int r = it;
        if (r < I1) { const int nb = r % 64, kb = r / 64; transpose_item<true>(ap->in[I_WIN], D, DIN, (bf16_t*)(ws + WS_WIN), 0, 64 * kb, 32 * nb, scr, lane); continue; } r -= I1;
        if (r < I2) { const int nb = r % 16, kb = r / 16; transpose_item(ap->in[I_GLUW], DSSM, DSSM, (bf16_t*)(ws + WS_GLU), 32 * nb, 64 * kb, 32 * nb, scr, lane); continue; } r -= I2;
        if (r < I3) { const int nb = r % 32, kb = r / 32; transpose_item(ap->in[I_WOUT], D, D, (bf16_t*)(ws + WS_WOUT), 32 * nb, 64 * kb, 32 * nb, scr, lane); continue; } r -= I3;
        if (r < I4) { const int nb = r % 176, kb = r / 176; const int n0 = 32 * nb; const int j = n0 < DFF ? n0 : n0 - DFF;
            const int drow = (j / 128) * 256 + (n0 < DFF ? 0 : 128) + (j % 128);
            transpose_item(ap->in[I_WUP], D, NUP, (bf16_t*)(ws + WS_WUP), drow, 64 * kb, n0, scr, lane); continue; } r -= I4;
        { const int nb = r % 32, kb = r / 32; transpose_item(ap->in[I_WDN], DFF, D, (bf16_t*)(ws + WS_WDN), 32 * nb, 64 * kb, 32 * nb, scr, lane); }
    }
}

__device__ __forceinline__ void p1_rows(ArgsP ap, int wid0, bool wait_mod) {
    int tid_ = wid0 * 64 + lane_id(); asm volatile("" : "+v"(tid_));
    const int lane = tid_ & 63, wave = tid_ >> 6, G = gridDim.x;
    const float* mod = (const float*)(ap->ws + WS_MOD);
    bf16_t* H = (bf16_t*)(ap->ws + WS_H);
    if (wait_mod) {
        if (tid_ == 0) { unsigned* cnt = (unsigned*)(ap->ws + WS_BAR) + 64; unsigned sp = 0;
            while (__hip_atomic_load(cnt, __ATOMIC_RELAXED, __HIP_MEMORY_SCOPE_AGENT) < 96u) { __builtin_amdgcn_s_sleep(2); if (++sp > (1u << 22)) break; }
            __builtin_amdgcn_fence(__ATOMIC_ACQUIRE, "agent"); asm volatile("s_waitcnt vmcnt(0)" ::: "memory"); }
        __syncthreads();
    }
    const int vb = (G % 8 == 0) ? (int)(blockIdx.x % 8) * (G / 8) + (int)(blockIdx.x / 8) : (int)blockIdx.x;
    for (int base = (vb * 8 + wave) * 16; base < M; base += G * 8 * 16) {
        const int b = base / SEQ;
        f32x4 gs[4], sh[4];
#pragma unroll
        for (int j = 0; j < 4; ++j) { const int col = 4 * lane + 256 * j;
            const f32x4 g = *(const f32x4*)(ap->in[I_GPREMIX] + col), sc = *(const f32x4*)(mod + b * NMOD + D + col);
            gs[j] = g * (sc + 1.0f); sh[j] = *(const f32x4*)(mod + b * NMOD + col); }
#pragma unroll 1
        for (int rb = 0; rb < 16; rb += 4) {
            f32x4 v[4][4];
#pragma unroll
            for (int r = 0; r < 4; ++r) { const f32x4* xr = (const f32x4*)(ap->in[I_X] + (size_t)(base + rb + r) * D) + lane;
#pragma unroll
                for (int j = 0; j < 4; ++j) v[r][j] = __builtin_nontemporal_load(xr + 64 * j); }
#pragma unroll
            for (int r = 0; r < 4; ++r) { const size_t row = base + rb + r; float ss = 0.f;
#pragma unroll
                for (int j = 0; j < 4; ++j) ss += (v[r][j].x * v[r][j].x + v[r][j].y * v[r][j].y) + (v[r][j].z * v[r][j].z + v[r][j].w * v[r][j].w);
                const float rs = rsqrtf(wave_sum(ss) * (1.0f / D) + EPS);
                u32x2* o = (u32x2*)(H + row * D) + lane;
#pragma unroll
                for (int j = 0; j < 4; ++j) { const f32x4 h = v[r][j] * rs * gs[j] + sh[j]; u32x2 w; w.x = pk2(h.x, h.y); w.y = pk2(h.z, h.w); o[64 * j] = w; }
            }
        }
    }
}

constexpr int L_KTAB = 0, L_XS = 8704, L_MT = 78336, L_CARRY = 147968;
constexpr int L_BBAR = L_XS, L_CC = L_XS + 8192, L_LAMP = L_XS + 16384;
__device__ __forceinline__ void ssm_unit(ArgsP ap, LAS unsigned char* lds, int unit, int wid0) {
    int tid_ = wid0 * 64 + lane_id(); asm volatile("" : "+v"(tid_));
    const int tid = tid_, lane = tid & 63, wave = __builtin_amdgcn_readfirstlane(tid >> 6), b = unit & 7, g = unit >> 3;
    const bf16_t* UB = (const bf16_t*)(ap->ws + WS_U);
    bf16_t* Z = (bf16_t*)(ap->ws + WS_Z);
    float* SS = (float*)(ap->ws + WS_SS) + (size_t)unit * NCH * 128;
    const unsigned char* img = ap->ws + WS_TAB + (size_t)g * TAB_BYTES;
    __syncthreads();
    u32x4 t0[2], t1[9], m2r[9];
#pragma unroll
    for (int k = 0; k < 2; ++k) { const int i = tid + 512 * k; if (i < 8704 / 16) t0[k] = ((const u32x4*)(img + TAB_KTAB))[i]; }
#pragma unroll
    for (int k = 0; k < 9; ++k) { const int i = tid + 512 * k; if (i < 67584 / 16) t1[k] = ((const u32x4*)(img + TAB_M3))[i]; }
    const int r32 = lane & 31, hh = lane >> 5, c0 = wave * 32;
    const bf16_t* up = UB + ((size_t)b * SEQ + (size_t)(c0 + r32) * TCH) * DSSM + 16 * g + 8 * hh;
    f32x16 accS[4];
    {
    bf16x8 ufr[16];
#pragma unroll
    for (int j = 0; j < 16; ++j) ufr[j] = *(const bf16x8*)(up + (size_t)j * DSSM);
#pragma unroll
    for (int k = 0; k < 9; ++k) { const int i = tid + 512 * k; if (i < 69632 / 16) m2r[k] = ((const u32x4*)(img + TAB_M2))[i]; }
#pragma unroll
    for (int k = 0; k < 2; ++k) { const int i = tid + 512 * k; if (i < 8704 / 16) ((LAS u32x4*)(lds + L_KTAB))[i] = t0[k]; }
#pragma unroll
    for (int k = 0; k < 9; ++k) { const int i = tid + 512 * k; if (i < 67584 / 16) ((LAS u32x4*)(lds + L_MT))[i] = t1[k]; }
    __syncthreads();
#pragma unroll
    for (int nb = 0; nb < 4; ++nb) {
        __builtin_amdgcn_sched_barrier(0);
#pragma unroll
        for (int e = 0; e < 16; ++e) accS[nb][e] = 0.f;
#pragma unroll
        for (int j = 0; j < 16; ++j) { const bf16x8 bf = *(const LAS bf16x8*)(lds + L_MT + (32 * nb + r32) * 528 + (16 * j + 8 * hh) * 2);
            accS[nb] = __builtin_amdgcn_mfma_f32_32x32x16_bf16(ufr[j], bf, accS[nb], 0, 0, 0); }
    }
    }
    const int p = lane, sb = wave;
    const float ltr = ((const float*)(img + TAB_LAMT))[p * 2], lti = ((const float*)(img + TAB_LAMT))[p * 2 + 1];
    __syncthreads();
    { LAS float* sl = (LAS float*)(lds + L_XS);
#pragma unroll
      for (int nb = 0; nb < 4; ++nb)
#pragma unroll
          for (int e = 0; e < 16; ++e) sl[(c0 + (e & 3) + 8 * (e >> 2) + 4 * hh) * 128 + 32 * nb + r32] = accS[nb][e]; }
    __syncthreads();
    float er[32], ei[32];
    { const LAS float* sp = (const LAS float*)(lds + L_XS) + (32 * sb) * 128 + p;
#pragma unroll
      for (int k = 0; k < 32; ++k) { er[k] = sp[k * 128]; ei[k] = sp[k * 128 + 64]; } }
    __syncthreads();
#pragma unroll
    for (int k = 0; k < 9; ++k) { const int i = tid + 512 * k; if (i < 69632 / 16) ((LAS u32x4*)(lds + L_MT))[i] = m2r[k]; }
    { float xr = 0.f, xi = 0.f;
#pragma unroll
      for (int k = 0; k < 32; ++k) { const float sr = er[k], si = ei[k]; er[k] = xr; ei[k] = xi;
          const float nr = ltr * xr - lti * xi + sr, ni = ltr * xi + lti * xr + si; xr = nr; xi = ni; }
      LAS float* carry = (LAS float*)(lds + L_CARRY);
      carry[(sb * 64 + p) * 2] = xr; carry[(sb * 64 + p) * 2 + 1] = xi; }
    __syncthreads();
    { float l32r = ltr, l32i = lti;
#pragma unroll
      for (int s = 0; s < 5; ++s) { const float nr = l32r * l32r - l32i * l32i, ni = 2.0f * l32r * l32i; l32r = nr; l32i = ni; }
      const LAS float* carry = (const LAS float*)(lds + L_CARRY);
      float xr = 0.f, xi = 0.f;
      for (int s = 0; s < sb; ++s) { const float nr = l32r * xr - l32i * xi + carry[(s * 64 + p) * 2], ni = l32r * xi + l32i * xr + carry[(s * 64 + p) * 2 + 1]; xr = nr; xi = ni; }
      float pr = 1.f, pi = 0.f;
#pragma unroll
      for (int k = 0; k < 32; ++k) { const float vr = er[k] + pr * xr - pi * xi, vi = ei[k] + pr * xi + pi * xr;
          LAS bf16_t* xs = (LAS bf16_t*)(lds + L_XS + (32 * sb + k) * 272);
          const unsigned w = pk2(vr, vi); xs[p] = (bf16_t)(w & 0xffffu); xs[64 + p] = (bf16_t)(w >> 16);
          const float nr = pr * ltr - pi * lti, ni = pr * lti + pi * ltr; pr = nr; pi = ni; } }
    __syncthreads();
    __builtin_amdgcn_sched_barrier(0);
    bf16x8 ufr[16];
    { int l2 = lane_id(); asm volatile("" : "+v"(l2)); const int r2 = l2 & 31, h2 = (l2 >> 5) & 1;
      const bf16_t* up2 = UB + ((size_t)b * SEQ + (size_t)(c0 + r2) * TCH) * DSSM + 16 * g + 8 * h2;
#pragma unroll
      for (int j = 0; j < 16; ++j) ufr[j] = *(const bf16x8*)(up2 + (size_t)j * DSSM); }
#pragma unroll
    for (int half = 0; half < 2; ++half) {
        __builtin_amdgcn_sched_barrier(0);
        f32x16 acc[4];
#pragma unroll
        for (int q = 0; q < 4; ++q)
#pragma unroll
            for (int e = 0; e < 16; ++e) acc[q][e] = 0.f;
#pragma unroll
        for (int j = 0; j < 8 * half + 8; ++j)
#pragma unroll
            for (int q = 0; q < 4; ++q) { const int nb = 4 * half + q;
                if (j <= 2 * nb + 1) { int d1 = 2 * nb - j + (r32 >> 4) + 1; d1 = d1 < 0 ? 0 : d1;
                    const bf16x8 bf = *(const LAS bf16x8*)(lds + L_KTAB + d1 * 512 + (lane & 15) * 32 + 16 * hh);
                    acc[q] = __builtin_amdgcn_mfma_f32_32x32x16_bf16(ufr[j], bf, acc[q], 0, 0, 0); } }
#pragma unroll
        for (int ks = 0; ks < 8; ++ks) { const bf16x8 af = *(const LAS bf16x8*)(lds + L_XS + (c0 + r32) * 272 + (16 * ks + 8 * hh) * 2);
#pragma unroll
            for (int q = 0; q < 4; ++q) { const int nb = 4 * half + q;
                const bf16x8 bf = *(const LAS bf16x8*)(lds + L_MT + (32 * nb + r32) * 272 + (16 * ks + 8 * hh) * 2);
                acc[q] = __builtin_amdgcn_mfma_f32_32x32x16_bf16(af, bf, acc[q], 0, 0, 0); } }
#pragma unroll
        for (int q = 0; q < 4; ++q) { __builtin_amdgcn_sched_barrier(0); const int n = 32 * (4 * half + q) + r32, ii = n >> 4, ch = 16 * g + (n & 15);
#pragma unroll
            for (int e = 0; e < 16; ++e) { const int chunk = c0 + (e & 3) + 8 * (e >> 2) + 4 * hh; const size_t t = (size_t)b * SEQ + (size_t)chunk * TCH + ii;
                Z[t * DSSM + ch] = (bf16_t)(pk2(gelu_tanh(acc[q][e]), 0.f) & 0xffffu); } }
    }
    __syncthreads();
}
__device__ __forceinline__ void fix_conv_rows(ArgsP ap, int wid0) {
    const int lane = lane_id(), G = gridDim.x;
    const float* HTI = (const float*)(ap->ws + WS_HT);
    bf16_t* Y = (bf16_t*)(ap->ws + WS_Y);
    const int ch = 8 * lane;
    for (int it = blockIdx.x * 8 + wid0; it < (M / 256) * 2; it += G * 8) {
        const int pm = it >> 1, r = it & 1;
        if ((pm & 15) == 0) continue;
        const float* hp = HTI + ((size_t)(pm - 1) * 6) * 512 + ch, *hc = HTI + ((size_t)pm * 6) * 512 + ch;
        float yb[8]; float ss = 0.f;
#pragma unroll
        for (int e = 0; e < 8; ++e) {
            const float pm2 = hp[2 * 512 + e], pm1 = hp[3 * 512 + e], p0 = hc[e], p1 = hc[512 + e];
            const float w0 = ap->in[I_CONVW][ch + e], w1 = ap->in[I_CONVW][512 + ch + e], w2 = ap->in[I_CONVW][1024 + ch + e];
            const float cv = r == 0 ? (w0 * pm2 + w1 * pm1 + w2 * p0) : (w0 * pm1 + w1 * p0 + w2 * p1);
            yb[e] = hc[(4 + r) * 512 + e] * cv; ss += yb[e] * yb[e]; }
        ss += __shfl_xor(ss, 1); ss += __shfl_xor(ss, 2); ss += __shfl_xor(ss, 4);
        const float rs = rsqrtf(ss * (1.0f / 64.0f) + EPS);
        u32x4 w;
        w.x = pk2(yb[0] * rs * ap->in[I_GOCONV][ch + 0], yb[1] * rs * ap->in[I_GOCONV][ch + 1]); w.y = pk2(yb[2] * rs * ap->in[I_GOCONV][ch + 2], yb[3] * rs * ap->in[I_GOCONV][ch + 3]);
        w.z = pk2(yb[4] * rs * ap->in[I_GOCONV][ch + 4], yb[5] * rs * ap->in[I_GOCONV][ch + 5]); w.w = pk2(yb[6] * rs * ap->in[I_GOCONV][ch + 6], yb[7] * rs * ap->in[I_GOCONV][ch + 7]);
        *(u32x4*)(Y + ((size_t)pm * 256 + r) * D + 512 + ch) = w;
    }
}
__device__ __forceinline__ void fix_panel(ArgsP ap, int pm, int tid) {
    if ((pm & 15) == 0) return;
    const float* HT = (const float*)(ap->ws + WS_HT);
    const float* fcw = ap->in[I_FCW];
    bf16_t* Gm = (bf16_t*)(ap->ws + WS_G);
    const float* hp = HT + ((size_t)(pm - 1) * 4) * NUP, *hc = HT + ((size_t)pm * 4) * NUP;
    for (int j = tid; j < DFF; j += 512) {
        const int ia = (j >> 7) * 256 + (j & 127), iv = ia + 128;
        const float am2 = hp[2 * NUP + ia], am1 = hp[3 * NUP + ia], a0 = hc[ia], a1 = hc[NUP + ia];
        const float vm2 = hp[2 * NUP + iv], vm1 = hp[3 * NUP + iv], v0 = hc[iv], v1 = hc[NUP + iv];
        const float wa0 = fcw[j], wa1 = fcw[NUP + j], wa2 = fcw[2 * NUP + j], wv0 = fcw[DFF + j], wv1 = fcw[NUP + DFF + j], wv2 = fcw[2 * NUP + DFF + j];
        const float ca0 = wa0 * am2 + wa1 * am1 + wa2 * a0, ca1 = wa0 * am1 + wa1 * a0 + wa2 * a1;
        const float cv0 = wv0 * vm2 + wv1 * vm1 + wv2 * v0, cv1 = wv0 * vm1 + wv1 * v0 + wv2 * v1;
        Gm[((size_t)pm * 256) * DFF + j] = (bf16_t)(pk2(siluf_(ca0) * cv0, 0.f) & 0xffffu);
        Gm[((size_t)pm * 256 + 1) * DFF + j] = (bf16_t)(pk2(siluf_(ca1) * cv1, 0.f) & 0xffffu);
    }
}
__global__ void __launch_bounds__(512, 2) hymba_fwd(Args a_unused) {
    extern __shared__ __attribute__((aligned(16))) unsigned char shm[];
    LAS unsigned char* lds = (LAS unsigned char*)shm;
    cg::grid_group grid = cg::this_grid();
    const int wid0 = __builtin_amdgcn_readfirstlane(threadIdx.x >> 6);
    if (threadIdx.x < 4) ((LAS unsigned*)(lds + L_BARST))[threadIdx.x] = 0u;
    __syncthreads();
    XcdBarrier xbar = xcd_barrier_post((unsigned*)(opaque_args()->ws + WS_BAR), (volatile LAS unsigned*)(lds + L_BARST));
    if (opaque_args()->ph_lo < 0) grid.sync();
    const int G = gridDim.x;
#define SEAM() xcd_barrier(xbar)
    p0_prologue(opaque_args(), lds, wid0);
    p1_rows(opaque_args(), wid0, true);
    SEAM();
    {
        ArgsP ap = opaque_args(); unsigned char* ws = ap->ws;
        pg8::Gemm g{(const bf16_t*)(ws + WS_H), (const bf16_t*)(ws + WS_WIN), M, DIN, D}; pg8::StaticOrder S; S.init(M, DIN, G, blockIdx.x);
        pg8::EpiIn E{(bf16_t*)(ws + WS_Y), (bf16_t*)(ws + WS_U), (float*)(ws + WS_HT), ap->in[I_CONVW], ap->in[I_GOCONV], (LAS float*)(lds + pg8::STAGE_BYTES)};
        pg8::gemm_phase<pg8::EpiIn, true, true>(lds, g, S, E, wid0);
    }
    SEAM();
    fix_conv_rows(opaque_args(), wid0);
    for (int u = blockIdx.x; u < NB * NGRP; u += G) ssm_unit(opaque_args(), lds, u, wid0);
    SEAM();
    {
        ArgsP ap = opaque_args(); unsigned char* ws = ap->ws;
        pg8::Gemm g{(const bf16_t*)(ws + WS_Z), (const bf16_t*)(ws + WS_GLU), M, DSSM, DSSM}; pg8::StaticOrder S; S.init(M, DSSM, G, blockIdx.x);
        pg8::EpiGlu E{(const bf16_t*)(ws + WS_Z), (bf16_t*)(ws + WS_Y), ap->in[I_GLUB], ap->in[I_GOSSM]};
        pg8::gemm_phase<pg8::EpiGlu, true, true>(lds, g, S, E, wid0);
    }
    SEAM();
    {
        ArgsP ap = opaque_args(); unsigned char* ws = ap->ws;
        pg8::Gemm g{(const bf16_t*)(ws + WS_Y), (const bf16_t*)(ws + WS_WOUT), M, D, D}; pg8::StaticOrder S; S.init(M, D, G, blockIdx.x);
        pg8::EpiOutNorm E{ap->in[I_X], (unsigned short*)(ws + WS_T), (bf16_t*)(ws + WS_H), (const float*)(ws + WS_MOD), ap->in[I_GPOSTMIX], ap->in[I_GPREFFN],
                          (float*)(ws + WS_XG) + (size_t)M * 4, (unsigned*)(ws + WS_CNT) + 128 * 64, (LAS float*)(lds + pg8::STAGE_BYTES)};
        pg8::gemm_phase<pg8::EpiOutNorm, true, true>(lds, g, S, E, wid0);
    }
    SEAM();
    {
        ArgsP ap = opaque_args(); unsigned char* ws = ap->ws;
        pg8::Gemm g{(const bf16_t*)(ws + WS_H), (const bf16_t*)(ws + WS_WUP), M, NUP, D}; pg8::StaticOrder S; S.init(M, NUP, G, blockIdx.x);
        pg8::EpiUp E{(bf16_t*)(ws + WS_G), (float*)(ws + WS_HT), ap->in[I_FCW], (LAS float*)(lds + pg8::STAGE_BYTES)};
        pg8::gemm_phase<pg8::EpiUp, true, true>(lds, g, S, E, wid0);
    }
    SEAM();
    {
        ArgsP ap = opaque_args(); unsigned char* ws = ap->ws;
        pg8::Gemm g{(const bf16_t*)(ws + WS_G), (const bf16_t*)(ws + WS_WDN), M, D, DFF}; pg8::StaticOrder S; S.init(M, D, G, blockIdx.x);
        { pg8::Unit fu; const int ftid = wid0 * 64 + lane_id(); for (int i = 0; S.next(i, fu); ++i) fix_panel(ap, fu.pm, ftid);
          asm volatile("s_waitcnt vmcnt(0)" ::: "memory"); __syncthreads(); }
        pg8::EpiDownNorm E{ap->out, (const unsigned short*)(ws + WS_T), (const float*)(ws + WS_MOD), ap->in[I_GPOSTFFN], (float*)(ws + WS_XG), (unsigned*)(ws + WS_CNT), (LAS float*)(lds + pg8::STAGE_BYTES)};
        pg8::gemm_phase<pg8::EpiDownNorm, true, true>(lds, g, S, E, wid0);
    }
#undef SEAM
}

extern "C" void kernel_launch(void* const* d_in, const int* in_sizes, int n_in, void* d_out, int out_size, void* d_ws, size_t ws_size, hipStream_t stream) {
    static int grid = 0;
    if (grid == 0) {
        if (n_in != 26 || in_sizes[0] != M * D || out_size != M * D || ws_size < WS_END) { fprintf(stderr, "kernel_launch: unexpected shapes (n_in %d, ws %zu)\n", n_in, ws_size); grid = -1; return; }
        int dev = 0, cus = 0, per_cu = 0;
        hipGetDevice(&dev); hipDeviceGetAttribute(&cus, hipDeviceAttributeMultiprocessorCount, dev);
        if (hipFuncSetAttribute((const void*)hymba_fwd, hipFuncAttributeMaxDynamicSharedMemorySize, LDS_BYTES) != hipSuccess) { fprintf(stderr, "kernel_launch: hipFuncSetAttribute failed\n"); }
        if (hipOccupancyMaxActiveBlocksPerMultiprocessor(&per_cu, (const void*)hymba_fwd, 512, LDS_BYTES) != hipSuccess || per_cu < 1) per_cu = 1;
        (void)hipGetLastError();
        grid = cus * per_cu;
        if (grid > 256) grid = 256;
    }
    if (grid < 0) return;
    Args a{};
    for (int i = 0; i < 26; ++i) a.in[i] = (const float*)d_in[i];
    a.out = (float*)d_out; a.ws = (unsigned char*)d_ws;
    (void)hipMemsetAsync((char*)d_ws + WS_BAR, 0, CTL_ZERO, stream);
    a.ph_lo = 0; a.ph_hi = 0;
    void* args[] = {&a};
    hipError_t e = hipLaunchCooperativeKernel((const void*)hymba_fwd, dim3(grid), dim3(512), args, LDS_BYTES, stream);
    if (e != hipSuccess) fprintf(stderr, "cooperative launch failed: %s (grid %d)\n", hipGetErrorString(e), grid);

}
```
